# Optimizing an MI355X kernel written in HIP

```python
import jax, jax.numpy as jnp
from jax import lax
import numpy as np

D_MODEL = 2048
BATCH = 4
SEQ = 4096
DEPTH = 1

CHUNK = 64
N_META = 16
EPS = 1e-6
RG_WIDTH = 2048
RG_HEADS = 16
RG_HEAD_DIM = RG_WIDTH // RG_HEADS
CONV_WIDTH = 4
RG_C = 8.0
HG_HEADS = 16
HG_EXPAND = 128
HG_HEAD_DIM = 128
HG_WIDTH = HG_HEADS * HG_EXPAND
PEER_HEADS = 8
N_KEYS = 128
N_EXPERTS = N_KEYS * N_KEYS
PEER_TOPK = 16
D_QUERY = 256
PEER_BLOCK = 128

IN_SPLITS = (RG_WIDTH, 2 * RG_WIDTH, 2 * RG_WIDTH + HG_WIDTH, 2 * RG_WIDTH + 2 * HG_WIDTH,
             2 * RG_WIDTH + 3 * HG_WIDTH, 2 * RG_WIDTH + 4 * HG_WIDTH,
             2 * RG_WIDTH + 4 * HG_WIDTH + D_MODEL)
IN_WIDTH = 2 * RG_WIDTH + 4 * HG_WIDTH + 2 * D_MODEL

kernel_name = "hybrid_rglru_hgrn2_peer_block"


def rms_norm(x, g):
    xf = x.astype(jnp.float32)
    y = xf * lax.rsqrt(jnp.mean(xf * xf, axis=-1, keepdims=True) + EPS)
    return (y * g.astype(jnp.float32)).astype(x.dtype)


def causal_dwconv(x, w, b):
    T = x.shape[1]
    xp = jnp.pad(x, ((0, 0), (CONV_WIDTH - 1, 0), (0, 0)))
    y = b
    for k in range(CONV_WIDTH):
        y = y + xp[:, k:k + T] * w[k]
    return y


def rg_lru(x, wa, ba, wx, bx, lam):
    B, T, _ = x.shape
    xf = x.astype(jnp.float32)
    xh = xf.reshape(B, T, RG_HEADS, RG_HEAD_DIM)
    r = jax.nn.sigmoid(jnp.einsum('bthi,hij->bthj', xh, wa.astype(jnp.float32)).reshape(B, T, RG_WIDTH) + ba)
    i = jax.nn.sigmoid(jnp.einsum('bthi,hij->bthj', xh, wx.astype(jnp.float32)).reshape(B, T, RG_WIDTH) + bx)
    log_a = -RG_C * r * jax.nn.softplus(-lam.astype(jnp.float32))
    a = jnp.exp(log_a)
    u = jnp.sqrt(-jnp.expm1(2.0 * log_a)) * (i * xf)

    def combine(e, l):
        return l[0] * e[0], l[0] * e[1] + l[1]

    _, h = lax.associative_scan(combine, (a, u), axis=1)
    return h.astype(x.dtype)


def hgrn2(q, f_logits, v, og, lb, norm_g):
    B, T, _ = q.shape
    dt = q.dtype
    f = lb + (1.0 - lb) * jax.nn.sigmoid(f_logits.astype(jnp.float32))
    log_f = jnp.log(f)
    k = 1.0 - f
    qs = jax.nn.silu(q.astype(jnp.float32))
    vf = v.astype(jnp.float32)
    pad = (-T) % CHUNK
    Tp = T + pad
    nc = Tp // CHUNK

    def to_chunks(t, d):
        t = jnp.pad(t, ((0, 0), (pad, 0), (0, 0)))
        return t.reshape(B, nc, CHUNK, HG_HEADS, d).transpose(1, 0, 3, 2, 4)

    qc, kc, lfc = to_chunks(qs, HG_EXPAND), to_chunks(k, HG_EXPAND), to_chunks(log_f, HG_EXPAND)
    vc = to_chunks(vf, HG_HEAD_DIM)
    causal = jnp.tril(jnp.ones((CHUNK, CHUNK), dtype=bool))

    def step(S, inp):
        qt, kt, vt, lf = inp
        bcum = jnp.cumsum(lf, axis=2)
        diff = bcum[:, :, :, None, :] - bcum[:, :, None, :, :]
        decay = jnp.exp(jnp.where(causal[:, :, None], diff, -jnp.inf))
        scores = jnp.einsum('bhtk,bhtsk,bhsk->bhts', qt, decay, kt)
        o = (jnp.einsum('bhts,bhsv->bhtv', scores, vt)
             + jnp.einsum('bhtk,bhkv->bhtv', qt * jnp.exp(bcum), S))
        blast = bcum[:, :, -1:, :]
        S = (jnp.exp(blast[:, :, 0, :])[..., None] * S
             + jnp.einsum('bhsk,bhsv->bhkv', kt * jnp.exp(blast - bcum), vt))
        return S, o

    S0 = jnp.zeros((B, HG_HEADS, HG_EXPAND, HG_HEAD_DIM), jnp.float32)
    _, o = lax.scan(step, S0, (qc, kc, vc, lfc))
    o = o.transpose(1, 0, 3, 2, 4).reshape(B, Tp, HG_HEADS, HG_HEAD_DIM)[:, pad:]
    o = o * lax.rsqrt(jnp.mean(o * o, axis=-1, keepdims=True) + EPS)
    o = o.reshape(B, T, HG_HEADS * HG_HEAD_DIM) * norm_g.astype(jnp.float32)
    return (o * jax.nn.silu(og.astype(jnp.float32))).astype(dt)


def peer(x, wq, keys, u, v):
    B, T, D = x.shape
    n = B * T
    xt = x.reshape(n, D)
    q = (xt @ wq).reshape(n, PEER_HEADS, 2, D_QUERY // 2)
    s = jnp.einsum('nhpd,hpkd->nhpk', q, keys).astype(jnp.float32)
    s_top, i_top = lax.top_k(s, PEER_TOPK)
    cand = (s_top[:, :, 0, :, None] + s_top[:, :, 1, None, :]).reshape(n, PEER_HEADS, PEER_TOPK * PEER_TOPK)
    cand_idx = (i_top[:, :, 0, :, None] * N_KEYS + i_top[:, :, 1, None, :]).reshape(n, PEER_HEADS, PEER_TOPK * PEER_TOPK)
    best, pos = lax.top_k(cand, PEER_TOPK)
    idx = jnp.take_along_axis(cand_idx, pos, axis=-1).reshape(n, PEER_HEADS * PEER_TOPK)
    gate = jax.nn.softmax(best, axis=-1).reshape(n, PEER_HEADS * PEER_TOPK).astype(x.dtype)
    pad_n = (-n) % PEER_BLOCK
    nb = (n + pad_n) // PEER_BLOCK
    xb = jnp.pad(xt, ((0, pad_n), (0, 0))).reshape(nb, PEER_BLOCK, D)
    ib = jnp.pad(idx, ((0, pad_n), (0, 0))).reshape(nb, PEER_BLOCK, -1)
    gb = jnp.pad(gate, ((0, pad_n), (0, 0))).reshape(nb, PEER_BLOCK, -1)

    def block(args):
        xs, ids, gs = args
        ue = jnp.take(u, ids, axis=0)
        act = jax.nn.gelu(jnp.einsum('nd,ned->ne', xs, ue), approximate=False)
        ve = jnp.take(v, ids, axis=0)
        return jnp.einsum('ne,ned->nd', gs * act, ve)

    out = lax.map(block, (xb, ib, gb)).reshape(nb * PEER_BLOCK, D)[:n]
    return out.reshape(B, T, D)


def setup_inputs(seed: int = 0) -> dict:
    key = jax.random.key(seed)
    ks = jax.random.split(key, 24)
    f32 = jnp.float32
    L = DEPTH

    def nrm(k, shape, scale):
        return jax.random.normal(k, shape, f32) * scale

    a_c = jax.random.uniform(ks[11], (L, RG_WIDTH), f32, 0.9, 0.999)
    a = a_c ** (1.0 / RG_C)
    rg_lambda = jnp.log(a) - jnp.log1p(-a)
    return {
        'x': nrm(ks[0], (BATCH, SEQ, D_MODEL), 1.0),
        'meta': nrm(ks[1], (N_META, D_MODEL), 1.0),
        'ln1_g': 1.0 + nrm(ks[2], (L, D_MODEL), 0.02),
        'w_in': nrm(ks[3], (L, D_MODEL, IN_WIDTH), D_MODEL ** -0.5),
        'conv_w': nrm(ks[4], (L, CONV_WIDTH, RG_WIDTH), CONV_WIDTH ** -0.5),
        'conv_b': nrm(ks[5], (L, RG_WIDTH), 0.02),
        'rg_wa': nrm(ks[6], (L, RG_HEADS, RG_HEAD_DIM, RG_HEAD_DIM), RG_HEAD_DIM ** -0.5),
        'rg_ba': nrm(ks[7], (L, RG_WIDTH), 0.02),
        'rg_wx': nrm(ks[8], (L, RG_HEADS, RG_HEAD_DIM, RG_HEAD_DIM), RG_HEAD_DIM ** -0.5),
        'rg_bx': nrm(ks[9], (L, RG_WIDTH), 0.02),
        'rg_lambda': rg_lambda,
        'hg_lb_logits': nrm(ks[10], (L + 1, HG_WIDTH), 0.5),
        'hg_norm_g': 1.0 + nrm(ks[12], (L, HG_WIDTH), 0.02),
        'w_pa': nrm(ks[13], (L, RG_WIDTH, D_MODEL), RG_WIDTH ** -0.5),
        'w_pb': nrm(ks[14], (L, HG_WIDTH, D_MODEL), HG_WIDTH ** -0.5),
        'w_out': nrm(ks[15], (L, D_MODEL, D_MODEL), D_MODEL ** -0.5),
        'ln2_g': 1.0 + nrm(ks[16], (L, D_MODEL), 0.02),
        'peer_wq': nrm(ks[17], (L, D_MODEL, PEER_HEADS * D_QUERY), D_MODEL ** -0.5),
        'peer_keys': nrm(ks[18], (L, PEER_HEADS, 2, N_KEYS, D_QUERY // 2), (D_QUERY // 2) ** -0.5),
        'peer_u': nrm(ks[19], (L, N_EXPERTS, D_MODEL), D_MODEL ** -0.5),
        'peer_v': nrm(ks[20], (L, N_EXPERTS, D_MODEL), PEER_HEADS ** -0.5),
        'final_g': 1.0 + nrm(ks[21], (D_MODEL,), 0.02),
    }


def reference(x, meta, ln1_g, w_in, conv_w, conv_b, rg_wa, rg_ba, rg_wx, rg_bx, rg_lambda,
              hg_lb_logits, hg_norm_g, w_pa, w_pb, w_out, ln2_g, peer_wq, peer_keys,
              peer_u, peer_v, final_g):
    B = x.shape[0]
    h = jnp.concatenate([jnp.broadcast_to(meta[None].astype(x.dtype), (B, N_META, D_MODEL)), x], axis=1)
    lb_all = jnp.cumsum(jax.nn.softmax(hg_lb_logits.astype(jnp.float32), axis=0), axis=0)
    for l in range(DEPTH):
        xn = rms_norm(h, ln1_g[l])
        proj = xn @ w_in[l]
        xa, ya, qb, fb, ib, gb, za, zb = jnp.split(proj, IN_SPLITS, axis=-1)
        ha = rg_lru(causal_dwconv(xa, conv_w[l], conv_b[l]), rg_wa[l], rg_ba[l], rg_wx[l], rg_bx[l], rg_lambda[l])
        y_a = jax.nn.gelu(ya, approximate=False) * ha
        y_b = hgrn2(qb, fb, ib, gb, lb_all[l], hg_norm_g[l])
        mixed = jax.nn.sigmoid(za) * (y_a @ w_pa[l]) + jax.nn.sigmoid(zb) * (y_b @ w_pb[l])
        h = h + mixed @ w_out[l]
        h = h + peer(rms_norm(h, ln2_g[l]), peer_wq[l], peer_keys[l], peer_u[l], peer_v[l])
    h = rms_norm(h, final_g)
    return h[:, N_META:]
```

```cpp
#include <hip/hip_runtime.h>
#include <cstdio>
#include <cstdint>
#define RGVAR 0
#ifndef REPMASK
#define REPMASK 0
#endif
namespace pg8 {
#define PG8_LAS __attribute__((address_space(3)))
typedef unsigned short bf16_t;
typedef short bf16x8 __attribute__((ext_vector_type(8)));
typedef float f32x4 __attribute__((ext_vector_type(4)));
typedef unsigned u32x4 __attribute__((ext_vector_type(4)));
constexpr int BM = 256, BK = 64, HALF = 128, HTB = HALF * BK * 2  , STAGE_BYTES = 8 * HTB, NXCD = 8, WGM = 8;

__host__ __device__ __forceinline__ int lds_byte(int r, int c) { const int st = (r >> 4) * 2 + (c >> 5), rr = r & 15, cc = c & 31, ob = rr * 64 + cc * 2; return st * 1024 + (ob ^ (((ob >> 9) & 1) << 5)); }
__host__ __device__ __forceinline__ void stage_rc(int b, int& R, int& C) { const int st = b / 1024, sb = b % 1024, swz = sb ^ (((sb >> 9) & 1) << 5); R = (st >> 1) * 16 + swz / 64; C = (st & 1) * 32 + (swz % 64) / 2; }
__host__ __device__ __forceinline__ int perm32(int rho) { const int n = rho >> 4, i = rho & 15; return 8 * (i >> 2) + 4 * n + (i & 3); }

__device__ __forceinline__ int lane_now_pg8() { int l; asm volatile("v_mbcnt_lo_u32_b32 %0, -1, 0\n\tv_mbcnt_hi_u32_b32 %0, -1, %0" : "=v"(l)); return l; }
struct Unit { int pm, pn, seg; };
struct Gemm { const bf16_t* A; const bf16_t* Bt; int M, N, K; const bf16_t* A2; const bf16_t* Bt2; };

struct StaticOrder {
    int nM, nN, nwg, G, c;
    __host__ __device__ void init(int M, int N, int G_, int c_) { nM = M / BM; nN = N / BM; nwg = nM * nN; G = G_; c = c_; }
    __host__ __device__ bool next(int i, Unit& u) const {
        const long L = (long)i * G + c; if (L >= nwg) return false;
        int wgid = (int)L; { const int q = nwg / NXCD, r = nwg % NXCD, xcd = wgid % NXCD, off = wgid / NXCD; wgid = (xcd < r ? xcd * (q + 1) : r * (q + 1) + (xcd - r) * q) + off; }
        const int nig = WGM * nN, gid = wgid / nig, fm = gid * WGM, gsz = (nM - fm) < WGM ? (nM - fm) : WGM;
        u.pm = fm + ((wgid % nig) % gsz); u.pn = (wgid % nig) / gsz; u.seg = 0; return true;
    }
    __device__ __forceinline__ void a_ready(const Unit&) const {}
    __device__ __forceinline__ void done(const Unit&) const {}
};
struct PairOrder : StaticOrder {
    __host__ __device__ bool next(int i, Unit& u) const { if (!StaticOrder::next(i >> 1, u)) return false; u.seg = i & 1; return true; }
};

__device__ __forceinline__ unsigned cvt_pk_bf16(float lo, float hi) { unsigned r; asm volatile("v_cvt_pk_bf16_f32 %0, %1, %2" : "=v"(r) : "v"(lo), "v"(hi)); return r; }
typedef float f32x2 __attribute__((ext_vector_type(2)));
__device__ __forceinline__ f32x2 gelu_pk(f32x2 v) {
    const f32x2 av = __builtin_elementwise_abs(v), d = av * 0.2316418882f + 1.0f;
    f32x2 t; t.x = __builtin_amdgcn_rcpf(d.x); t.y = __builtin_amdgcn_rcpf(d.y);
    f32x2 q = t * 0.5307027145f + (-0.7265760135f); q = q * t + 0.7107068705f; q = q * t + (-0.142248368f); q = q * t + 0.127414796f; q = q * t;
    const f32x2 s = (v * v) * (-0.72134752044f);
    f32x2 e; e.x = __builtin_amdgcn_exp2f(s.x); e.y = __builtin_amdgcn_exp2f(s.y);
    const f32x2 m = v * (q * e), r = v - m;
    f32x2 o; o.x = v.x < 0.f ? m.x : r.x; o.y = v.y < 0.f ? m.y : r.y; return o;
}

__device__ __forceinline__ float bf_lo(unsigned w) { return __uint_as_float(w << 16); }
__device__ __forceinline__ float bf_hi(unsigned w) { return __uint_as_float(w & 0xffff0000u); }
__device__ __forceinline__ float sigmoidf_(float x) { return __builtin_amdgcn_rcpf(1.0f + __expf(-x)); }
typedef unsigned u32x2 __attribute__((ext_vector_type(2)));

struct EpiSplit {
    static constexpr bool PERM = true, AFTER_DRAIN = false, PAIRED = false;
    bf16_t* O; int ldc; int split_cols; size_t split_stride;
    __device__ __forceinline__ void operator()(const f32x4 (&acc)[2][2][4][2], const Unit& u, int wr, int wc, int fr, int fq) const {
        const int row0 = u.pm * BM + wr * 64 + fr; int colt = u.pn * BM; bf16_t* base = O;
        if (split_cols) { const int t = colt / split_cols; base += (size_t)t * split_stride; colt -= t * split_cols; }
        const int col0 = colt + wc * 32 + 8 * fq;
#pragma unroll
        for (int ai = 0; ai < 2; ++ai)
#pragma unroll
            for (int m = 0; m < 4; ++m) { bf16_t* rowp = base + (size_t)(row0 + ai * HALF + m * 16) * ldc + col0;
#pragma unroll
                for (int bj = 0; bj < 2; ++bj) { const f32x4 v0 = acc[ai][bj][m][0], v1 = acc[ai][bj][m][1];
                    u32x4 w; w.x = cvt_pk_bf16(v0[0], v0[1]); w.y = cvt_pk_bf16(v0[2], v0[3]); w.z = cvt_pk_bf16(v1[0], v1[1]); w.w = cvt_pk_bf16(v1[2], v1[3]);
                    *(u32x4*)(rowp + bj * HALF) = w; } }
    }
};
struct EpiRowScale {
    static constexpr bool PERM = true, AFTER_DRAIN = false, PAIRED = false;
    bf16_t* O; int ldc; const float* rsp; float inv_n, eps; float* rstd_out;
    __device__ __forceinline__ void operator()(const f32x4 (&acc)[2][2][4][2], const Unit& u, int wr, int wc, int fr, int fq) const {
        const int row0 = u.pm * BM + wr * 64 + fr; const int col0 = u.pn * BM + wc * 32 + 8 * fq;
#pragma unroll
        for (int ai = 0; ai < 2; ++ai)
#pragma unroll
            for (int m = 0; m < 4; ++m) { const int row = row0 + ai * HALF + m * 16; bf16_t* rowp = O + (size_t)row * ldc + col0;
                const f32x4* rp = (const f32x4*)(rsp + (size_t)row * 32); float ss = 0.f;
#pragma unroll
                for (int q = 0; q < 8; ++q) { const f32x4 t = rp[q]; ss += (t[0] + t[1]) + (t[2] + t[3]); }
                const float sc = __builtin_amdgcn_rsqf(ss * inv_n + eps);
                if (u.pn == 0 && wc == 0 && fq == 0) rstd_out[row] = sc;
#pragma unroll
                for (int bj = 0; bj < 2; ++bj) { const f32x4 v0 = acc[ai][bj][m][0] * sc, v1 = acc[ai][bj][m][1] * sc;
                    u32x4 w; w.x = cvt_pk_bf16(v0[0], v0[1]); w.y = cvt_pk_bf16(v0[2], v0[3]); w.z = cvt_pk_bf16(v1[0], v1[1]); w.w = cvt_pk_bf16(v1[2], v1[3]);
                    *(u32x4*)(rowp + bj * HALF) = w; } }
    }
};
struct EpiGateF32 {
    static constexpr bool PERM = false, AFTER_DRAIN = false, PAIRED = false;
    bf16_t* C; const bf16_t* Z; int ldc;
    __device__ __forceinline__ void operator()(const f32x4 (&acc)[2][2][4][2], const Unit& u, int wr, int wc, int fr, int fq) const {
        const int row0 = u.pm * BM + wr * 64 + fr, col0 = u.pn * BM + wc * 32 + 4 * fq;
#pragma unroll
        for (int ai = 0; ai < 2; ++ai)
#pragma unroll
            for (int m = 0; m < 4; ++m) { const size_t off = (size_t)(row0 + ai * HALF + m * 16) * ldc + col0;
#pragma unroll
                for (int bj = 0; bj < 2; ++bj)
#pragma unroll
                    for (int n = 0; n < 2; ++n) { const u32x2 z = *(const u32x2*)(Z + off + bj * HALF + n * 16);
                        const f32x4 g = (f32x4){sigmoidf_(bf_lo(z.x)), sigmoidf_(bf_hi(z.x)), sigmoidf_(bf_lo(z.y)), sigmoidf_(bf_hi(z.y))};
                        const f32x4 t = acc[ai][bj][m][n] * g; u32x2 w; w.x = cvt_pk_bf16(t[0], t[1]); w.y = cvt_pk_bf16(t[2], t[3]); *(u32x2*)(C + off + bj * HALF + n * 16) = w; } }
    }
};
struct EpiMerge {
    static constexpr bool PERM = false, AFTER_DRAIN = false, PAIRED = false;
    const bf16_t* T1; const bf16_t* Z; bf16_t* O; int ldc;
    __device__ __forceinline__ void operator()(const f32x4 (&acc)[2][2][4][2], const Unit& u, int wr, int wc, int fr, int fq) const {
        const int row0 = u.pm * BM + wr * 64 + fr, col0 = u.pn * BM + wc * 32 + 4 * fq;
#pragma unroll
        for (int ai = 0; ai < 2; ++ai)
#pragma unroll
            for (int m = 0; m < 4; ++m) { const size_t off = (size_t)(row0 + ai * HALF + m * 16) * ldc + col0;
#pragma unroll
                for (int bj = 0; bj < 2; ++bj)
#pragma unroll
                    for (int n = 0; n < 2; ++n) { const u32x2 z = *(const u32x2*)(Z + off + bj * HALF + n * 16); const u32x2 tw = *(const u32x2*)(T1 + off + bj * HALF + n * 16); const f32x4 t1 = (f32x4){bf_lo(tw.x), bf_hi(tw.x), bf_lo(tw.y), bf_hi(tw.y)};
                        const f32x4 g = (f32x4){sigmoidf_(bf_lo(z.x)), sigmoidf_(bf_hi(z.x)), sigmoidf_(bf_lo(z.y)), sigmoidf_(bf_hi(z.y))};
                        const f32x4 o = t1 + acc[ai][bj][m][n] * g; u32x2 w; w.x = cvt_pk_bf16(o[0], o[1]); w.y = cvt_pk_bf16(o[2], o[3]);
                        *(u32x2*)(O + off + bj * HALF + n * 16) = w; } }
    }
};
struct EpiPairGate {
    static constexpr bool PERM = false, AFTER_DRAIN = false, PAIRED = true;
    const bf16_t* ZA; const bf16_t* ZB; bf16_t* O; int ldc;
    __device__ __forceinline__ void mid(f32x4 (&acc)[2][2][4][2], const Unit& u, int wr, int wc, int fr, int fq) const {
        const int row0 = u.pm * BM + wr * 64 + fr, col0 = u.pn * BM + wc * 32 + 4 * fq;
#pragma unroll
        for (int ai = 0; ai < 2; ++ai)
#pragma unroll
            for (int m = 0; m < 4; ++m) { const size_t off = (size_t)(row0 + ai * HALF + m * 16) * ldc + col0;
#pragma unroll
                for (int bj = 0; bj < 2; ++bj)
#pragma unroll
                    for (int n = 0; n < 2; ++n) { const u32x2 za = *(const u32x2*)(ZA + off + bj * HALF + n * 16), zb = *(const u32x2*)(ZB + off + bj * HALF + n * 16);
                        const f32x4 ra = (f32x4){sigmoidf_(bf_lo(za.x)), sigmoidf_(bf_hi(za.x)), sigmoidf_(bf_lo(za.y)), sigmoidf_(bf_hi(za.y))};
                        const f32x4 ib = (f32x4){1.0f + __expf(-fmaxf(bf_lo(zb.x), -30.f)), 1.0f + __expf(-fmaxf(bf_hi(zb.x), -30.f)), 1.0f + __expf(-fmaxf(bf_lo(zb.y), -30.f)), 1.0f + __expf(-fmaxf(bf_hi(zb.y), -30.f))};
                        acc[ai][bj][m][n] = acc[ai][bj][m][n] * ra * ib; } }
    }
    __device__ __forceinline__ void operator()(const f32x4 (&acc)[2][2][4][2], const Unit& u, int wr, int wc, int fr, int fq) const {
        const int row0 = u.pm * BM + wr * 64 + fr, col0 = u.pn * BM + wc * 32 + 4 * fq;
#pragma unroll
        for (int ai = 0; ai < 2; ++ai)
#pragma unroll
            for (int m = 0; m < 4; ++m) { const size_t off = (size_t)(row0 + ai * HALF + m * 16) * ldc + col0;
#pragma unroll
                for (int bj = 0; bj < 2; ++bj)
#pragma unroll
                    for (int n = 0; n < 2; ++n) { const u32x2 zb = *(const u32x2*)(ZB + off + bj * HALF + n * 16);
                        const f32x4 g = (f32x4){sigmoidf_(fmaxf(bf_lo(zb.x), -30.f)), sigmoidf_(fmaxf(bf_hi(zb.x), -30.f)), sigmoidf_(fmaxf(bf_lo(zb.y), -30.f)), sigmoidf_(fmaxf(bf_hi(zb.y), -30.f))};
                        const f32x4 o = acc[ai][bj][m][n] * g; u32x2 w; w.x = cvt_pk_bf16(o[0], o[1]); w.y = cvt_pk_bf16(o[2], o[3]);
                        *(u32x2*)(O + off + bj * HALF + n * 16) = w; } }
    }
};
struct EpiResid {
    static constexpr bool PERM = false, AFTER_DRAIN = false, PAIRED = false;
    const float* X; float* H2; bf16_t* H2B; float* rsp; int ldc;
    __device__ __forceinline__ void operator()(const f32x4 (&acc)[2][2][4][2], const Unit& u, int wr, int wc, int fr, int fq) const {
        const int row0 = u.pm * BM + wr * 64 + fr, col0 = u.pn * BM + wc * 32 + 4 * fq;
#pragma unroll
        for (int ai = 0; ai < 2; ++ai)
#pragma unroll
            for (int m = 0; m < 4; ++m) { const int row = row0 + ai * HALF + m * 16; const size_t off = (size_t)row * ldc + col0; float ss = 0.f;
#pragma unroll
                for (int bj = 0; bj < 2; ++bj)
#pragma unroll
                    for (int n = 0; n < 2; ++n) { const f32x4 x = *(const f32x4*)(X + off + bj * HALF + n * 16); const f32x4 o = x + acc[ai][bj][m][n];
                        ss += (o[0] * o[0] + o[1] * o[1]) + (o[2] * o[2] + o[3] * o[3]);
                        u32x2 w; w.x = cvt_pk_bf16(o[0], o[1]); w.y = cvt_pk_bf16(o[2], o[3]); *(u32x2*)(H2B + off + bj * HALF + n * 16) = w; }
                ss += __shfl_xor(ss, 16); ss += __shfl_xor(ss, 32);
                if (fq == 0) rsp[(size_t)row * 32 + 4 * u.pn + wc] = ss; }
    }
};

template <class Epi, class Sched, bool ALIGN_EPI = false, bool SP2 = false>
__device__ __forceinline__ void gemm_phase(PG8_LAS unsigned char* lds, const Gemm g, const Sched& S, const Epi& E, const int wid) {
    const int lane = lane_now_pg8(), tid = wid * 64 + lane, wr = wid >> 2, wc = wid & 3, fr = lane & 15, fq = lane >> 4;
    const int K = g.K, nt = K / BK;
    unsigned voffA[2], voffB[2];
#pragma unroll
    for (int i = 0; i < 2; ++i) { int R, C; stage_rc(tid * 16 + i * 8192, R, C); const int Rb = Epi::PERM ? ((R & ~31) + perm32(R & 31)) : R;
        voffA[i] = (unsigned)(R * K + C) * 2u; voffB[i] = (unsigned)(Rb * K + C) * 2u; }
    const size_t kstep = (size_t)(BK * 2);
    const size_t hstep = (size_t)HALF * K * 2;
    const size_t tstep = 2 * hstep;
    const unsigned ldsw = (unsigned)wid * 1024u;
    const int aoff = lds_byte(wr * 64 + fr, fq * 8), boff = lds_byte(wc * 32 + fr, fq * 8);
#define PG8_SA(b, h) (((b) * 2 + (h)) * HTB)
#define PG8_SB(b, h) ((4 + (b) * 2 + (h)) * HTB)
#define PG8_STAGE(bufoff, gbase, voff) do { _Pragma("unroll") for (int _i = 0; _i < 2; ++_i) \
        __builtin_amdgcn_global_load_lds((const unsigned*)((const char*)(gbase) + (voff)[_i]), (PG8_LAS unsigned*)(lds + (bufoff) + ldsw + _i * 8192), 16, 0, 0); } while (0)
#define PG8_LDA(dst, b, h) do { _Pragma("unroll") for (int m = 0; m < 4; ++m) _Pragma("unroll") for (int k = 0; k < 2; ++k) dst[m][k] = *(const PG8_LAS bf16x8*)(lds + PG8_SA(b, h) + aoff + m * 2048 + k * 1024); } while (0)
#define PG8_LDB(dst, b, h) do { _Pragma("unroll") for (int n = 0; n < 2; ++n) _Pragma("unroll") for (int k = 0; k < 2; ++k) dst[n][k] = *(const PG8_LAS bf16x8*)(lds + PG8_SB(b, h) + boff + n * 2048 + k * 1024); } while (0)
#define PG8_MMA(ai, bj, At, Bt) do { __builtin_amdgcn_s_setprio(1); _Pragma("unroll") for (int m = 0; m < 4; ++m) _Pragma("unroll") for (int n = 0; n < 2; ++n) _Pragma("unroll") for (int k = 0; k < 2; ++k) \
        acc[ai][bj][m][n] = __builtin_amdgcn_mfma_f32_16x16x32_bf16(Bt[n][k], At[m][k], acc[ai][bj][m][n], 0, 0, 0); __builtin_amdgcn_s_setprio(0); } while (0)
#define PG8_WAIT_V(n) asm volatile("s_waitcnt vmcnt(" #n ")" ::: "memory")
#define PG8_WAIT_L(n) asm volatile("s_waitcnt lgkmcnt(" #n ")" ::: "memory")
#define PG8_BAR __builtin_amdgcn_s_barrier()
#define PG8_SCHED __builtin_amdgcn_sched_barrier(0)
    Unit cur, nxt; int ui = 0;
    if (!S.next(0, cur)) return;
    f32x4 acc[2][2][4][2];
#pragma unroll
    for (int a = 0; a < 2; ++a)
#pragma unroll
        for (int b = 0; b < 2; ++b)
#pragma unroll
            for (int m = 0; m < 4; ++m)
#pragma unroll
                for (int n = 0; n < 2; ++n) acc[a][b][m][n] = (f32x4){0.f, 0.f, 0.f, 0.f};
    bf16x8 At[4][2], B0[2][2], B1[2][2];
    const char* cA = (const char*)(cur.seg ? g.A2 : g.A) + (size_t)cur.pm * tstep; const char* cB = (const char*)(cur.seg ? g.Bt2 : g.Bt) + (size_t)cur.pn * tstep;
    S.a_ready(cur);
    if constexpr (SP2) {
        PG8_STAGE(PG8_SB(0, 0), cB, voffB); PG8_STAGE(PG8_SB(0, 1), cB + hstep, voffB); PG8_STAGE(PG8_SA(0, 0), cA, voffA); PG8_STAGE(PG8_SA(0, 1), cA + hstep, voffA);
        if (wr == 1) PG8_BAR;
        PG8_WAIT_V(2); PG8_BAR;
        PG8_STAGE(PG8_SB(1, 0), cB + kstep, voffB); PG8_STAGE(PG8_SA(1, 0), cA + kstep, voffA); PG8_STAGE(PG8_SB(1, 1), cB + hstep + kstep, voffB);
        PG8_WAIT_V(6); PG8_BAR;
    } else {
        PG8_STAGE(PG8_SB(0, 0), cB, voffB); PG8_STAGE(PG8_SA(0, 0), cA, voffA); PG8_STAGE(PG8_SB(0, 1), cB + hstep, voffB); PG8_STAGE(PG8_SA(0, 1), cA + hstep, voffA);
        if (wr == 1) PG8_BAR;
        PG8_WAIT_V(4); PG8_BAR;
        PG8_STAGE(PG8_SB(1, 0), cB + kstep, voffB); PG8_STAGE(PG8_SA(1, 0), cA + kstep, voffA); PG8_STAGE(PG8_SB(1, 1), cB + hstep + kstep, voffB);
        PG8_WAIT_V(6); PG8_BAR;
    }
    for (;;) {
        const bool has_next = S.next(ui + 1, nxt);
        const char* nA = has_next ? (const char*)(nxt.seg ? g.A2 : g.A) + (size_t)nxt.pm * tstep : cA; const char* nB = has_next ? (const char*)(nxt.seg ? g.Bt2 : g.Bt) + (size_t)nxt.pn * tstep : cB;
        for (int t = 0; t < nt; t += 2) {
            const bool last = (t == nt - 2);
            const char* a1 = cA + (size_t)(t + 1) * kstep;
            const char* a2 = last ? nA : cA + (size_t)(t + 2) * kstep; const char* b2 = last ? nB : cB + (size_t)(t + 2) * kstep;
            const char* a3 = a2 + kstep; const char* b3 = b2 + kstep;
            if (last && has_next) S.a_ready(nxt);
            if constexpr (SP2) {
            PG8_LDB(B0, 0, 0); PG8_LDB(B1, 0, 1); PG8_SCHED; PG8_LDA(At, 0, 0); PG8_STAGE(PG8_SA(1, 1), a1 + hstep, voffA);
            PG8_WAIT_V(8); PG8_WAIT_L(0); PG8_BAR; PG8_MMA(0, 0, At, B0); PG8_MMA(0, 1, At, B1); PG8_BAR; PG8_SCHED;
            PG8_LDA(At, 0, 1); PG8_STAGE(PG8_SB(0, 0), b2, voffB); PG8_STAGE(PG8_SB(0, 1), b2 + hstep, voffB); PG8_STAGE(PG8_SA(0, 0), a2, voffA);
            PG8_WAIT_V(8); PG8_WAIT_L(0); PG8_BAR; PG8_MMA(1, 0, At, B0); PG8_MMA(1, 1, At, B1); PG8_BAR; PG8_SCHED;
            PG8_LDB(B0, 1, 0); PG8_LDB(B1, 1, 1); PG8_SCHED; PG8_LDA(At, 1, 0); PG8_STAGE(PG8_SA(0, 1), a2 + hstep, voffA);
            PG8_WAIT_V(8); PG8_WAIT_L(0); PG8_BAR; PG8_MMA(0, 0, At, B0); PG8_MMA(0, 1, At, B1); PG8_BAR; PG8_SCHED;
            PG8_LDA(At, 1, 1); PG8_STAGE(PG8_SB(1, 0), b3, voffB); PG8_STAGE(PG8_SB(1, 1), b3 + hstep, voffB); PG8_STAGE(PG8_SA(1, 0), a3, voffA);
            PG8_WAIT_V(8); PG8_WAIT_L(0); PG8_BAR; PG8_MMA(1, 0, At, B0); PG8_MMA(1, 1, At, B1); PG8_BAR; PG8_SCHED;
            } else {
            PG8_LDB(B0, 0, 0); PG8_SCHED; PG8_LDA(At, 0, 0); PG8_STAGE(PG8_SA(1, 1), a1 + hstep, voffA);
            PG8_WAIT_L(8); PG8_BAR; PG8_WAIT_L(0); PG8_MMA(0, 0, At, B0); PG8_BAR; PG8_SCHED;
            PG8_LDB(B1, 0, 1); PG8_STAGE(PG8_SB(0, 0), b2, voffB);
            PG8_BAR; PG8_WAIT_L(0); PG8_MMA(0, 1, At, B1); PG8_BAR;
            PG8_LDA(At, 0, 1); PG8_STAGE(PG8_SA(0, 0), a2, voffA);
            PG8_BAR; PG8_WAIT_L(0); PG8_MMA(1, 0, At, B0); PG8_BAR; PG8_SCHED;
            PG8_STAGE(PG8_SB(0, 1), b2 + hstep, voffB);
            PG8_WAIT_V(6); PG8_BAR; PG8_MMA(1, 1, At, B1); PG8_BAR;
            PG8_LDB(B0, 1, 0); PG8_SCHED; PG8_LDA(At, 1, 0); PG8_STAGE(PG8_SA(0, 1), a2 + hstep, voffA);
            PG8_WAIT_L(8); PG8_BAR; PG8_WAIT_L(0); PG8_MMA(0, 0, At, B0); PG8_BAR; PG8_SCHED;
            PG8_LDB(B1, 1, 1); PG8_STAGE(PG8_SB(1, 0), b3, voffB);
            PG8_BAR; PG8_WAIT_L(0); PG8_MMA(0, 1, At, B1); PG8_BAR;
            PG8_LDA(At, 1, 1); PG8_STAGE(PG8_SA(1, 0), a3, voffA);
            PG8_BAR; PG8_WAIT_L(0); PG8_MMA(1, 0, At, B0); PG8_BAR; PG8_SCHED;
            PG8_STAGE(PG8_SB(1, 1), b3 + hstep, voffB);
            PG8_WAIT_V(6); PG8_BAR; PG8_MMA(1, 1, At, B1); PG8_BAR;
            }
        }
        if constexpr (ALIGN_EPI) { if (wr == 0) PG8_BAR; }
        bool keep = false;
        if constexpr (Epi::PAIRED) { if (cur.seg == 0) { E.mid(acc, cur, wr, wc, fr, fq); keep = true; } else E(acc, cur, wr, wc, fr, fq); S.done(cur); }
        else if constexpr (!Epi::AFTER_DRAIN) { E(acc, cur, wr, wc, fr, fq); S.done(cur); }
        if (!has_next) break;
        if (!keep)
#pragma unroll
        for (int a = 0; a < 2; ++a)
#pragma unroll
            for (int b = 0; b < 2; ++b)
#pragma unroll
                for (int m = 0; m < 4; ++m)
#pragma unroll
                    for (int n = 0; n < 2; ++n) acc[a][b][m][n] = (f32x4){0.f, 0.f, 0.f, 0.f};
        cur = nxt; cA = nA; cB = nB; ++ui;
        if constexpr (ALIGN_EPI) { if (wr == 1) PG8_BAR; }
    }
    PG8_WAIT_V(0);
    if constexpr (!ALIGN_EPI) { if (wr == 0) PG8_BAR; }
    PG8_BAR;
    if constexpr (Epi::AFTER_DRAIN) { E.fused(acc, cur, wr, wc, fr, fq, lds, wid, lane); S.done(cur); }
#undef PG8_SA
#undef PG8_SB
#undef PG8_STAGE
#undef PG8_LDA
#undef PG8_LDB
#undef PG8_MMA
#undef PG8_WAIT_V
#undef PG8_WAIT_L
#undef PG8_BAR
#undef PG8_SCHED
}
}


constexpr int NWAVES = 8;
constexpr int DM = 2048, BATCH = 4, SEQ = 4096, M = BATCH * SEQ, NMETA = 16, INW = 16384;
constexpr int NH = 16, HD = 128, CH = 64, NCH = SEQ / CH;
constexpr int PH = 8, NKEY = 128, TOPK = 16, NEXP = NKEY * NKEY, NSEL = PH * TOPK;
constexpr float EPS = 1e-6f;

constexpr size_t MiB = 1u << 20;
constexpr size_t WS_CTL = 0, CTL_ZERO_BYTES = 1 * MiB;
constexpr size_t SLAB_BYTES = (size_t)M * DM * 2;
constexpr size_t WS_SLAB = 1 * MiB;
constexpr size_t WS_WPA = 513 * MiB, WS_WPB = 521 * MiB, WS_WOUT = 529 * MiB, WS_WQ = 537 * MiB;
constexpr size_t WS_KEYS = 545 * MiB, WS_WA = WS_KEYS + 512 * 1024, WS_WX = WS_WA + 512 * 1024;
constexpr size_t WS_METAPROJ = 547 * MiB, WS_XNMETA = WS_METAPROJ + 512 * 1024;
constexpr size_t WS_RGSUM = 548 * MiB;
constexpr size_t WS_RGHIN = 553 * MiB;
constexpr size_t WS_HGDEC = 556 * MiB;
constexpr size_t WS_HGMETA = 559 * MiB;
constexpr size_t WS_RSP = 561 * MiB;
constexpr size_t WS_PSC = 563 * MiB;
constexpr size_t WS_END = 564 * MiB;
constexpr int SL_XA = 0, SL_YA = 1, SL_Q = 2, SL_F = 3, SL_I = 4, SL_OG = 5, SL_ZA = 6, SL_ZB = 7;
constexpr int SL_UB = 0, SL_VB = 2, SL_MIX = 3, SL_H2B = 4, SL_QP = 1, SL_SEL = 5;
constexpr int CW_BAR = 4096;

constexpr int RING_BYTES = 131072;
constexpr int LDS_BYTES = 147456;
constexpr int LDSCTL_OFF = LDS_BYTES - 1024, MISC_OFF = LDSCTL_OFF + 320;

#define LAS __attribute__((address_space(3)))
typedef unsigned short bf16;
typedef unsigned v4u __attribute__((ext_vector_type(4)));
typedef unsigned v2u __attribute__((ext_vector_type(2)));
typedef float f32x4 __attribute__((ext_vector_type(4)));
typedef float f32x2 __attribute__((ext_vector_type(2)));
typedef short bf16x8 __attribute__((ext_vector_type(8)));
#define LDS_WAIT() asm volatile("s_waitcnt lgkmcnt(0)" ::: "memory")
__device__ __forceinline__ int lane_now() { int l; asm volatile("v_mbcnt_lo_u32_b32 %0, -1, 0\n\tv_mbcnt_hi_u32_b32 %0, -1, %0" : "=v"(l)); return l; }
#define VM_WAIT() asm volatile("s_waitcnt vmcnt(0)" ::: "memory")
__device__ __forceinline__ unsigned f2bf(float f) { unsigned u = __builtin_bit_cast(unsigned, f); return (u + 0x7fffu + ((u >> 16) & 1u)) >> 16; }
__device__ __forceinline__ unsigned pk2(float lo, float hi) { unsigned r; asm("v_cvt_pk_bf16_f32 %0, %1, %2" : "=v"(r) : "v"(lo), "v"(hi)); return r; }
__device__ __forceinline__ float bflo(unsigned w) { return __uint_as_float(w << 16); }
__device__ __forceinline__ float bfhi(unsigned w) { return __uint_as_float(w & 0xffff0000u); }
__device__ __forceinline__ float bf1(bf16 h) { return __uint_as_float(((unsigned)h) << 16); }
__device__ __forceinline__ float sigm(float x) { return __builtin_amdgcn_rcpf(1.0f + __builtin_amdgcn_exp2f(-1.44269504f * x)); }
__device__ __forceinline__ float gelu1(float v) { pg8::f32x2 t; t.x = v; t.y = 0.f; t = pg8::gelu_pk(t); return t.x; }

#define XB_TMO      128
#define XB_XCNT(j)  (256  + 64 * (j))
#define XB_XSUB(j)  (1280 + 64 * (j))
#define XB_XGEN(j)  (2304 + 64 * (j))
#define XB_TOP      3328
#define XB_TOPGEN   3392
#define XCD_BAR_WORDS 3456
#define XB_SPIN_CAP (1u << 18)
__device__ __forceinline__ unsigned xb_ld(unsigned* p)              { return __hip_atomic_load(p, __ATOMIC_RELAXED, __HIP_MEMORY_SCOPE_AGENT); }
__device__ __forceinline__ unsigned xb_add(unsigned* p, unsigned v) { return __hip_atomic_fetch_add(p, v, __ATOMIC_RELAXED, __HIP_MEMORY_SCOPE_AGENT); }
__device__ __forceinline__ unsigned xb_xcc_id() { return (unsigned)__builtin_amdgcn_s_getreg((3 << 11) | 20) & 0xFu; }
#define XB_SPIN(cond, bar) do { unsigned _sp = 0; while (cond) { __builtin_amdgcn_s_sleep(1); \
    if ((++_sp & 255u) == 0u) { if (xb_ld(&(bar)[XB_TMO])) break; if (_sp > XB_SPIN_CAP) { atomicAdd(&(bar)[XB_TMO], 1u); break; } } } } while (0)
struct XcdBarrier { unsigned* bar; unsigned x; volatile LAS unsigned* st; int wave; };
__device__ __forceinline__ XcdBarrier xcd_barrier_post(unsigned* bar, volatile LAS unsigned* st) {
    XcdBarrier b; b.bar = bar; b.x = xb_xcc_id(); b.st = st; b.wave = __builtin_amdgcn_readfirstlane((int)threadIdx.x >> 6);
    if (threadIdx.x == 0) (void)xb_add(&bar[XB_XCNT(b.x)], 1u);
    return b;
}
__device__ __forceinline__ void xcd_barrier_complete(unsigned* bar, unsigned x, unsigned& nloc, unsigned& nx) {
    const unsigned G = gridDim.x * gridDim.y * gridDim.z;
    unsigned sum, cnt, mine, sp = 0u;
    for (;;) {
        sum = 0u; cnt = 0u; mine = 0u;
#pragma unroll
        for (unsigned j = 0; j < 16; ++j) { const unsigned c = xb_ld(&bar[XB_XCNT(j)]); sum += c; cnt += (c > 0u) ? 1u : 0u; mine = (j == x) ? c : mine; }
        if (sum == G) break;
        __builtin_amdgcn_s_sleep(1);
        if ((++sp & 255u) == 0u) { if (xb_ld(&bar[XB_TMO])) break; if (sp > XB_SPIN_CAP) { atomicAdd(&bar[XB_TMO], 1u); break; } }
    }
    nloc = mine > 0u ? mine : 1u; nx = cnt > 0u ? cnt : 1u;
}
__device__ __forceinline__ void xcd_barrier(const XcdBarrier& b) {
    asm volatile("s_waitcnt vmcnt(0)" ::: "memory");
    __syncthreads();
    if (b.wave == 0 && lane_now() == 0) {
        unsigned* bar = b.bar;
        __builtin_amdgcn_s_waitcnt(0);
        unsigned nloc = b.st[0], nx = b.st[1];
        if (nloc == 0u) { xcd_barrier_complete(bar, b.x, nloc, nx); b.st[0] = nloc; b.st[1] = nx; }
        const unsigned old = xb_add(&bar[XB_XSUB(b.x)], 1u);
        const unsigned gen = old / nloc;
        if (old + 1u == (gen + 1u) * nloc) {
            __builtin_amdgcn_fence(__ATOMIC_RELEASE, "agent");
            asm volatile("s_waitcnt vmcnt(0)" ::: "memory");
            const unsigned og = xb_add(&bar[XB_TOP], 1u);
            const unsigned tg = og / nx;
            if (og + 1u == (tg + 1u) * nx) xb_add(&bar[XB_TOPGEN], 1u);
            else XB_SPIN(xb_ld(&bar[XB_TOPGEN]) == tg, bar);
            __builtin_amdgcn_fence(__ATOMIC_ACQUIRE, "agent");
            xb_add(&bar[XB_XGEN(b.x)], 1u);
            asm volatile("s_waitcnt vmcnt(0)" ::: "memory");
        } else {
            XB_SPIN(xb_ld(&bar[XB_XGEN(b.x)]) == gen, bar);
            __builtin_amdgcn_fence(__ATOMIC_ACQUIRE, "agent");
            asm volatile("s_waitcnt vmcnt(0)" ::: "memory");
        }
    }
    __syncthreads();
}

struct Args { const float* in[22]; float* out; unsigned char* ws; };
struct Frame {
    LAS unsigned char* lds;
    volatile LAS unsigned* MISC;
    int wave, vcu, G;
};
#define IN_(k) (args.in[k])
#define A_x IN_(0)
#define A_meta IN_(1)
#define A_ln1_g IN_(2)
#define A_w_in IN_(3)
#define A_conv_w IN_(4)
#define A_conv_b IN_(5)
#define A_rg_wa IN_(6)
#define A_rg_ba IN_(7)
#define A_rg_wx IN_(8)
#define A_rg_bx IN_(9)
#define A_rg_lambda IN_(10)
#define A_hg_lb IN_(11)
#define A_hg_norm_g IN_(12)
#define A_w_pa IN_(13)
#define A_w_pb IN_(14)
#define A_w_out IN_(15)
#define A_ln2_g IN_(16)
#define A_peer_wq IN_(17)
#define A_peer_keys IN_(18)
#define A_peer_u IN_(19)
#define A_peer_v IN_(20)
#define A_final_g IN_(21)
#define A_out (args.out)
#define W_SLAB(i) ((bf16*)(args.ws + WS_SLAB + (size_t)(i) * SLAB_BYTES))
#define W_WinT ((bf16*)args.out)
#define W_XN ((bf16*)args.out + (size_t)INW * DM)
#define W_WpaT ((bf16*)(args.ws + WS_WPA))
#define W_WpbT ((bf16*)(args.ws + WS_WPB))
#define W_WoutT ((bf16*)(args.ws + WS_WOUT))
#define W_WqT ((bf16*)(args.ws + WS_WQ))
#define W_KEYS ((bf16*)(args.ws + WS_KEYS))
#define W_WAT ((bf16*)(args.ws + WS_WA))
#define W_WXT ((bf16*)(args.ws + WS_WX))
#define W_METAPROJ ((bf16*)(args.ws + WS_METAPROJ))
#define W_XNMETA ((bf16*)(args.ws + WS_XNMETA))
#define W_RGSUM ((float*)(args.ws + WS_RGSUM))
#define W_RGHIN ((float*)(args.ws + WS_RGHIN))
#define W_HGDEC ((float*)(args.ws + WS_HGDEC))
#define W_HGMETA ((float*)(args.ws + WS_HGMETA))
#define W_RSP ((float*)(args.ws + WS_RSP))
#define W_PSC ((float*)(args.ws + WS_PSC))
#define W_RSTD2 ((float*)(args.ws + WS_PSC + 256 * 1024))
__device__ __forceinline__ float wave_sum(float v) {
#pragma unroll
    for (int o = 1; o < 64; o <<= 1) v += __shfl_xor(v, o);
    return v;
}
__device__ __forceinline__ float wave_max(float v) {
#pragma unroll
    for (int o = 1; o < 64; o <<= 1) v = fmaxf(v, __shfl_xor(v, o));
    return v;
}
__device__ __forceinline__ f32x4 mma16(f32x4 acc, const LAS unsigned char* a, int lda, const LAS unsigned char* b, int ldb, int K, int lane) {
    const int r = lane & 15, g = lane >> 4;
    const LAS unsigned char* ap = a + r * lda + g * 16; const LAS unsigned char* bp = b + r * ldb + g * 16;
    for (int k0 = 0; k0 < K; k0 += 32) {
        const bf16x8 av = *(const LAS bf16x8*)(ap + k0 * 2); const bf16x8 bv = *(const LAS bf16x8*)(bp + k0 * 2);
        acc = __builtin_amdgcn_mfma_f32_16x16x32_bf16(av, bv, acc, 0, 0, 0);
    }
    return acc;
}
__device__ __forceinline__ void p0_transpose_item(const float* W, int K, int N, bf16* WT, LAS float* scr, int item, int lane, const float* rs) {
    const int nblk = N / 32, kb = item / nblk, nb = item % nblk, k0 = 64 * kb, n0 = 32 * nb;
#pragma unroll 8
    for (int i = 0; i < 32; ++i) { const int kk = 2 * i + (lane >> 5); float w = W[(size_t)(k0 + kk) * N + n0 + (lane & 31)]; if (rs) w *= rs[k0 + kk]; scr[kk * 33 + (lane & 31)] = w; }
    LDS_WAIT(); asm volatile("" ::: "memory");
    const int c = lane & 7;
#pragma unroll
    for (int j = 0; j < 4; ++j) { const int n = (lane >> 3) + 8 * j; const LAS float* s = scr + (8 * c) * 33 + n;
        v4u o; o.x = pk2(s[0 * 33], s[1 * 33]); o.y = pk2(s[2 * 33], s[3 * 33]); o.z = pk2(s[4 * 33], s[5 * 33]); o.w = pk2(s[6 * 33], s[7 * 33]);
        *(v4u*)(WT + (size_t)(n0 + n) * K + k0 + 8 * c) = o; }
    LDS_WAIT(); asm volatile("" ::: "memory");
}
__device__ __forceinline__ void rms_row_to_bf16(const float* xrow, const float* g, bf16* orow, int lane) {
    const f32x4* xr = (const f32x4*)xrow + lane; const f32x4* gr = (const f32x4*)g + lane;
    f32x4 v[8]; float s = 0.f;
#pragma unroll
    for (int j = 0; j < 8; ++j) { v[j] = xr[64 * j]; s += (v[j].x * v[j].x + v[j].y * v[j].y) + (v[j].z * v[j].z + v[j].w * v[j].w); }
    const float rstd = 1.0f / sqrtf(wave_sum(s) * (1.f / DM) + EPS);
    unsigned long long* o8 = (unsigned long long*)orow + lane;
#pragma unroll
    for (int j = 0; j < 8; ++j) { const f32x4 gg = gr[64 * j];
        o8[64 * j] = (unsigned long long)pk2(v[j].x * rstd * gg.x, v[j].y * rstd * gg.y) | ((unsigned long long)pk2(v[j].z * rstd * gg.z, v[j].w * rstd * gg.w) << 32); }
}
__device__ __forceinline__ void p0_prologue(Frame& F, const Args& args) {
    const int lane_ = lane_now(), tid_ = F.wave * 64 + lane_; (void)tid_;
    LAS float* scr = (LAS float*)(F.lds + F.wave * 16384);
    const int gw = F.vcu * NWAVES + F.wave, NGW = F.G * NWAVES;
    constexpr int I_IN = (DM / 64) * (INW / 32), I_SQ = (DM / 64) * (DM / 32), I_G = 16 * (HD / 64) * (HD / 32);
    constexpr int NITEMS = I_IN + 4 * I_SQ + 2 * I_G;
    for (int it = gw; it < NITEMS; it += NGW) {
        int r = it;
        if (r < I_IN) { p0_transpose_item(A_w_in, DM, INW, W_WinT, scr, r, lane_, nullptr); continue; } r -= I_IN;
        if (r < I_SQ) { p0_transpose_item(A_w_pa, DM, DM, W_WpaT, scr, r, lane_, nullptr); continue; } r -= I_SQ;
        if (r < I_SQ) { p0_transpose_item(A_w_pb, DM, DM, W_WpbT, scr, r, lane_, nullptr); continue; } r -= I_SQ;
        if (r < I_SQ) { p0_transpose_item(A_w_out, DM, DM, W_WoutT, scr, r, lane_, nullptr); continue; } r -= I_SQ;
        if (r < I_SQ) { p0_transpose_item(A_peer_wq, DM, DM, W_WqT, scr, r, lane_, A_ln2_g); continue; } r -= I_SQ;
        if (r < I_G) { const int h = r / 8; p0_transpose_item(A_rg_wa + (size_t)h * HD * HD, HD, HD, W_WAT + (size_t)h * HD * HD, scr, r % 8, lane_, nullptr); continue; } r -= I_G;
        { const int h = r / 8; p0_transpose_item(A_rg_wx + (size_t)h * HD * HD, HD, HD, W_WXT + (size_t)h * HD * HD, scr, r % 8, lane_, nullptr); }
    }
    for (int m = gw; m < M + NMETA; m += NGW) {
        if (m < M) rms_row_to_bf16(A_x + (size_t)m * DM, A_ln1_g, W_XN + (size_t)m * DM, lane_);
        else rms_row_to_bf16(A_meta + (size_t)(m - M) * DM, A_ln1_g, W_XNMETA + (size_t)(m - M) * DM, lane_);
    }
    for (int i = (F.vcu * NWAVES * 64 + tid_); i < PH * 2 * NKEY * 128 / 2; i += F.G * NWAVES * 64) {
        const f32x2 k2 = ((const f32x2*)A_peer_keys)[i]; ((unsigned*)W_KEYS)[i] = pk2(k2.x, k2.y); }
}

__device__ __forceinline__ void p1_meta(Frame& F, const Args& args) {
    const int lane_ = lane_now(), tid_ = F.wave * 64 + lane_; (void)tid_;
    const int gw = F.vcu * NWAVES + F.wave, NGW = F.G * NWAVES, r = lane_ & 15, g = lane_ >> 4;
    for (int it = gw; it < INW / 16; it += NGW) {
        const int n0 = it * 16;
        const bf16* ap = W_XNMETA + (size_t)r * DM + 8 * g; const bf16* bp = W_WinT + (size_t)(n0 + r) * DM + 8 * g;
        f32x4 acc = (f32x4){0.f, 0.f, 0.f, 0.f};
#pragma unroll 16
        for (int k0 = 0; k0 < DM; k0 += 32) { const bf16x8 a = *(const bf16x8*)(ap + k0); const bf16x8 b = *(const bf16x8*)(bp + k0); acc = __builtin_amdgcn_mfma_f32_16x16x32_bf16(a, b, acc, 0, 0, 0); }
#pragma unroll
        for (int j = 0; j < 4; ++j) W_METAPROJ[(size_t)(4 * g + j) * INW + n0 + r] = (bf16)f2bf(acc[j]);
    }
}

template <int MODE, bool DUMMY, int VAR = 0>
__device__ __forceinline__ void rg_wave_item(const Args& args, const LAS unsigned char* WAl, const LAS unsigned char* WXl, LAS unsigned char* YL, const LAS float* CST, int h, int b, int c, bool meta, int lane) {
    const int r = lane & 15, g = lane >> 4;
    const int nhalf = meta ? 1 : 2, ntile = meta ? 1 : 2;
    bf16x8 SEL0, SEL1;
#pragma unroll
    for (int j = 0; j < 8; ++j) { SEL0[j] = (8 * g + j == r) ? (short)0x3F80 : (short)0; SEL1[j] = (8 * g + j == 16 + r) ? (short)0x3F80 : (short)0; }
    float hc[8], pt[8];
#pragma unroll
    for (int ct = 0; ct < 8; ++ct) { hc[ct] = (MODE == 1) ? W_RGHIN[(size_t)(b * NCH + c) * DM + h * HD + 16 * ct + r] : 0.f; pt[ct] = 1.f; }
#pragma unroll 1
    for (int hf = 0; hf < nhalf; ++hf) {
        v4u yr[8];
        if (MODE == 1) {
#pragma unroll
            for (int i = 0; i < 8; ++i) yr[i] = *(const v4u*)(W_SLAB(SL_YA) + (size_t)(b * SEQ + c * CH + 32 * hf + 4 * i + (lane >> 4)) * DM + h * HD + 8 * (lane & 15));
        }
        bf16x8 A[2][4];
#pragma unroll
        for (int ks = 0; ks < 4; ++ks) {
            const int ch0 = h * HD + 32 * ks + 8 * g;
            f32x4 wk[4][2], cb[2];
#pragma unroll
            for (int k = 0; k < 4; ++k) { wk[k][0] = *(const f32x4*)(A_conv_w + (size_t)k * DM + ch0); wk[k][1] = *(const f32x4*)(A_conv_w + (size_t)k * DM + ch0 + 4); }
            cb[0] = *(const f32x4*)(A_conv_b + ch0); cb[1] = *(const f32x4*)(A_conv_b + ch0 + 4);
#pragma unroll
            for (int rt = 0; rt < 2; ++rt) {
                if (rt < ntile) {
                    const int t = 32 * hf + 16 * rt + r;
                    f32x4 a0 = cb[0], a1 = cb[1];
#pragma unroll
                    for (int k = 0; k < 4; ++k) {
                        const bf16* rowp; bool valid = true;
                        if (meta) { const int s = t + k - 3; valid = s >= 0; rowp = W_METAPROJ + (size_t)(valid ? s : 0) * INW; }
                        else { const int s = c * CH + t + k - 3; rowp = (s >= 0) ? W_SLAB(SL_XA) + (size_t)(b * SEQ + s) * DM : W_METAPROJ + (size_t)(NMETA + s) * INW; }
                        v4u xw = (VAR == 1) ? (v4u){(unsigned)t, (unsigned)k, 0x3f803f80u, 0x3f803f80u} : *(const v4u*)(rowp + ch0);
                        if (!valid) xw = (v4u){0u, 0u, 0u, 0u};
                        a0 += wk[k][0] * (f32x4){bflo(xw.x), bfhi(xw.x), bflo(xw.y), bfhi(xw.y)};
                        a1 += wk[k][1] * (f32x4){bflo(xw.z), bfhi(xw.z), bflo(xw.w), bfhi(xw.w)};
                    }
                    v4u pk; pk.x = pk2(a0[0], a0[1]); pk.y = pk2(a0[2], a0[3]); pk.z = pk2(a1[0], a1[1]); pk.w = pk2(a1[2], a1[3]);
                    A[rt][ks] = __builtin_bit_cast(bf16x8, pk);
                } else A[rt][ks] = (bf16x8){0, 0, 0, 0, 0, 0, 0, 0};
            }
            __builtin_amdgcn_sched_barrier(0);
        }
        if (MODE == 1) {
#pragma unroll
            for (int i = 0; i < 8; ++i) { v4u gw;
#pragma unroll
                for (int w = 0; w < 4; ++w) { const pg8::f32x2 gl = pg8::gelu_pk((pg8::f32x2){bflo(yr[i][w]), bfhi(yr[i][w])}); gw[w] = pk2(gl.x, gl.y); }
                *(LAS v4u*)(YL + (4 * i + (lane >> 4)) * 272 + 16 * (lane & 15)) = gw; }
        }
#pragma unroll
        for (int ct = 0; ct < 8; ++ct) {
            const int col = h * HD + 16 * ct + r;
            const float ba = CST[16 * ct + r], bx = CST[128 + 16 * ct + r], sp2 = CST[256 + 16 * ct + r];
            bf16x8 wa[4], wx[4];
#pragma unroll
            for (int ks = 0; ks < 4; ++ks) { wa[ks] = *(const LAS bf16x8*)(WAl + (16 * ct + r) * 272 + ks * 64 + g * 16); wx[ks] = *(const LAS bf16x8*)(WXl + (16 * ct + r) * 272 + ks * 64 + g * 16); }
#pragma unroll
            for (int rt = 0; rt < 2; ++rt) {
                if (rt < ntile) {
                    f32x4 R = (f32x4){0.f, 0.f, 0.f, 0.f}, I = R, XC = R;
#pragma unroll
                    for (int ks = 0; ks < 4; ++ks) { if (VAR == 4 && ks > 0) continue; R = __builtin_amdgcn_mfma_f32_16x16x32_bf16(A[rt][ks], wa[ks], R, 0, 0, 0); I = __builtin_amdgcn_mfma_f32_16x16x32_bf16(A[rt][ks], wx[ks], I, 0, 0, 0); }
                    XC = __builtin_amdgcn_mfma_f32_16x16x32_bf16(A[rt][ct >> 1], (ct & 1) ? SEL1 : SEL0, XC, 0, 0, 0);
                    float av[4], uv[4];
#pragma unroll
                    for (int j = 0; j < 4; ++j) {
                        const float rr = sigm(R[j] + ba), ii = sigm(I[j] + bx);
                        av[j] = __builtin_amdgcn_exp2f(sp2 * rr); uv[j] = __builtin_amdgcn_sqrtf((1.0f - av[j]) * (1.0f + av[j])) * ii * XC[j]; }
                    const float P = (av[0] * av[1]) * (av[2] * av[3]);
                    const float U = ((uv[0] * av[1] + uv[1]) * av[2] + uv[2]) * av[3] + uv[3];
                    const float P0 = (VAR == 2) ? P : __shfl(P, r), P1 = (VAR == 2) ? P : __shfl(P, r + 16), P2 = (VAR == 2) ? P : __shfl(P, r + 32), P3 = (VAR == 2) ? P : __shfl(P, r + 48);
                    const float U0 = (VAR == 2) ? U : __shfl(U, r), U1 = (VAR == 2) ? U : __shfl(U, r + 16), U2 = (VAR == 2) ? U : __shfl(U, r + 32), U3 = (VAR == 2) ? U : __shfl(U, r + 48);
                    const float h0 = hc[ct], h1 = P0 * h0 + U0, h2 = P1 * h1 + U1, h3 = P2 * h2 + U2, he = P3 * h3 + U3;
                    if (MODE == 1) {
                        float hh = (g == 0) ? h0 : (g == 1) ? h1 : (g == 2) ? h2 : h3;
#pragma unroll
                        for (int j = 0; j < 4; j += 2) { const int tl = 16 * rt + 4 * g + j;
                            const float hA = av[j] * hh + uv[j], hB = av[j + 1] * hA + uv[j + 1]; hh = hB;
                            LAS bf16* yp = (LAS bf16*)(YL + tl * 272 + (16 * ct + r) * 2);
                            const unsigned pw = pk2(bf1(yp[0]) * hA, bf1(yp[136]) * hB);
                            yp[0] = (bf16)(pw & 0xffffu); yp[136] = (bf16)(pw >> 16); }
                    }
                    hc[ct] = he; pt[ct] *= (P0 * P1) * (P2 * P3);
                }
            }
            if (ct & 1) __builtin_amdgcn_sched_barrier(0);
        }
        if (MODE == 1) {
#pragma unroll
            for (int i = 0; i < 8; ++i) { const v4u yv = *(const LAS v4u*)(YL + (4 * i + (lane >> 4)) * 272 + 16 * (lane & 15));
                const size_t eo = (size_t)(b * SEQ + c * CH + 32 * hf + 4 * i + (lane >> 4)) * DM + h * HD + 8 * (lane & 15);
                bf16* yo = DUMMY ? (bf16*)(args.ws + WS_END) + (eo & (size_t)(4 * MiB - 1)) : W_SLAB(SL_YA) + eo;
                *(v4u*)yo = yv; }
        }
    }
    if (MODE == 0 && g == 0) {
#pragma unroll
        for (int ct = 0; ct < 8; ++ct) { const int col = h * HD + 16 * ct + r;
            const size_t o = meta ? ((size_t)BATCH * NCH * DM + col) : ((size_t)(b * NCH + c) * DM + col);
            ((f32x2*)W_RGSUM)[o] = (f32x2){pt[ct], hc[ct]}; }
    }
}
template <int MODE, bool DUMMY = false, int VAR = 0>
__device__ __forceinline__ void rg_phase(Frame& F, const Args& args) {
    const int lane_ = lane_now(), tid_ = F.wave * 64 + lane_; (void)tid_;
    LAS unsigned char* WAl = F.lds;
    LAS unsigned char* WXl = F.lds + 34816;
    LAS unsigned char* YL = F.lds + 69632 + F.wave * 8704;
    LAS float* CST = (LAS float*)(F.lds + 139264);
    const int nit = BATCH * NCH * NH, per = (nit + F.G - 1) / F.G;
    const int it0 = F.vcu * per, it1 = (it0 + per < nit) ? it0 + per : nit;
    for (int seg0 = it0; seg0 < it1;) {
        const int h = seg0 >> 8, hend = (h + 1) << 8, seg1 = hend < it1 ? hend : it1;
        __syncthreads();
        { const v4u* ga = (const v4u*)(W_WAT + (size_t)h * HD * HD); const v4u* gx = (const v4u*)(W_WXT + (size_t)h * HD * HD);
#pragma unroll
          for (int i = 0; i < 4; ++i) { const int p = tid_ + 512 * i, row = p >> 4, c16 = p & 15;
              *(LAS v4u*)(WAl + row * 272 + c16 * 16) = ga[p]; *(LAS v4u*)(WXl + row * 272 + c16 * 16) = gx[p]; } }
        if (tid_ < HD) { const int col = h * HD + tid_; CST[tid_] = A_rg_ba[col]; CST[128 + tid_] = A_rg_bx[col]; CST[256 + tid_] = -8.0f * 1.44269504f * log1pf(__expf(-A_rg_lambda[col])); }
        __syncthreads();
        for (int it = seg0 + F.wave; it < seg1; it += NWAVES) {
            const int bc = it & 255, b = bc >> 6, c = bc & 63;
            if (MODE == 0 && bc == 0) rg_wave_item<MODE, DUMMY, VAR>(args, WAl, WXl, YL, CST, h, 0, 0, true, lane_);
            rg_wave_item<MODE, DUMMY, VAR>(args, WAl, WXl, YL, CST, h, b, c, false, lane_);
        }
        seg0 = seg1;
    }
    __syncthreads();
}
__device__ __forceinline__ void rg_carry(Frame& F, const Args& args) {
    const int lane_ = lane_now(), tid_ = F.wave * 64 + lane_; (void)tid_;
    const int gid = F.vcu * NWAVES * 64 + tid_;
    if (gid < BATCH * DM) {
        const int b = gid >> 11, col = gid & (DM - 1);
        float h = ((const f32x2*)W_RGSUM)[(size_t)BATCH * NCH * DM + col].y;
        for (int c0 = 0; c0 < NCH; c0 += 16) { f32x2 sv[16];
#pragma unroll
            for (int i = 0; i < 16; ++i) sv[i] = ((const f32x2*)W_RGSUM)[(size_t)(b * NCH + c0 + i) * DM + col];
#pragma unroll
            for (int i = 0; i < 16; ++i) { W_RGHIN[(size_t)(b * NCH + c0 + i) * DM + col] = h; h = sv[i].x * h + sv[i].y; } }
    }
}

struct HgRaw { unsigned fw[8], vw[8], qw[8]; v4u stw[4]; v2u ogw[4]; };
template <int MODE>
__device__ __forceinline__ void hg_load(HgRaw& R, const Args& args, const bf16* ST, int it, int tid_, int lane_, int w) {
    const bool meta = it >= BATCH * NH * NCH;
    const int bh = meta ? 0 : (it >> 6), c = meta ? 0 : (it & 63), b = bh >> 4, h = meta ? (it - BATCH * NH * NCH) : (bh & 15);
    const int kp = w * 8 + (lane_ & 7), sg = lane_ >> 3, r = lane_ & 15, g = lane_ >> 4, col = h * HD + 2 * kp;
#pragma unroll
    for (int i = 0; i < 8; ++i) { const int s = 8 * sg + i;
        if (meta) { const bool valid = s < NMETA; const size_t ro = (size_t)(valid ? s : 0) * INW + col;
            const unsigned f = *(const unsigned*)(W_METAPROJ + ro + 3 * DM), v = *(const unsigned*)(W_METAPROJ + ro + 4 * DM); R.fw[i] = valid ? f : 0u; R.vw[i] = valid ? v : 0u; if (MODE == 1) R.qw[i] = 0u; }
        else { const size_t ro = (size_t)(b * SEQ + c * CH + s) * DM + col; R.fw[i] = *(const unsigned*)(W_SLAB(SL_F) + ro); R.vw[i] = *(const unsigned*)(W_SLAB(SL_I) + ro);
               if (MODE == 1) R.qw[i] = *(const unsigned*)(W_SLAB(SL_Q) + ro); } }
    if (MODE == 1) { const v4u* gs = (const v4u*)(ST + ((size_t)(bh * NCH + c)) * HD * HD);
#pragma unroll
        for (int i = 0; i < 4; ++i) R.stw[i] = gs[tid_ + 512 * i];
#pragma unroll
        for (int tt = 0; tt < 4; ++tt) R.ogw[tt] = *(const v2u*)(W_SLAB(SL_OG) + (size_t)(b * SEQ + c * CH + 16 * tt + r) * DM + h * HD + 16 * w + 4 * g); }
}
template <int MODE, bool DUMMY = false>
__device__ __forceinline__ void hg_phase(Frame& F, const Args& args, bf16* ST) {
    const int lane_ = lane_now(), tid_ = F.wave * 64 + lane_; (void)tid_;
    LAS unsigned char* VT = F.lds;
    LAS float* TOT = (LAS float*)(F.lds + 18432);
    LAS unsigned char* KDT = F.lds + 22528;
    LAS unsigned char* QDEC = F.lds + 22528;
    LAS unsigned char* QD2 = F.lds + 39936;
    LAS unsigned char* KD2 = F.lds + 57344;
    LAS unsigned char* STl = F.lds + 74752;
    LAS unsigned char* PB = F.lds + 109568;
    LAS float* SSQ = (LAS float*)(F.lds + 118784);
    const int nit = BATCH * NH * NCH + (MODE == 0 ? NH : 0);
    const int w = F.wave, kp = w * 8 + (lane_ & 7), sg = lane_ >> 3, r = lane_ & 15, g = lane_ >> 4;
    HgRaw cur, nxt;
    if (F.vcu < nit) hg_load<MODE>(cur, args, ST, F.vcu, tid_, lane_, w);
    for (int it = F.vcu; it < nit; it += F.G) {
        const bool meta = it >= BATCH * NH * NCH;
        const int bh = meta ? 0 : (it >> 6), c = meta ? 0 : (it & 63), b = bh >> 4, h = meta ? (it - BATCH * NH * NCH) : (bh & 15);
        const int col = h * HD + 2 * kp;
        __syncthreads();
        float lb0, lb1;
        { const f32x2 l0 = *(const f32x2*)(A_hg_lb + col), l1 = *(const f32x2*)(A_hg_lb + DM + col); lb0 = 1.0f / (1.0f + __expf(l1.x - l0.x)); lb1 = 1.0f / (1.0f + __expf(l1.y - l0.y)); }
        float cs0[8], cs1[8], kk0[8], kk1[8];
        float run0 = 0.f, run1 = 0.f;
#pragma unroll
        for (int i = 0; i < 8; ++i) {
            const int s = 8 * sg + i; const unsigned fw = cur.fw[i]; const bool valid = !meta || s < NMETA;
            const float f0 = lb0 + (1.0f - lb0) * sigm(bflo(fw)), f1 = lb1 + (1.0f - lb1) * sigm(bfhi(fw));
            const float l0 = valid ? __logf(f0) : 0.f, l1 = valid ? __logf(f1) : 0.f;
            kk0[i] = valid ? 1.0f - f0 : 0.f; kk1[i] = valid ? 1.0f - f1 : 0.f;
            run0 += l0; run1 += l1; cs0[i] = run0; cs1[i] = run1;
        }
        float inc0 = run0, inc1 = run1;
        { float t0 = __shfl_up(inc0, 8), t1 = __shfl_up(inc1, 8); if (sg >= 1) { inc0 += t0; inc1 += t1; }
          t0 = __shfl_up(inc0, 16); t1 = __shfl_up(inc1, 16); if (sg >= 2) { inc0 += t0; inc1 += t1; }
          t0 = __shfl_up(inc0, 32); t1 = __shfl_up(inc1, 32); if (sg >= 4) { inc0 += t0; inc1 += t1; } }
        const float pre0 = inc0 - run0, pre1 = inc1 - run1;
        const float tot0 = __shfl(inc0, lane_ | 56), tot1 = __shfl(inc1, lane_ | 56), ref0 = __shfl(inc0, (lane_ & 7) | 24), ref1 = __shfl(inc1, (lane_ & 7) | 24);
        { v4u p0, p1;
          p0.x = (cur.vw[0] & 0xffffu) | (cur.vw[1] << 16); p0.y = (cur.vw[2] & 0xffffu) | (cur.vw[3] << 16); p0.z = (cur.vw[4] & 0xffffu) | (cur.vw[5] << 16); p0.w = (cur.vw[6] & 0xffffu) | (cur.vw[7] << 16);
          p1.x = (cur.vw[0] >> 16) | (cur.vw[1] & 0xffff0000u); p1.y = (cur.vw[2] >> 16) | (cur.vw[3] & 0xffff0000u); p1.z = (cur.vw[4] >> 16) | (cur.vw[5] & 0xffff0000u); p1.w = (cur.vw[6] >> 16) | (cur.vw[7] & 0xffff0000u);
          *(LAS v4u*)(VT + (2 * kp) * 144 + sg * 16) = p0; *(LAS v4u*)(VT + (2 * kp + 1) * 144 + sg * 16) = p1; }
        if (MODE == 0) {
            float d0[8], d1[8];
#pragma unroll
            for (int i = 0; i < 8; ++i) { d0[i] = kk0[i] * __expf(tot0 - (pre0 + cs0[i])); d1[i] = kk1[i] * __expf(tot1 - (pre1 + cs1[i])); }
            v4u p0, p1;
            p0.x = pk2(d0[0], d0[1]); p0.y = pk2(d0[2], d0[3]); p0.z = pk2(d0[4], d0[5]); p0.w = pk2(d0[6], d0[7]);
            p1.x = pk2(d1[0], d1[1]); p1.y = pk2(d1[2], d1[3]); p1.z = pk2(d1[4], d1[5]); p1.w = pk2(d1[6], d1[7]);
            *(LAS v4u*)(KDT + (2 * kp) * 144 + sg * 16) = p0; *(LAS v4u*)(KDT + (2 * kp + 1) * 144 + sg * 16) = p1;
            if (!meta && sg == 0) *(f32x2*)(W_HGDEC + (size_t)(bh * NCH + c) * HD + 2 * kp) = (f32x2){__expf(tot0), __expf(tot1)};
            if (it + F.G < nit) hg_load<MODE>(nxt, args, ST, it + F.G, tid_, lane_, w);
            __syncthreads();
#pragma unroll 2
            for (int kt = 0; kt < 8; ++kt) {
                f32x4 acc = (f32x4){0.f, 0.f, 0.f, 0.f};
                acc = mma16(acc, KDT + kt * 16 * 144, 144, VT + w * 16 * 144, 144, CH, lane_);
                const int v = 16 * w + r, k0 = 16 * kt + 4 * g;
                if (meta) *(f32x4*)(W_HGMETA + ((size_t)h * HD + v) * HD + k0) = acc;
                else { v2u o; o.x = pk2(acc[0], acc[1]); o.y = pk2(acc[2], acc[3]); *(v2u*)(ST + (((size_t)(bh * NCH + c)) * HD + v) * HD + k0) = o; }
            }
        } else {
#pragma unroll
            for (int i = 0; i < 8; ++i) { const int s = 8 * sg + i;
                const float q0 = bflo(cur.qw[i]), q1 = bfhi(cur.qw[i]), qs0 = q0 * sigm(q0), qs1 = q1 * sigm(q1);
                const float bc0 = pre0 + cs0[i], bc1 = pre1 + cs1[i];
                *(LAS unsigned*)(QDEC + s * 272 + 4 * kp) = pk2(qs0 * __expf(bc0), qs1 * __expf(bc1));
                *(LAS unsigned*)(QD2 + s * 272 + 4 * kp) = pk2(qs0 * __expf(fminf(bc0 - ref0, 80.f)), qs1 * __expf(fminf(bc1 - ref1, 80.f)));
                *(LAS unsigned*)(KD2 + s * 272 + 4 * kp) = pk2(kk0[i] * __expf(fminf(ref0 - bc0, 80.f)), kk1[i] * __expf(fminf(ref1 - bc1, 80.f))); }
#pragma unroll
            for (int i = 0; i < 4; ++i) { const int p = tid_ + 512 * i, row = p >> 4, c16 = p & 15; *(LAS v4u*)(STl + row * 272 + c16 * 16) = cur.stw[i]; }
            if (it + F.G < nit) hg_load<MODE>(nxt, args, ST, it + F.G, tid_, lane_, w);
            __syncthreads();
            { const int tt = w >> 1;
#pragma unroll
              for (int e = 0; e < 2; ++e) { const int st = 2 * (w & 1) + e; f32x4 acc = (f32x4){0.f, 0.f, 0.f, 0.f};
                  if (st <= tt) acc = mma16(acc, KD2 + st * 16 * 272, 272, QD2 + tt * 16 * 272, 272, HD, lane_);
                  const int t = 16 * tt + r, s0 = 16 * st + 4 * g;
#pragma unroll
                  for (int j = 0; j < 4; ++j) if (s0 + j > t) acc[j] = 0.f;
                  v2u o; o.x = pk2(acc[0], acc[1]); o.y = pk2(acc[2], acc[3]); *(LAS v2u*)(PB + t * 144 + s0 * 2) = o; } }
            __syncthreads();
            f32x4 o4[4];
#pragma unroll
            for (int tt = 0; tt < 4; ++tt) { f32x4 acc = (f32x4){0.f, 0.f, 0.f, 0.f};
                acc = mma16(acc, STl + w * 16 * 272, 272, QDEC + tt * 16 * 272, 272, HD, lane_);
                acc = mma16(acc, VT + w * 16 * 144, 144, PB + tt * 16 * 144, 144, CH, lane_);
                o4[tt] = acc;
                float q = (acc[0] * acc[0] + acc[1] * acc[1]) + (acc[2] * acc[2] + acc[3] * acc[3]);
                q += __shfl_xor(q, 16); q += __shfl_xor(q, 32);
                if (g == 0) SSQ[(16 * tt + r) * 8 + w] = q; }
            __syncthreads();
            const f32x4 ng = *(const f32x4*)(A_hg_norm_g + h * HD + 16 * w + 4 * g);
#pragma unroll
            for (int tt = 0; tt < 4; ++tt) { const int t = 16 * tt + r;
                const f32x4 sa = *(const LAS f32x4*)(SSQ + t * 8), sb = *(const LAS f32x4*)(SSQ + t * 8 + 4);
                const float rs = __builtin_amdgcn_rsqf(((sa[0] + sa[1]) + (sa[2] + sa[3]) + (sb[0] + sb[1]) + (sb[2] + sb[3])) * (1.0f / HD) + EPS);
                v2u* op = (v2u*)(W_SLAB(SL_OG) + (size_t)(b * SEQ + c * CH + t) * DM + h * HD + 16 * w + 4 * g);
                const v2u ow = cur.ogw[tt]; const float g0 = bflo(ow.x), g1 = bfhi(ow.x), g2 = bflo(ow.y), g3 = bfhi(ow.y);
                v2u y; y.x = pk2(o4[tt][0] * rs * ng[0] * (g0 * sigm(g0)), o4[tt][1] * rs * ng[1] * (g1 * sigm(g1)));
                y.y = pk2(o4[tt][2] * rs * ng[2] * (g2 * sigm(g2)), o4[tt][3] * rs * ng[3] * (g3 * sigm(g3)));
                if (DUMMY) *(v2u*)((bf16*)(args.ws + WS_END) + ((((size_t)(b * SEQ + c * CH + t) * DM + h * HD + 16 * w + 4 * g)) & (size_t)(4 * MiB - 1))) = y; else *op = y; }
        }
#pragma unroll
        for (int i = 0; i < 8; ++i) { cur.fw[i] = nxt.fw[i]; cur.vw[i] = nxt.vw[i]; if (MODE == 1) cur.qw[i] = nxt.qw[i]; }
        if (MODE == 1) {
#pragma unroll
            for (int i = 0; i < 4; ++i) { cur.stw[i] = nxt.stw[i]; cur.ogw[i] = nxt.ogw[i]; } }
    }
}
__device__ __forceinline__ void hg_carry(Frame& F, const Args& args, bf16* ST) {
    const int lane_ = lane_now(), tid_ = F.wave * 64 + lane_; (void)tid_;
    for (int gid = F.vcu * NWAVES * 64 + tid_; gid < BATCH * NH * HD * (HD / 8); gid += F.G * NWAVES * 64) {
        const int k8 = gid & 15, v = (gid >> 4) & 127, bh = gid >> 11, h = bh & 15;
        float S[8];
        { const f32x4 a = *(const f32x4*)(W_HGMETA + ((size_t)h * HD + v) * HD + 8 * k8), b2 = *(const f32x4*)(W_HGMETA + ((size_t)h * HD + v) * HD + 8 * k8 + 4);
          S[0] = a[0]; S[1] = a[1]; S[2] = a[2]; S[3] = a[3]; S[4] = b2[0]; S[5] = b2[1]; S[6] = b2[2]; S[7] = b2[3]; }
        v4u* p0 = (v4u*)(ST + (((size_t)(bh * NCH)) * HD + v) * HD + 8 * k8);
        const f32x4* d0 = (const f32x4*)(W_HGDEC + (size_t)(bh * NCH) * HD + 8 * k8);
        for (int c0 = 0; c0 < NCH; c0 += 8) {
            v4u d[8]; f32x4 da[8], db[8];
#pragma unroll
            for (int i = 0; i < 8; ++i) { d[i] = p0[(size_t)(c0 + i) * 2048]; da[i] = d0[(c0 + i) * 32]; db[i] = d0[(c0 + i) * 32 + 1]; }
#pragma unroll
            for (int i = 0; i < 8; ++i) {
                v4u o; o.x = pk2(S[0], S[1]); o.y = pk2(S[2], S[3]); o.z = pk2(S[4], S[5]); o.w = pk2(S[6], S[7]); p0[(size_t)(c0 + i) * 2048] = o;
                S[0] = da[i][0] * S[0] + bflo(d[i].x); S[1] = da[i][1] * S[1] + bfhi(d[i].x); S[2] = da[i][2] * S[2] + bflo(d[i].y); S[3] = da[i][3] * S[3] + bfhi(d[i].y);
                S[4] = db[i][0] * S[4] + bflo(d[i].z); S[5] = db[i][1] * S[5] + bfhi(d[i].z); S[6] = db[i][2] * S[6] + bflo(d[i].w); S[7] = db[i][3] * S[7] + bfhi(d[i].w);
            }
        }
    }
}

__device__ __forceinline__ void p3_convert_uv(Frame& F, const Args& args) {
    const int lane_ = lane_now(), tid_ = F.wave * 64 + lane_; (void)tid_;
    const int gw = F.vcu * NWAVES + F.wave, NGW = F.G * NWAVES, lane = lane_;
    unsigned char* U8 = (unsigned char*)W_SLAB(SL_UB); unsigned char* V8 = (unsigned char*)W_SLAB(SL_VB);
    for (int it = gw; it < 2 * NEXP; it += NGW) {
        const bool isv = it >= NEXP; const int e = isv ? it - NEXP : it;
        const float* src = (isv ? A_peer_v : A_peer_u) + (size_t)e * DM;
        f32x4 a[8];
        { LAS f32x4* T = (LAS f32x4*)(F.lds + F.wave * 8192);
          f32x4 raw[8];
#pragma unroll
          for (int j = 0; j < 8; ++j) raw[j] = *((const f32x4*)src + lane + 64 * j);
#pragma unroll
          for (int j = 0; j < 8; ++j) { const int c = lane + 64 * j; T[c ^ ((c >> 4) & 3)] = raw[j]; }
#pragma unroll
          for (int q = 0; q < 4; ++q) { const int c0 = 4 * lane + q, c1 = 256 + 4 * lane + q; a[q] = T[c0 ^ ((c0 >> 4) & 3)]; a[4 + q] = T[c1 ^ ((c1 >> 4) & 3)]; } }
        if (!isv) {
#pragma unroll
            for (int q = 0; q < 4; ++q) { a[q] = a[q] * *(const f32x4*)(A_ln2_g + 16 * lane + 4 * q); a[4 + q] = a[4 + q] * *(const f32x4*)(A_ln2_g + 1024 + 16 * lane + 4 * q); }
        }
        float mx = 0.f;
#pragma unroll
        for (int q = 0; q < 8; ++q) mx = fmaxf(mx, fmaxf(fmaxf(fabsf(a[q][0]), fabsf(a[q][1])), fmaxf(fabsf(a[q][2]), fabsf(a[q][3]))));
        mx = wave_max(mx);
        const float sc = mx > 0.f ? 256.0f / mx : 0.f;
        v4u o0, o1;
#pragma unroll
        for (int q = 0; q < 4; ++q) {
            int w0 = __builtin_amdgcn_cvt_pk_fp8_f32(a[q][0] * sc, a[q][1] * sc, 0, false); w0 = __builtin_amdgcn_cvt_pk_fp8_f32(a[q][2] * sc, a[q][3] * sc, w0, true);
            int w1 = __builtin_amdgcn_cvt_pk_fp8_f32(a[4 + q][0] * sc, a[4 + q][1] * sc, 0, false); w1 = __builtin_amdgcn_cvt_pk_fp8_f32(a[4 + q][2] * sc, a[4 + q][3] * sc, w1, true);
            o0[q] = (unsigned)w0; o1[q] = (unsigned)w1; }
        unsigned char* dst = (isv ? V8 : U8) + (size_t)e * DM + 16 * lane;
        *(v4u*)dst = o0; *(v4u*)(dst + 1024) = o1;
        if (lane == 0) W_PSC[it] = mx * (1.0f / 256.0f);
    }
}

#define CEU(x, y) do { const unsigned _h = (x) > (y) ? (x) : (y), _l = (x) > (y) ? (y) : (x); (x) = _h; (y) = _l; } while (0)
#define CEP(vx, ix, vy, iy) do { const bool _s = (vy) > (vx); const float _hv = _s ? (vy) : (vx), _lv = _s ? (vx) : (vy); const int _hi = _s ? (iy) : (ix), _li = _s ? (ix) : (iy); (vx) = _hv; (vy) = _lv; (ix) = _hi; (iy) = _li; } while (0)
#define SEL4(g, x0, x1, x2, x3) (((g) & 2) ? (((g) & 1) ? (x3) : (x2)) : (((g) & 1) ? (x1) : (x0)))
__device__ __forceinline__ unsigned sel_key(float f, int idx) { const unsigned u = __float_as_uint(f); const unsigned k = u ^ ((unsigned)((int)u >> 31) | 0x80000000u); return (k & ~127u) | (unsigned)idx; }
__device__ __forceinline__ float sel_val(unsigned k) { const unsigned u = k & ~127u; return __uint_as_float(u ^ (~(unsigned)((int)u >> 31) | 0x80000000u)); }
__device__ __forceinline__ void sel_top16(unsigned (&a)[32], unsigned (&t)[16]) {
    CEU(a[0], a[1]);
    CEU(a[3], a[2]);
    CEU(a[4], a[5]);
    CEU(a[7], a[6]);
    CEU(a[8], a[9]);
    CEU(a[11], a[10]);
    CEU(a[12], a[13]);
    CEU(a[15], a[14]);
    CEU(a[0], a[2]);
    CEU(a[1], a[3]);
    CEU(a[6], a[4]);
    CEU(a[7], a[5]);
    CEU(a[8], a[10]);
    CEU(a[9], a[11]);
    CEU(a[14], a[12]);
    CEU(a[15], a[13]);
    CEU(a[0], a[1]);
    CEU(a[2], a[3]);
    CEU(a[5], a[4]);
    CEU(a[7], a[6]);
    CEU(a[8], a[9]);
    CEU(a[10], a[11]);
    CEU(a[13], a[12]);
    CEU(a[15], a[14]);
    CEU(a[0], a[4]);
    CEU(a[1], a[5]);
    CEU(a[2], a[6]);
    CEU(a[3], a[7]);
    CEU(a[12], a[8]);
    CEU(a[13], a[9]);
    CEU(a[14], a[10]);
    CEU(a[15], a[11]);
    CEU(a[0], a[2]);
    CEU(a[1], a[3]);
    CEU(a[4], a[6]);
    CEU(a[5], a[7]);
    CEU(a[10], a[8]);
    CEU(a[11], a[9]);
    CEU(a[14], a[12]);
    CEU(a[15], a[13]);
    CEU(a[0], a[1]);
    CEU(a[2], a[3]);
    CEU(a[4], a[5]);
    CEU(a[6], a[7]);
    CEU(a[9], a[8]);
    CEU(a[11], a[10]);
    CEU(a[13], a[12]);
    CEU(a[15], a[14]);
    CEU(a[0], a[8]);
    CEU(a[1], a[9]);
    CEU(a[2], a[10]);
    CEU(a[3], a[11]);
    CEU(a[4], a[12]);
    CEU(a[5], a[13]);
    CEU(a[6], a[14]);
    CEU(a[7], a[15]);
    CEU(a[0], a[4]);
    CEU(a[1], a[5]);
    CEU(a[2], a[6]);
    CEU(a[3], a[7]);
    CEU(a[8], a[12]);
    CEU(a[9], a[13]);
    CEU(a[10], a[14]);
    CEU(a[11], a[15]);
    CEU(a[0], a[2]);
    CEU(a[1], a[3]);
    CEU(a[4], a[6]);
    CEU(a[5], a[7]);
    CEU(a[8], a[10]);
    CEU(a[9], a[11]);
    CEU(a[12], a[14]);
    CEU(a[13], a[15]);
    CEU(a[0], a[1]);
    CEU(a[2], a[3]);
    CEU(a[4], a[5]);
    CEU(a[6], a[7]);
    CEU(a[8], a[9]);
    CEU(a[10], a[11]);
    CEU(a[12], a[13]);
    CEU(a[14], a[15]);
    CEU(a[16], a[17]);
    CEU(a[19], a[18]);
    CEU(a[20], a[21]);
    CEU(a[23], a[22]);
    CEU(a[24], a[25]);
    CEU(a[27], a[26]);
    CEU(a[28], a[29]);
    CEU(a[31], a[30]);
    CEU(a[16], a[18]);
    CEU(a[17], a[19]);
    CEU(a[22], a[20]);
    CEU(a[23], a[21]);
    CEU(a[24], a[26]);
    CEU(a[25], a[27]);
    CEU(a[30], a[28]);
    CEU(a[31], a[29]);
    CEU(a[16], a[17]);
    CEU(a[18], a[19]);
    CEU(a[21], a[20]);
    CEU(a[23], a[22]);
    CEU(a[24], a[25]);
    CEU(a[26], a[27]);
    CEU(a[29], a[28]);
    CEU(a[31], a[30]);
    CEU(a[16], a[20]);
    CEU(a[17], a[21]);
    CEU(a[18], a[22]);
    CEU(a[19], a[23]);
    CEU(a[28], a[24]);
    CEU(a[29], a[25]);
    CEU(a[30], a[26]);
    CEU(a[31], a[27]);
    CEU(a[16], a[18]);
    CEU(a[17], a[19]);
    CEU(a[20], a[22]);
    CEU(a[21], a[23]);
    CEU(a[26], a[24]);
    CEU(a[27], a[25]);
    CEU(a[30], a[28]);
    CEU(a[31], a[29]);
    CEU(a[16], a[17]);
    CEU(a[18], a[19]);
    CEU(a[20], a[21]);
    CEU(a[22], a[23]);
    CEU(a[25], a[24]);
    CEU(a[27], a[26]);
    CEU(a[29], a[28]);
    CEU(a[31], a[30]);
    CEU(a[16], a[24]);
    CEU(a[17], a[25]);
    CEU(a[18], a[26]);
    CEU(a[19], a[27]);
    CEU(a[20], a[28]);
    CEU(a[21], a[29]);
    CEU(a[22], a[30]);
    CEU(a[23], a[31]);
    CEU(a[16], a[20]);
    CEU(a[17], a[21]);
    CEU(a[18], a[22]);
    CEU(a[19], a[23]);
    CEU(a[24], a[28]);
    CEU(a[25], a[29]);
    CEU(a[26], a[30]);
    CEU(a[27], a[31]);
    CEU(a[16], a[18]);
    CEU(a[17], a[19]);
    CEU(a[20], a[22]);
    CEU(a[21], a[23]);
    CEU(a[24], a[26]);
    CEU(a[25], a[27]);
    CEU(a[28], a[30]);
    CEU(a[29], a[31]);
    CEU(a[16], a[17]);
    CEU(a[18], a[19]);
    CEU(a[20], a[21]);
    CEU(a[22], a[23]);
    CEU(a[24], a[25]);
    CEU(a[26], a[27]);
    CEU(a[28], a[29]);
    CEU(a[30], a[31]);
    t[0] = a[0] > a[31] ? a[0] : a[31];
    t[1] = a[1] > a[30] ? a[1] : a[30];
    t[2] = a[2] > a[29] ? a[2] : a[29];
    t[3] = a[3] > a[28] ? a[3] : a[28];
    t[4] = a[4] > a[27] ? a[4] : a[27];
    t[5] = a[5] > a[26] ? a[5] : a[26];
    t[6] = a[6] > a[25] ? a[6] : a[25];
    t[7] = a[7] > a[24] ? a[7] : a[24];
    t[8] = a[8] > a[23] ? a[8] : a[23];
    t[9] = a[9] > a[22] ? a[9] : a[22];
    t[10] = a[10] > a[21] ? a[10] : a[21];
    t[11] = a[11] > a[20] ? a[11] : a[20];
    t[12] = a[12] > a[19] ? a[12] : a[19];
    t[13] = a[13] > a[18] ? a[13] : a[18];
    t[14] = a[14] > a[17] ? a[14] : a[17];
    t[15] = a[15] > a[16] ? a[15] : a[16];
    CEU(t[0], t[8]);
    CEU(t[1], t[9]);
    CEU(t[2], t[10]);
    CEU(t[3], t[11]);
    CEU(t[4], t[12]);
    CEU(t[5], t[13]);
    CEU(t[6], t[14]);
    CEU(t[7], t[15]);
    CEU(t[0], t[4]);
    CEU(t[1], t[5]);
    CEU(t[2], t[6]);
    CEU(t[3], t[7]);
    CEU(t[8], t[12]);
    CEU(t[9], t[13]);
    CEU(t[10], t[14]);
    CEU(t[11], t[15]);
    CEU(t[0], t[2]);
    CEU(t[1], t[3]);
    CEU(t[4], t[6]);
    CEU(t[5], t[7]);
    CEU(t[8], t[10]);
    CEU(t[9], t[11]);
    CEU(t[12], t[14]);
    CEU(t[13], t[15]);
    CEU(t[0], t[1]);
    CEU(t[2], t[3]);
    CEU(t[4], t[5]);
    CEU(t[6], t[7]);
    CEU(t[8], t[9]);
    CEU(t[10], t[11]);
    CEU(t[12], t[13]);
    CEU(t[14], t[15]);
    { unsigned o[16];
      o[0] = (unsigned)__shfl_xor((int)t[15], 16);
      o[1] = (unsigned)__shfl_xor((int)t[14], 16);
      o[2] = (unsigned)__shfl_xor((int)t[13], 16);
      o[3] = (unsigned)__shfl_xor((int)t[12], 16);
      o[4] = (unsigned)__shfl_xor((int)t[11], 16);
      o[5] = (unsigned)__shfl_xor((int)t[10], 16);
      o[6] = (unsigned)__shfl_xor((int)t[9], 16);
      o[7] = (unsigned)__shfl_xor((int)t[8], 16);
      o[8] = (unsigned)__shfl_xor((int)t[7], 16);
      o[9] = (unsigned)__shfl_xor((int)t[6], 16);
      o[10] = (unsigned)__shfl_xor((int)t[5], 16);
      o[11] = (unsigned)__shfl_xor((int)t[4], 16);
      o[12] = (unsigned)__shfl_xor((int)t[3], 16);
      o[13] = (unsigned)__shfl_xor((int)t[2], 16);
      o[14] = (unsigned)__shfl_xor((int)t[1], 16);
      o[15] = (unsigned)__shfl_xor((int)t[0], 16);
      t[0] = t[0] > o[0] ? t[0] : o[0];
      t[1] = t[1] > o[1] ? t[1] : o[1];
      t[2] = t[2] > o[2] ? t[2] : o[2];
      t[3] = t[3] > o[3] ? t[3] : o[3];
      t[4] = t[4] > o[4] ? t[4] : o[4];
      t[5] = t[5] > o[5] ? t[5] : o[5];
      t[6] = t[6] > o[6] ? t[6] : o[6];
      t[7] = t[7] > o[7] ? t[7] : o[7];
      t[8] = t[8] > o[8] ? t[8] : o[8];
      t[9] = t[9] > o[9] ? t[9] : o[9];
      t[10] = t[10] > o[10] ? t[10] : o[10];
      t[11] = t[11] > o[11] ? t[11] : o[11];
      t[12] = t[12] > o[12] ? t[12] : o[12];
      t[13] = t[13] > o[13] ? t[13] : o[13];
      t[14] = t[14] > o[14] ? t[14] : o[14];
      t[15] = t[15] > o[15] ? t[15] : o[15];
    }
    CEU(t[0], t[8]);
    CEU(t[1], t[9]);
    CEU(t[2], t[10]);
    CEU(t[3], t[11]);
    CEU(t[4], t[12]);
    CEU(t[5], t[13]);
    CEU(t[6], t[14]);
    CEU(t[7], t[15]);
    CEU(t[0], t[4]);
    CEU(t[1], t[5]);
    CEU(t[2], t[6]);
    CEU(t[3], t[7]);
    CEU(t[8], t[12]);
    CEU(t[9], t[13]);
    CEU(t[10], t[14]);
    CEU(t[11], t[15]);
    CEU(t[0], t[2]);
    CEU(t[1], t[3]);
    CEU(t[4], t[6]);
    CEU(t[5], t[7]);
    CEU(t[8], t[10]);
    CEU(t[9], t[11]);
    CEU(t[12], t[14]);
    CEU(t[13], t[15]);
    CEU(t[0], t[1]);
    CEU(t[2], t[3]);
    CEU(t[4], t[5]);
    CEU(t[6], t[7]);
    CEU(t[8], t[9]);
    CEU(t[10], t[11]);
    CEU(t[12], t[13]);
    CEU(t[14], t[15]);
    { unsigned o[16];
      o[0] = (unsigned)__shfl_xor((int)t[15], 32);
      o[1] = (unsigned)__shfl_xor((int)t[14], 32);
      o[2] = (unsigned)__shfl_xor((int)t[13], 32);
      o[3] = (unsigned)__shfl_xor((int)t[12], 32);
      o[4] = (unsigned)__shfl_xor((int)t[11], 32);
      o[5] = (unsigned)__shfl_xor((int)t[10], 32);
      o[6] = (unsigned)__shfl_xor((int)t[9], 32);
      o[7] = (unsigned)__shfl_xor((int)t[8], 32);
      o[8] = (unsigned)__shfl_xor((int)t[7], 32);
      o[9] = (unsigned)__shfl_xor((int)t[6], 32);
      o[10] = (unsigned)__shfl_xor((int)t[5], 32);
      o[11] = (unsigned)__shfl_xor((int)t[4], 32);
      o[12] = (unsigned)__shfl_xor((int)t[3], 32);
      o[13] = (unsigned)__shfl_xor((int)t[2], 32);
      o[14] = (unsigned)__shfl_xor((int)t[1], 32);
      o[15] = (unsigned)__shfl_xor((int)t[0], 32);
      t[0] = t[0] > o[0] ? t[0] : o[0];
      t[1] = t[1] > o[1] ? t[1] : o[1];
      t[2] = t[2] > o[2] ? t[2] : o[2];
      t[3] = t[3] > o[3] ? t[3] : o[3];
      t[4] = t[4] > o[4] ? t[4] : o[4];
      t[5] = t[5] > o[5] ? t[5] : o[5];
      t[6] = t[6] > o[6] ? t[6] : o[6];
      t[7] = t[7] > o[7] ? t[7] : o[7];
      t[8] = t[8] > o[8] ? t[8] : o[8];
      t[9] = t[9] > o[9] ? t[9] : o[9];
      t[10] = t[10] > o[10] ? t[10] : o[10];
      t[11] = t[11] > o[11] ? t[11] : o[11];
      t[12] = t[12] > o[12] ? t[12] : o[12];
      t[13] = t[13] > o[13] ? t[13] : o[13];
      t[14] = t[14] > o[14] ? t[14] : o[14];
      t[15] = t[15] > o[15] ? t[15] : o[15];
    }
    CEU(t[0], t[8]);
    CEU(t[1], t[9]);
    CEU(t[2], t[10]);
    CEU(t[3], t[11]);
    CEU(t[4], t[12]);
    CEU(t[5], t[13]);
    CEU(t[6], t[14]);
    CEU(t[7], t[15]);
    CEU(t[0], t[4]);
    CEU(t[1], t[5]);
    CEU(t[2], t[6]);
    CEU(t[3], t[7]);
    CEU(t[8], t[12]);
    CEU(t[9], t[13]);
    CEU(t[10], t[14]);
    CEU(t[11], t[15]);
    CEU(t[0], t[2]);
    CEU(t[1], t[3]);
    CEU(t[4], t[6]);
    CEU(t[5], t[7]);
    CEU(t[8], t[10]);
    CEU(t[9], t[11]);
    CEU(t[12], t[14]);
    CEU(t[13], t[15]);
    CEU(t[0], t[1]);
    CEU(t[2], t[3]);
    CEU(t[4], t[5]);
    CEU(t[6], t[7]);
    CEU(t[8], t[9]);
    CEU(t[10], t[11]);
    CEU(t[12], t[13]);
    CEU(t[14], t[15]);
}
__device__ __forceinline__ void sel_phase(Frame& F, const Args& args) {
    const int lane_ = lane_now(), tid_ = F.wave * 64 + lane_; (void)tid_;
    LAS unsigned char* KL = F.lds;
    const int h = F.vcu & 7, r = lane_ & 15, g = lane_ >> 4;
    unsigned short* SELI = (unsigned short*)W_SLAB(SL_SEL); float* SELG = (float*)(W_SLAB(SL_SEL)) + (size_t)M * NSEL;
    { const v4u* gk = (const v4u*)(W_KEYS + (size_t)h * 2 * NKEY * 128);
#pragma unroll
      for (int i = 0; i < 8; ++i) { const int p = tid_ + 512 * i, row = p >> 4, c16 = p & 15; *(LAS v4u*)(KL + row * 272 + c16 * 16) = gk[p]; } }
    __syncthreads();
    const int njob = M / 16, jstride = (F.G >> 3) * NWAVES;
    const int job0 = (F.vcu >> 3) * NWAVES + F.wave;
    bf16x8 bqn[8];
    if (job0 < njob) { const bf16* qp = W_SLAB(SL_QP) + (size_t)(job0 * 16 + r) * DM + h * 256 + 8 * g;
#pragma unroll
        for (int i = 0; i < 8; ++i) bqn[i] = *(const bf16x8*)(qp + 32 * i); }
    for (int job = job0; job < njob; job += jstride) {
        const int tok = job * 16 + r;
        unsigned ta[16], tb[16];
        bf16x8 bqc[8];
#pragma unroll
        for (int i = 0; i < 8; ++i) bqc[i] = bqn[i];
        if (job + jstride < njob) { const bf16* qp = W_SLAB(SL_QP) + (size_t)((job + jstride) * 16 + r) * DM + h * 256 + 8 * g;
#pragma unroll
            for (int i = 0; i < 8; ++i) bqn[i] = *(const bf16x8*)(qp + 32 * i); }
#pragma unroll
        for (int pp = 0; pp < 2; ++pp) {
            bf16x8 bq[4];
#pragma unroll
            for (int ks = 0; ks < 4; ++ks) bq[ks] = bqc[4 * pp + ks];
            unsigned a[32];
#pragma unroll
            for (int kt = 0; kt < 8; ++kt) { f32x4 acc = (f32x4){0.f, 0.f, 0.f, 0.f};
#pragma unroll
                for (int ks = 0; ks < 4; ++ks) { const bf16x8 av = *(const LAS bf16x8*)(KL + (pp * 128 + kt * 16 + r) * 272 + ks * 64 + g * 16); acc = __builtin_amdgcn_mfma_f32_16x16x32_bf16(av, bq[ks], acc, 0, 0, 0); }
#pragma unroll
                for (int j = 0; j < 4; ++j) a[kt * 4 + j] = sel_key(acc[j], kt * 16 + 4 * g + j);
                __builtin_amdgcn_sched_barrier(0); }
            if (pp == 0) sel_top16(a, ta); else sel_top16(a, tb);
        }
        float va[16], vb[16]; int ia[16], ib[16];
#pragma unroll
        for (int i = 0; i < 16; ++i) { va[i] = sel_val(ta[i]); vb[i] = sel_val(tb[i]); ia[i] = (int)(ta[i] & 127u); ib[i] = (int)(tb[i] & 127u); }
        float cv[16]; int ci[16];
        cv[0] = va[0] + SEL4(g, vb[0], vb[1], vb[2], vb[3]); ci[0] = ia[0] * NKEY + SEL4(g, ib[0], ib[1], ib[2], ib[3]);
        cv[1] = va[0] + SEL4(g, vb[4], vb[5], vb[6], vb[7]); ci[1] = ia[0] * NKEY + SEL4(g, ib[4], ib[5], ib[6], ib[7]);
        cv[2] = va[0] + SEL4(g, vb[8], vb[9], vb[10], vb[11]); ci[2] = ia[0] * NKEY + SEL4(g, ib[8], ib[9], ib[10], ib[11]);
        cv[3] = va[0] + SEL4(g, vb[12], vb[13], vb[14], vb[15]); ci[3] = ia[0] * NKEY + SEL4(g, ib[12], ib[13], ib[14], ib[15]);
        cv[4] = va[1] + SEL4(g, vb[0], vb[1], vb[2], vb[3]); ci[4] = ia[1] * NKEY + SEL4(g, ib[0], ib[1], ib[2], ib[3]);
        cv[5] = va[1] + SEL4(g, vb[4], vb[5], vb[6], vb[7]); ci[5] = ia[1] * NKEY + SEL4(g, ib[4], ib[5], ib[6], ib[7]);
        cv[6] = va[2] + SEL4(g, vb[0], vb[1], vb[2], vb[3]); ci[6] = ia[2] * NKEY + SEL4(g, ib[0], ib[1], ib[2], ib[3]);
        cv[7] = SEL4(g, va[2], va[3], va[3], va[3]) + SEL4(g, vb[4], vb[0], vb[1], vb[2]); ci[7] = SEL4(g, ia[2], ia[3], ia[3], ia[3]) * NKEY + SEL4(g, ib[4], ib[0], ib[1], ib[2]);
        cv[8] = SEL4(g, va[3], va[4], va[4], va[4]) + SEL4(g, vb[3], vb[0], vb[1], vb[2]); ci[8] = SEL4(g, ia[3], ia[4], ia[4], ia[4]) * NKEY + SEL4(g, ib[3], ib[0], ib[1], ib[2]);
        cv[9] = SEL4(g, va[5], va[5], va[6], va[6]) + SEL4(g, vb[0], vb[1], vb[0], vb[1]); ci[9] = SEL4(g, ia[5], ia[5], ia[6], ia[6]) * NKEY + SEL4(g, ib[0], ib[1], ib[0], ib[1]);
        cv[10] = SEL4(g, va[7], va[7], va[8], va[9]) + SEL4(g, vb[0], vb[1], vb[0], vb[0]); ci[10] = SEL4(g, ia[7], ia[7], ia[8], ia[9]) * NKEY + SEL4(g, ib[0], ib[1], ib[0], ib[0]);
        cv[11] = SEL4(g, va[10], va[11], va[12], va[13]) + vb[0]; ci[11] = SEL4(g, ia[10], ia[11], ia[12], ia[13]) * NKEY + ib[0];
        { const float sa = SEL4(g, va[14], va[15], 0.f, 0.f), sb = SEL4(g, vb[0], vb[0], 0.f, 0.f); const bool pad = g == 2 || g == 3;
          cv[12] = pad ? -3.0e38f : sa + sb; ci[12] = SEL4(g, ia[14], ia[15], 0, 0) * NKEY + SEL4(g, ib[0], ib[0], 0, 0); }
        cv[13] = -3.0e38f; ci[13] = 0;
        cv[14] = -3.0e38f; ci[14] = 0;
        cv[15] = -3.0e38f; ci[15] = 0;
        CEP(cv[0], ci[0], cv[1], ci[1]);
        CEP(cv[3], ci[3], cv[2], ci[2]);
        CEP(cv[4], ci[4], cv[5], ci[5]);
        CEP(cv[7], ci[7], cv[6], ci[6]);
        CEP(cv[8], ci[8], cv[9], ci[9]);
        CEP(cv[11], ci[11], cv[10], ci[10]);
        CEP(cv[12], ci[12], cv[13], ci[13]);
        CEP(cv[15], ci[15], cv[14], ci[14]);
        CEP(cv[0], ci[0], cv[2], ci[2]);
        CEP(cv[1], ci[1], cv[3], ci[3]);
        CEP(cv[6], ci[6], cv[4], ci[4]);
        CEP(cv[7], ci[7], cv[5], ci[5]);
        CEP(cv[8], ci[8], cv[10], ci[10]);
        CEP(cv[9], ci[9], cv[11], ci[11]);
        CEP(cv[14], ci[14], cv[12], ci[12]);
        CEP(cv[15], ci[15], cv[13], ci[13]);
        CEP(cv[0], ci[0], cv[1], ci[1]);
        CEP(cv[2], ci[2], cv[3], ci[3]);
        CEP(cv[5], ci[5], cv[4], ci[4]);
        CEP(cv[7], ci[7], cv[6], ci[6]);
        CEP(cv[8], ci[8], cv[9], ci[9]);
        CEP(cv[10], ci[10], cv[11], ci[11]);
        CEP(cv[13], ci[13], cv[12], ci[12]);
        CEP(cv[15], ci[15], cv[14], ci[14]);
        CEP(cv[0], ci[0], cv[4], ci[4]);
        CEP(cv[1], ci[1], cv[5], ci[5]);
        CEP(cv[2], ci[2], cv[6], ci[6]);
        CEP(cv[3], ci[3], cv[7], ci[7]);
        CEP(cv[12], ci[12], cv[8], ci[8]);
        CEP(cv[13], ci[13], cv[9], ci[9]);
        CEP(cv[14], ci[14], cv[10], ci[10]);
        CEP(cv[15], ci[15], cv[11], ci[11]);
        CEP(cv[0], ci[0], cv[2], ci[2]);
        CEP(cv[1], ci[1], cv[3], ci[3]);
        CEP(cv[4], ci[4], cv[6], ci[6]);
        CEP(cv[5], ci[5], cv[7], ci[7]);
        CEP(cv[10], ci[10], cv[8], ci[8]);
        CEP(cv[11], ci[11], cv[9], ci[9]);
        CEP(cv[14], ci[14], cv[12], ci[12]);
        CEP(cv[15], ci[15], cv[13], ci[13]);
        CEP(cv[0], ci[0], cv[1], ci[1]);
        CEP(cv[2], ci[2], cv[3], ci[3]);
        CEP(cv[4], ci[4], cv[5], ci[5]);
        CEP(cv[6], ci[6], cv[7], ci[7]);
        CEP(cv[9], ci[9], cv[8], ci[8]);
        CEP(cv[11], ci[11], cv[10], ci[10]);
        CEP(cv[13], ci[13], cv[12], ci[12]);
        CEP(cv[15], ci[15], cv[14], ci[14]);
        CEP(cv[0], ci[0], cv[8], ci[8]);
        CEP(cv[1], ci[1], cv[9], ci[9]);
        CEP(cv[2], ci[2], cv[10], ci[10]);
        CEP(cv[3], ci[3], cv[11], ci[11]);
        CEP(cv[4], ci[4], cv[12], ci[12]);
        CEP(cv[5], ci[5], cv[13], ci[13]);
        CEP(cv[6], ci[6], cv[14], ci[14]);
        CEP(cv[7], ci[7], cv[15], ci[15]);
        CEP(cv[0], ci[0], cv[4], ci[4]);
        CEP(cv[1], ci[1], cv[5], ci[5]);
        CEP(cv[2], ci[2], cv[6], ci[6]);
        CEP(cv[3], ci[3], cv[7], ci[7]);
        CEP(cv[8], ci[8], cv[12], ci[12]);
        CEP(cv[9], ci[9], cv[13], ci[13]);
        CEP(cv[10], ci[10], cv[14], ci[14]);
        CEP(cv[11], ci[11], cv[15], ci[15]);
        CEP(cv[0], ci[0], cv[2], ci[2]);
        CEP(cv[1], ci[1], cv[3], ci[3]);
        CEP(cv[4], ci[4], cv[6], ci[6]);
        CEP(cv[5], ci[5], cv[7], ci[7]);
        CEP(cv[8], ci[8], cv[10], ci[10]);
        CEP(cv[9], ci[9], cv[11], ci[11]);
        CEP(cv[12], ci[12], cv[14], ci[14]);
        CEP(cv[13], ci[13], cv[15], ci[15]);
        CEP(cv[0], ci[0], cv[1], ci[1]);
        CEP(cv[2], ci[2], cv[3], ci[3]);
        CEP(cv[4], ci[4], cv[5], ci[5]);
        CEP(cv[6], ci[6], cv[7], ci[7]);
        CEP(cv[8], ci[8], cv[9], ci[9]);
        CEP(cv[10], ci[10], cv[11], ci[11]);
        CEP(cv[12], ci[12], cv[13], ci[13]);
        CEP(cv[14], ci[14], cv[15], ci[15]);
        { float ov[16]; int oi[16];
          ov[0] = __shfl_xor(cv[15], 16); oi[0] = __shfl_xor(ci[15], 16);
          ov[1] = __shfl_xor(cv[14], 16); oi[1] = __shfl_xor(ci[14], 16);
          ov[2] = __shfl_xor(cv[13], 16); oi[2] = __shfl_xor(ci[13], 16);
          ov[3] = __shfl_xor(cv[12], 16); oi[3] = __shfl_xor(ci[12], 16);
          ov[4] = __shfl_xor(cv[11], 16); oi[4] = __shfl_xor(ci[11], 16);
          ov[5] = __shfl_xor(cv[10], 16); oi[5] = __shfl_xor(ci[10], 16);
          ov[6] = __shfl_xor(cv[9], 16); oi[6] = __shfl_xor(ci[9], 16);
          ov[7] = __shfl_xor(cv[8], 16); oi[7] = __shfl_xor(ci[8], 16);
          ov[8] = __shfl_xor(cv[7], 16); oi[8] = __shfl_xor(ci[7], 16);
          ov[9] = __shfl_xor(cv[6], 16); oi[9] = __shfl_xor(ci[6], 16);
          ov[10] = __shfl_xor(cv[5], 16); oi[10] = __shfl_xor(ci[5], 16);
          ov[11] = __shfl_xor(cv[4], 16); oi[11] = __shfl_xor(ci[4], 16);
          ov[12] = __shfl_xor(cv[3], 16); oi[12] = __shfl_xor(ci[3], 16);
          ov[13] = __shfl_xor(cv[2], 16); oi[13] = __shfl_xor(ci[2], 16);
          ov[14] = __shfl_xor(cv[1], 16); oi[14] = __shfl_xor(ci[1], 16);
          ov[15] = __shfl_xor(cv[0], 16); oi[15] = __shfl_xor(ci[0], 16);
          { const bool s_ = ov[0] > cv[0]; cv[0] = s_ ? ov[0] : cv[0]; ci[0] = s_ ? oi[0] : ci[0]; }
          { const bool s_ = ov[1] > cv[1]; cv[1] = s_ ? ov[1] : cv[1]; ci[1] = s_ ? oi[1] : ci[1]; }
          { const bool s_ = ov[2] > cv[2]; cv[2] = s_ ? ov[2] : cv[2]; ci[2] = s_ ? oi[2] : ci[2]; }
          { const bool s_ = ov[3] > cv[3]; cv[3] = s_ ? ov[3] : cv[3]; ci[3] = s_ ? oi[3] : ci[3]; }
          { const bool s_ = ov[4] > cv[4]; cv[4] = s_ ? ov[4] : cv[4]; ci[4] = s_ ? oi[4] : ci[4]; }
          { const bool s_ = ov[5] > cv[5]; cv[5] = s_ ? ov[5] : cv[5]; ci[5] = s_ ? oi[5] : ci[5]; }
          { const bool s_ = ov[6] > cv[6]; cv[6] = s_ ? ov[6] : cv[6]; ci[6] = s_ ? oi[6] : ci[6]; }
          { const bool s_ = ov[7] > cv[7]; cv[7] = s_ ? ov[7] : cv[7]; ci[7] = s_ ? oi[7] : ci[7]; }
          { const bool s_ = ov[8] > cv[8]; cv[8] = s_ ? ov[8] : cv[8]; ci[8] = s_ ? oi[8] : ci[8]; }
          { const bool s_ = ov[9] > cv[9]; cv[9] = s_ ? ov[9] : cv[9]; ci[9] = s_ ? oi[9] : ci[9]; }
          { const bool s_ = ov[10] > cv[10]; cv[10] = s_ ? ov[10] : cv[10]; ci[10] = s_ ? oi[10] : ci[10]; }
          { const bool s_ = ov[11] > cv[11]; cv[11] = s_ ? ov[11] : cv[11]; ci[11] = s_ ? oi[11] : ci[11]; }
          { const bool s_ = ov[12] > cv[12]; cv[12] = s_ ? ov[12] : cv[12]; ci[12] = s_ ? oi[12] : ci[12]; }
          { const bool s_ = ov[13] > cv[13]; cv[13] = s_ ? ov[13] : cv[13]; ci[13] = s_ ? oi[13] : ci[13]; }
          { const bool s_ = ov[14] > cv[14]; cv[14] = s_ ? ov[14] : cv[14]; ci[14] = s_ ? oi[14] : ci[14]; }
          { const bool s_ = ov[15] > cv[15]; cv[15] = s_ ? ov[15] : cv[15]; ci[15] = s_ ? oi[15] : ci[15]; }
        }
        CEP(cv[0], ci[0], cv[8], ci[8]);
        CEP(cv[1], ci[1], cv[9], ci[9]);
        CEP(cv[2], ci[2], cv[10], ci[10]);
        CEP(cv[3], ci[3], cv[11], ci[11]);
        CEP(cv[4], ci[4], cv[12], ci[12]);
        CEP(cv[5], ci[5], cv[13], ci[13]);
        CEP(cv[6], ci[6], cv[14], ci[14]);
        CEP(cv[7], ci[7], cv[15], ci[15]);
        CEP(cv[0], ci[0], cv[4], ci[4]);
        CEP(cv[1], ci[1], cv[5], ci[5]);
        CEP(cv[2], ci[2], cv[6], ci[6]);
        CEP(cv[3], ci[3], cv[7], ci[7]);
        CEP(cv[8], ci[8], cv[12], ci[12]);
        CEP(cv[9], ci[9], cv[13], ci[13]);
        CEP(cv[10], ci[10], cv[14], ci[14]);
        CEP(cv[11], ci[11], cv[15], ci[15]);
        CEP(cv[0], ci[0], cv[2], ci[2]);
        CEP(cv[1], ci[1], cv[3], ci[3]);
        CEP(cv[4], ci[4], cv[6], ci[6]);
        CEP(cv[5], ci[5], cv[7], ci[7]);
        CEP(cv[8], ci[8], cv[10], ci[10]);
        CEP(cv[9], ci[9], cv[11], ci[11]);
        CEP(cv[12], ci[12], cv[14], ci[14]);
        CEP(cv[13], ci[13], cv[15], ci[15]);
        CEP(cv[0], ci[0], cv[1], ci[1]);
        CEP(cv[2], ci[2], cv[3], ci[3]);
        CEP(cv[4], ci[4], cv[5], ci[5]);
        CEP(cv[6], ci[6], cv[7], ci[7]);
        CEP(cv[8], ci[8], cv[9], ci[9]);
        CEP(cv[10], ci[10], cv[11], ci[11]);
        CEP(cv[12], ci[12], cv[13], ci[13]);
        CEP(cv[14], ci[14], cv[15], ci[15]);
        { float ov[16]; int oi[16];
          ov[0] = __shfl_xor(cv[15], 32); oi[0] = __shfl_xor(ci[15], 32);
          ov[1] = __shfl_xor(cv[14], 32); oi[1] = __shfl_xor(ci[14], 32);
          ov[2] = __shfl_xor(cv[13], 32); oi[2] = __shfl_xor(ci[13], 32);
          ov[3] = __shfl_xor(cv[12], 32); oi[3] = __shfl_xor(ci[12], 32);
          ov[4] = __shfl_xor(cv[11], 32); oi[4] = __shfl_xor(ci[11], 32);
          ov[5] = __shfl_xor(cv[10], 32); oi[5] = __shfl_xor(ci[10], 32);
          ov[6] = __shfl_xor(cv[9], 32); oi[6] = __shfl_xor(ci[9], 32);
          ov[7] = __shfl_xor(cv[8], 32); oi[7] = __shfl_xor(ci[8], 32);
          ov[8] = __shfl_xor(cv[7], 32); oi[8] = __shfl_xor(ci[7], 32);
          ov[9] = __shfl_xor(cv[6], 32); oi[9] = __shfl_xor(ci[6], 32);
          ov[10] = __shfl_xor(cv[5], 32); oi[10] = __shfl_xor(ci[5], 32);
          ov[11] = __shfl_xor(cv[4], 32); oi[11] = __shfl_xor(ci[4], 32);
          ov[12] = __shfl_xor(cv[3], 32); oi[12] = __shfl_xor(ci[3], 32);
          ov[13] = __shfl_xor(cv[2], 32); oi[13] = __shfl_xor(ci[2], 32);
          ov[14] = __shfl_xor(cv[1], 32); oi[14] = __shfl_xor(ci[1], 32);
          ov[15] = __shfl_xor(cv[0], 32); oi[15] = __shfl_xor(ci[0], 32);
          { const bool s_ = ov[0] > cv[0]; cv[0] = s_ ? ov[0] : cv[0]; ci[0] = s_ ? oi[0] : ci[0]; }
          { const bool s_ = ov[1] > cv[1]; cv[1] = s_ ? ov[1] : cv[1]; ci[1] = s_ ? oi[1] : ci[1]; }
          { const bool s_ = ov[2] > cv[2]; cv[2] = s_ ? ov[2] : cv[2]; ci[2] = s_ ? oi[2] : ci[2]; }
          { const bool s_ = ov[3] > cv[3]; cv[3] = s_ ? ov[3] : cv[3]; ci[3] = s_ ? oi[3] : ci[3]; }
          { const bool s_ = ov[4] > cv[4]; cv[4] = s_ ? ov[4] : cv[4]; ci[4] = s_ ? oi[4] : ci[4]; }
          { const bool s_ = ov[5] > cv[5]; cv[5] = s_ ? ov[5] : cv[5]; ci[5] = s_ ? oi[5] : ci[5]; }
          { const bool s_ = ov[6] > cv[6]; cv[6] = s_ ? ov[6] : cv[6]; ci[6] = s_ ? oi[6] : ci[6]; }
          { const bool s_ = ov[7] > cv[7]; cv[7] = s_ ? ov[7] : cv[7]; ci[7] = s_ ? oi[7] : ci[7]; }
          { const bool s_ = ov[8] > cv[8]; cv[8] = s_ ? ov[8] : cv[8]; ci[8] = s_ ? oi[8] : ci[8]; }
          { const bool s_ = ov[9] > cv[9]; cv[9] = s_ ? ov[9] : cv[9]; ci[9] = s_ ? oi[9] : ci[9]; }
          { const bool s_ = ov[10] > cv[10]; cv[10] = s_ ? ov[10] : cv[10]; ci[10] = s_ ? oi[10] : ci[10]; }
          { const bool s_ = ov[11] > cv[11]; cv[11] = s_ ? ov[11] : cv[11]; ci[11] = s_ ? oi[11] : ci[11]; }
          { const bool s_ = ov[12] > cv[12]; cv[12] = s_ ? ov[12] : cv[12]; ci[12] = s_ ? oi[12] : ci[12]; }
          { const bool s_ = ov[13] > cv[13]; cv[13] = s_ ? ov[13] : cv[13]; ci[13] = s_ ? oi[13] : ci[13]; }
          { const bool s_ = ov[14] > cv[14]; cv[14] = s_ ? ov[14] : cv[14]; ci[14] = s_ ? oi[14] : ci[14]; }
          { const bool s_ = ov[15] > cv[15]; cv[15] = s_ ? ov[15] : cv[15]; ci[15] = s_ ? oi[15] : ci[15]; }
        }
        CEP(cv[0], ci[0], cv[8], ci[8]);
        CEP(cv[1], ci[1], cv[9], ci[9]);
        CEP(cv[2], ci[2], cv[10], ci[10]);
        CEP(cv[3], ci[3], cv[11], ci[11]);
        CEP(cv[4], ci[4], cv[12], ci[12]);
        CEP(cv[5], ci[5], cv[13], ci[13]);
        CEP(cv[6], ci[6], cv[14], ci[14]);
        CEP(cv[7], ci[7], cv[15], ci[15]);
        CEP(cv[0], ci[0], cv[4], ci[4]);
        CEP(cv[1], ci[1], cv[5], ci[5]);
        CEP(cv[2], ci[2], cv[6], ci[6]);
        CEP(cv[3], ci[3], cv[7], ci[7]);
        CEP(cv[8], ci[8], cv[12], ci[12]);
        CEP(cv[9], ci[9], cv[13], ci[13]);
        CEP(cv[10], ci[10], cv[14], ci[14]);
        CEP(cv[11], ci[11], cv[15], ci[15]);
        CEP(cv[0], ci[0], cv[2], ci[2]);
        CEP(cv[1], ci[1], cv[3], ci[3]);
        CEP(cv[4], ci[4], cv[6], ci[6]);
        CEP(cv[5], ci[5], cv[7], ci[7]);
        CEP(cv[8], ci[8], cv[10], ci[10]);
        CEP(cv[9], ci[9], cv[11], ci[11]);
        CEP(cv[12], ci[12], cv[14], ci[14]);
        CEP(cv[13], ci[13], cv[15], ci[15]);
        CEP(cv[0], ci[0], cv[1], ci[1]);
        CEP(cv[2], ci[2], cv[3], ci[3]);
        CEP(cv[4], ci[4], cv[5], ci[5]);
        CEP(cv[6], ci[6], cv[7], ci[7]);
        CEP(cv[8], ci[8], cv[9], ci[9]);
        CEP(cv[10], ci[10], cv[11], ci[11]);
        CEP(cv[12], ci[12], cv[13], ci[13]);
        CEP(cv[14], ci[14], cv[15], ci[15]);
        float ex[16], sum = 0.f;
#pragma unroll
        for (int i = 0; i < 16; ++i) { ex[i] = __expf(cv[i] - cv[0]); sum += ex[i]; }
        const float inv = 1.0f / sum;
        v4u oi4; f32x4 og4;
        oi4[0] = (unsigned)SEL4(g, ci[0], ci[4], ci[8], ci[12]); og4[0] = SEL4(g, ex[0], ex[4], ex[8], ex[12]) * inv;
        oi4[1] = (unsigned)SEL4(g, ci[1], ci[5], ci[9], ci[13]); og4[1] = SEL4(g, ex[1], ex[5], ex[9], ex[13]) * inv;
        oi4[2] = (unsigned)SEL4(g, ci[2], ci[6], ci[10], ci[14]); og4[2] = SEL4(g, ex[2], ex[6], ex[10], ex[14]) * inv;
        oi4[3] = (unsigned)SEL4(g, ci[3], ci[7], ci[11], ci[15]); og4[3] = SEL4(g, ex[3], ex[7], ex[11], ex[15]) * inv;
        { v2u o2; o2.x = oi4[0] | (oi4[1] << 16); o2.y = oi4[2] | (oi4[3] << 16); *(v2u*)(SELI + (size_t)tok * NSEL + h * TOPK + 4 * g) = o2; } *(f32x4*)(SELG + (size_t)tok * NSEL + h * TOPK + 4 * g) = og4;
    }
}

constexpr int NSLICE = 16;
struct DotsPre { v4u idv[2]; v4u xw[2]; float rstd; };
struct AxpyPre { v4u idv[2]; f32x2 hv; };
#define SLICE_EID(idv, i) (((idv)[(i) >> 3][((i) >> 1) & 3] >> (16 * ((i) & 1))) & 0xffffu)
__device__ __forceinline__ void dots_pre(DotsPre& P, const Args& args, int tok, int sl, int lane) {
    const int m = lane & 7, sg = lane >> 3;
    const unsigned short* SELI = (const unsigned short*)W_SLAB(SL_SEL);
    P.idv[0] = *(const v4u*)(SELI + (size_t)tok * NSEL + 16 * sg); P.idv[1] = *(const v4u*)(SELI + (size_t)tok * NSEL + 16 * sg + 8);
    const bf16* xp = W_SLAB(SL_H2B) + (size_t)tok * DM + 128 * sl + 16 * m;
    P.xw[0] = *(const v4u*)xp; P.xw[1] = *(const v4u*)(xp + 8);
    P.rstd = W_RSTD2[tok];
}
__device__ __forceinline__ void axpy_pre(AxpyPre& P, const Args& args, int tok, int sl, int lane) {
    const int m = lane & 7, sg = lane >> 3;
    const unsigned short* SELI = (const unsigned short*)W_SLAB(SL_SEL);
    P.idv[0] = *(const v4u*)(SELI + (size_t)tok * NSEL + 16 * sg); P.idv[1] = *(const v4u*)(SELI + (size_t)tok * NSEL + 16 * sg + 8);
    { const unsigned hw = *(const unsigned*)(W_SLAB(SL_H2B) + (size_t)tok * DM + 128 * sl + 16 * m + 2 * sg); P.hv = (f32x2){bflo(hw), bfhi(hw)}; }
}
__device__ __forceinline__ void slice_rows(v4u (&R)[16], const v4u (&idv)[2], const unsigned char* tb) {
#pragma unroll
    for (int i = 0; i < 16; ++i) R[i] = *(const v4u*)(tb + (size_t)SLICE_EID(idv, i) * DM);
}
__device__ __forceinline__ void dots_comp(const v4u (&R)[16], const DotsPre& P, LAS float* acc_row, bool first, int lane) {
    const bool m4 = lane & 4, m2 = lane & 2, m1 = lane & 1;
    const float rstd = P.rstd;
    f32x2 xs[8];
#pragma unroll
    for (int q = 0; q < 2; ++q)
#pragma unroll
        for (int w = 0; w < 4; ++w) xs[4 * q + w] = (f32x2){bflo(P.xw[q][w]) * rstd, bfhi(P.xw[q][w]) * rstd};
    float p[16];
#pragma unroll
    for (int i = 0; i < 16; ++i) { f32x2 d2 = (f32x2){0.f, 0.f};
#pragma unroll
        for (int w = 0; w < 4; ++w) { d2 += xs[2 * w] * __builtin_amdgcn_cvt_pk_f32_fp8((int)R[i][w], false); d2 += xs[2 * w + 1] * __builtin_amdgcn_cvt_pk_f32_fp8((int)R[i][w], true); }
        p[i] = d2.x + d2.y; }
    float qd4[8];
    { const float kp = m4 ? p[8] : p[0], sd = m4 ? p[0] : p[8]; qd4[0] = kp + __shfl_xor(sd, 4); }
    { const float kp = m4 ? p[9] : p[1], sd = m4 ? p[1] : p[9]; qd4[1] = kp + __shfl_xor(sd, 4); }
    { const float kp = m4 ? p[10] : p[2], sd = m4 ? p[2] : p[10]; qd4[2] = kp + __shfl_xor(sd, 4); }
    { const float kp = m4 ? p[11] : p[3], sd = m4 ? p[3] : p[11]; qd4[3] = kp + __shfl_xor(sd, 4); }
    { const float kp = m4 ? p[12] : p[4], sd = m4 ? p[4] : p[12]; qd4[4] = kp + __shfl_xor(sd, 4); }
    { const float kp = m4 ? p[13] : p[5], sd = m4 ? p[5] : p[13]; qd4[5] = kp + __shfl_xor(sd, 4); }
    { const float kp = m4 ? p[14] : p[6], sd = m4 ? p[6] : p[14]; qd4[6] = kp + __shfl_xor(sd, 4); }
    { const float kp = m4 ? p[15] : p[7], sd = m4 ? p[7] : p[15]; qd4[7] = kp + __shfl_xor(sd, 4); }
    float qd2[4];
    { const float kp = m2 ? qd4[4] : qd4[0], sd = m2 ? qd4[0] : qd4[4]; qd2[0] = kp + __shfl_xor(sd, 2); }
    { const float kp = m2 ? qd4[5] : qd4[1], sd = m2 ? qd4[1] : qd4[5]; qd2[1] = kp + __shfl_xor(sd, 2); }
    { const float kp = m2 ? qd4[6] : qd4[2], sd = m2 ? qd4[2] : qd4[6]; qd2[2] = kp + __shfl_xor(sd, 2); }
    { const float kp = m2 ? qd4[7] : qd4[3], sd = m2 ? qd4[3] : qd4[7]; qd2[3] = kp + __shfl_xor(sd, 2); }
    float qd1[2];
    { const float kp = m1 ? qd2[2] : qd2[0], sd = m1 ? qd2[0] : qd2[2]; qd1[0] = kp + __shfl_xor(sd, 1); }
    { const float kp = m1 ? qd2[3] : qd2[1], sd = m1 ? qd2[1] : qd2[3]; qd1[1] = kp + __shfl_xor(sd, 1); }
    LAS f32x2* ap = (LAS f32x2*)(acc_row + 2 * lane);
    f32x2 o = (f32x2){qd1[0], qd1[1]};
    if (!first) o += *ap;
    *ap = o;
}
__device__ __forceinline__ float axpy_comp(const v4u (&R)[16], const AxpyPre& P, const Args& args, const LAS float* coef_row, int tok, int sl, int lane) {
    const int m = lane & 7, sg = lane >> 3;
    const bool s4 = lane & 32, s2 = lane & 16, s1 = lane & 8;
    f32x4 cf[4];
#pragma unroll
    for (int q = 0; q < 4; ++q) cf[q] = *(const LAS f32x4*)(coef_row + 16 * sg + 4 * q);
    f32x2 a2[8];
#pragma unroll
    for (int w = 0; w < 8; ++w) a2[w] = (f32x2){0.f, 0.f};
#pragma unroll
    for (int i = 0; i < 16; ++i) { const float c = cf[i >> 2][i & 3]; const f32x2 c2 = (f32x2){c, c};
#pragma unroll
        for (int w = 0; w < 4; ++w) { a2[2 * w] += c2 * __builtin_amdgcn_cvt_pk_f32_fp8((int)R[i][w], false); a2[2 * w + 1] += c2 * __builtin_amdgcn_cvt_pk_f32_fp8((int)R[i][w], true); } }
    float acc[16];
#pragma unroll
    for (int w = 0; w < 8; ++w) { acc[2 * w] = a2[w].x; acc[2 * w + 1] = a2[w].y; }
    float qv32[8];
    { const float kp = s4 ? acc[8] : acc[0], sd = s4 ? acc[0] : acc[8]; qv32[0] = kp + __shfl_xor(sd, 32); }
    { const float kp = s4 ? acc[9] : acc[1], sd = s4 ? acc[1] : acc[9]; qv32[1] = kp + __shfl_xor(sd, 32); }
    { const float kp = s4 ? acc[10] : acc[2], sd = s4 ? acc[2] : acc[10]; qv32[2] = kp + __shfl_xor(sd, 32); }
    { const float kp = s4 ? acc[11] : acc[3], sd = s4 ? acc[3] : acc[11]; qv32[3] = kp + __shfl_xor(sd, 32); }
    { const float kp = s4 ? acc[12] : acc[4], sd = s4 ? acc[4] : acc[12]; qv32[4] = kp + __shfl_xor(sd, 32); }
    { const float kp = s4 ? acc[13] : acc[5], sd = s4 ? acc[5] : acc[13]; qv32[5] = kp + __shfl_xor(sd, 32); }
    { const float kp = s4 ? acc[14] : acc[6], sd = s4 ? acc[6] : acc[14]; qv32[6] = kp + __shfl_xor(sd, 32); }
    { const float kp = s4 ? acc[15] : acc[7], sd = s4 ? acc[7] : acc[15]; qv32[7] = kp + __shfl_xor(sd, 32); }
    float qv16[4];
    { const float kp = s2 ? qv32[4] : qv32[0], sd = s2 ? qv32[0] : qv32[4]; qv16[0] = kp + __shfl_xor(sd, 16); }
    { const float kp = s2 ? qv32[5] : qv32[1], sd = s2 ? qv32[1] : qv32[5]; qv16[1] = kp + __shfl_xor(sd, 16); }
    { const float kp = s2 ? qv32[6] : qv32[2], sd = s2 ? qv32[2] : qv32[6]; qv16[2] = kp + __shfl_xor(sd, 16); }
    { const float kp = s2 ? qv32[7] : qv32[3], sd = s2 ? qv32[3] : qv32[7]; qv16[3] = kp + __shfl_xor(sd, 16); }
    float qv8[2];
    { const float kp = s1 ? qv16[2] : qv16[0], sd = s1 ? qv16[0] : qv16[2]; qv8[0] = kp + __shfl_xor(sd, 8); }
    { const float kp = s1 ? qv16[3] : qv16[1], sd = s1 ? qv16[1] : qv16[3]; qv8[1] = kp + __shfl_xor(sd, 8); }
    const f32x2 o = (f32x2){P.hv.x + qv8[0], P.hv.y + qv8[1]};
    *(unsigned*)(W_SLAB(SL_ZA) + (size_t)tok * DM + 128 * sl + 16 * m + 2 * sg) = pk2(o.x, o.y);
    return wave_sum(o.x * o.x + o.y * o.y);
}
constexpr int PEER_TPW = 8;
#define PEER_TOK(n) (tokbase + ((n) & (PEER_TPW - 1)))
#define PEER_SL(n) ((n) / PEER_TPW)
#define DOTS_STEP(RX, RY, PX, PY, n) do { if ((n) < NU) { \
        slice_rows(RY, PY.idv, U8 + 128 * PEER_SL(((n) + 1 < NU) ? (n) + 1 : 0) + 16 * m); __builtin_amdgcn_sched_barrier(0); \
        dots_comp(RX, PX, ACC + ((n) & (PEER_TPW - 1)) * NSEL, PEER_SL(n) == 0, lane); __builtin_amdgcn_sched_barrier(0); \
        { const int n3 = ((n) + 3 < NU) ? (n) + 3 : 0; dots_pre(PX, args, PEER_TOK(n3), PEER_SL(n3), lane); } __builtin_amdgcn_sched_barrier(0); } } while (0)
#define AXPY_STEP(RX, RY, PX, PY, n) do { if ((n) < NU) { \
        slice_rows(RY, PY.idv, V8 + 128 * PEER_SL(((n) + 1 < NU) ? (n) + 1 : 0) + 16 * m); __builtin_amdgcn_sched_barrier(0); \
        { const float q_ = axpy_comp(RX, PX, args, ACC + ((n) & (PEER_TPW - 1)) * NSEL, PEER_TOK(n), PEER_SL(n), lane); \
          if (lane == 0) { LAS float* sp_ = SSQl + ((n) & (PEER_TPW - 1)); *sp_ = (PEER_SL(n) == 0) ? q_ : *sp_ + q_; } } __builtin_amdgcn_sched_barrier(0); \
        { const int n3 = ((n) + 3 < NU) ? (n) + 3 : 0; axpy_pre(PX, args, PEER_TOK(n3), PEER_SL(n3), lane); } __builtin_amdgcn_sched_barrier(0); } } while (0)
__device__ __forceinline__ void peer_phase(Frame& F, const Args& args) {
    const int lane = lane_now(), m = lane & 7;
    LAS float* ACC = (LAS float*)(F.lds + F.wave * 8192);
    LAS float* SSQl = (LAS float*)(F.lds + F.wave * 8192 + 4096);
    const unsigned char* U8 = (const unsigned char*)W_SLAB(SL_UB); const unsigned char* V8 = (const unsigned char*)W_SLAB(SL_VB);
    const int tpw = M / (F.G * NWAVES);
    const int tokbase = (F.vcu * NWAVES + F.wave) * tpw;
    constexpr int NU = NSLICE * PEER_TPW;
    v4u RA[16], RB[16];
    { DotsPre PA, PB, PC;
      dots_pre(PA, args, PEER_TOK(0), PEER_SL(0), lane); dots_pre(PB, args, PEER_TOK(1), PEER_SL(1), lane); dots_pre(PC, args, PEER_TOK(2), PEER_SL(2), lane);
      slice_rows(RA, PA.idv, U8 + 128 * PEER_SL(0) + 16 * m);
      for (int nb = 0; nb < NU; nb += 6) {
          DOTS_STEP(RA, RB, PA, PB, nb); DOTS_STEP(RB, RA, PB, PC, nb + 1); DOTS_STEP(RA, RB, PC, PA, nb + 2);
          DOTS_STEP(RB, RA, PA, PB, nb + 3); DOTS_STEP(RA, RB, PB, PC, nb + 4); DOTS_STEP(RB, RA, PC, PA, nb + 5); } }
    { const unsigned short* SELI = (const unsigned short*)W_SLAB(SL_SEL); const float* SELG = (const float*)(W_SLAB(SL_SEL)) + (size_t)M * NSEL;
#pragma unroll 2
      for (int i = 0; i < PEER_TPW; ++i) { const int tok = tokbase + i;
          const unsigned idw = *(const unsigned*)(SELI + (size_t)tok * NSEL + 2 * lane); const int e0 = (int)(idw & 0xffffu), e1 = (int)(idw >> 16);
          const f32x2 gt = *(const f32x2*)(SELG + (size_t)tok * NSEL + 2 * lane);
          LAS f32x2* ap = (LAS f32x2*)(ACC + i * NSEL + 2 * lane); const f32x2 d = *ap;
          const pg8::f32x2 ge = pg8::gelu_pk((pg8::f32x2){d.x * W_PSC[e0], d.y * W_PSC[e1]});
          *ap = (f32x2){ge.x * gt.x * W_PSC[NEXP + e0], ge.y * gt.y * W_PSC[NEXP + e1]}; } }
    { AxpyPre PA, PB, PC;
      axpy_pre(PA, args, PEER_TOK(0), PEER_SL(0), lane); axpy_pre(PB, args, PEER_TOK(1), PEER_SL(1), lane); axpy_pre(PC, args, PEER_TOK(2), PEER_SL(2), lane);
      slice_rows(RA, PA.idv, V8 + 128 * PEER_SL(0) + 16 * m);
      for (int nb = 0; nb < NU; nb += 6) {
          AXPY_STEP(RA, RB, PA, PB, nb); AXPY_STEP(RB, RA, PB, PC, nb + 1); AXPY_STEP(RA, RB, PC, PA, nb + 2);
          AXPY_STEP(RB, RA, PA, PB, nb + 3); AXPY_STEP(RA, RB, PB, PC, nb + 4); AXPY_STEP(RB, RA, PC, PA, nb + 5); } }
    asm volatile("s_waitcnt vmcnt(0) lgkmcnt(0)" ::: "memory");
    for (int i = 0; i < PEER_TPW; ++i) { const int tok = tokbase + i;
        const float r3 = __builtin_amdgcn_rsqf(SSQl[i] * (1.0f / DM) + EPS);
        const v4u* ur = (const v4u*)(W_SLAB(SL_ZA) + (size_t)tok * DM) + lane;
        f32x4* xr = (f32x4*)(A_out + (size_t)tok * DM); const f32x4* gr = (const f32x4*)A_final_g;
        v4u v[4];
#pragma unroll
        for (int j = 0; j < 4; ++j) v[j] = __builtin_nontemporal_load(ur + 64 * j);
#pragma unroll
        for (int j = 0; j < 4; ++j) { const int e4 = 2 * lane + 128 * j;
            xr[e4] = (f32x4){bflo(v[j].x), bfhi(v[j].x), bflo(v[j].y), bfhi(v[j].y)} * r3 * gr[e4];
            xr[e4 + 1] = (f32x4){bflo(v[j].z), bfhi(v[j].z), bflo(v[j].w), bfhi(v[j].w)} * r3 * gr[e4 + 1]; } }
}

__global__ void __launch_bounds__(NWAVES * 64, 2) fwd_kernel(Args args) {
    extern __shared__ __attribute__((aligned(16))) unsigned char lds[];
    Frame F;
    F.lds = (LAS unsigned char*)lds;
    F.MISC = (volatile LAS unsigned*)(F.lds + MISC_OFF);
    F.wave = __builtin_amdgcn_readfirstlane((int)threadIdx.x >> 6);
    F.G = gridDim.x; { const int bx = blockIdx.x; F.vcu = (F.G % 8 == 0) ? (bx % 8) * (F.G / 8) + bx / 8 : bx; }
    for (int u = F.wave * 64 + lane_now(); u < (LDS_BYTES - LDSCTL_OFF) / 4; u += NWAVES * 64) ((LAS unsigned*)(F.lds + LDSCTL_OFF))[u] = 0u;
    __syncthreads();
    XcdBarrier bar = xcd_barrier_post((unsigned*)(args.ws + WS_CTL) + CW_BAR, F.MISC + 8);
#define ST_ ((bf16*)args.out)
#define GRID_BAR() xcd_barrier(bar)

#define PH_P0() do { p0_prologue(F, args); GRID_BAR(); } while (0)
#define PH_G1() do { { pg8::Gemm gm{W_XN, W_WinT, M, INW, DM, nullptr, nullptr}; pg8::StaticOrder S; S.init(M, INW, F.G, (int)blockIdx.x); \
      pg8::EpiSplit E{W_SLAB(0), DM, DM, (size_t)M * DM}; \
      pg8::gemm_phase<pg8::EpiSplit, pg8::StaticOrder, true, true>(F.lds, gm, S, E, F.wave); } \
    p1_meta(F, args); GRID_BAR(); } while (0)
#define PH_P2A() do { rg_phase<0>(F, args); hg_phase<0>(F, args, ST_); GRID_BAR(); } while (0)
#define PH_G345(QPSLAB) do { \
    p3_convert_uv(F, args); __syncthreads(); \
    { pg8::Gemm gm{W_SLAB(SL_YA), W_WpaT, M, DM, DM, W_SLAB(SL_OG), W_WpbT}; pg8::PairOrder S; S.init(M, DM, F.G, (int)blockIdx.x); \
      pg8::EpiPairGate E{W_SLAB(SL_ZA), W_SLAB(SL_ZB), W_SLAB(SL_MIX), DM}; \
      pg8::gemm_phase<pg8::EpiPairGate, pg8::PairOrder, true, true>(F.lds, gm, S, E, F.wave); } \
    GRID_BAR(); \
    { pg8::Gemm gm{W_SLAB(SL_MIX), W_WoutT, M, DM, DM, nullptr, nullptr}; pg8::StaticOrder S; S.init(M, DM, F.G, (int)blockIdx.x); \
      pg8::EpiResid E{A_x, A_out, W_SLAB(SL_H2B), W_RSP, DM}; \
      pg8::gemm_phase<pg8::EpiResid, pg8::StaticOrder, true, true>(F.lds, gm, S, E, F.wave); } \
    GRID_BAR(); \
    { pg8::Gemm gm{W_SLAB(SL_H2B), W_WqT, M, DM, DM, nullptr, nullptr}; pg8::StaticOrder S; S.init(M, DM, F.G, (int)blockIdx.x); \
      pg8::EpiRowScale E{W_SLAB(QPSLAB), DM, W_RSP, 1.0f / DM, EPS, W_RSTD2}; \
      pg8::gemm_phase<pg8::EpiRowScale, pg8::StaticOrder, true, true>(F.lds, gm, S, E, F.wave); } \
    GRID_BAR(); } while (0)
#define PH_SEL() do { sel_phase(F, args); GRID_BAR(); } while (0)

#if defined(TEST_ONLY)
#if TEST_ONLY == 1
    rg_phase<0>(F, args);
#elif TEST_ONLY == 2
    rg_phase<1>(F, args);
#elif TEST_ONLY == 3
    hg_phase<0>(F, args, ST_);
#elif TEST_ONLY == 4
    hg_phase<1>(F, args, ST_);
#elif TEST_ONLY == 5
    sel_phase(F, args);
#elif TEST_ONLY == 6
    peer_phase(F, args);
#elif TEST_ONLY == 7
    p0_prologue(F, args);
#endif
    return;
#endif
    PH_P0();
#if REPMASK & 1
    PH_P0();
#endif
    PH_G1();
#if REPMASK & 2
    PH_G1();
#endif
#if REPMASK & 64
    rg_phase<0, false, RGVAR>(F, args); GRID_BAR();
#endif
    PH_P2A();
#if REPMASK & 4
    PH_P2A();
#endif
#if REPMASK & 128
    hg_phase<0>(F, args, ST_); GRID_BAR();
#endif
    rg_carry(F, args);
    hg_carry(F, args, ST_);
    GRID_BAR();
#if REPMASK & 256
    rg_phase<1, true>(F, args); GRID_BAR();
#endif
#if REPMASK & 512
    hg_phase<1, true>(F, args, ST_); GRID_BAR();
#endif
    rg_phase<1>(F, args);
    hg_phase<1>(F, args, ST_);
    GRID_BAR();
#if REPMASK & 8
    PH_G345(SL_MIX);
#endif
    PH_G345(SL_QP);
    PH_SEL();
#if REPMASK & 16
    PH_SEL();
#endif
    peer_phase(F, args);
}

extern "C" void kernel_launch(void* const* d_in, const int* in_sizes, int n_in, void* d_out, int out_size, void* d_ws, size_t ws_size, hipStream_t stream) {
    static int grid = 0;
    if (grid == 0) {
        if (n_in != 22 || in_sizes[0] != M * DM || out_size != M * DM || ws_size < WS_END) { fprintf(stderr, "kernel_launch: unexpected shapes (n_in %d in0 %d out %d ws %zu)\n", n_in, n_in > 0 ? in_sizes[0] : -1, out_size, ws_size); grid = -1; return; }
        int dev = 0, cus = 0, per_cu = 0;
        if (hipGetDevice(&dev) != hipSuccess || hipDeviceGetAttribute(&cus, hipDeviceAttributeMultiprocessorCount, dev) != hipSuccess) { grid = -1; return; }
        if (hipFuncSetAttribute((const void*)fwd_kernel, hipFuncAttributeMaxDynamicSharedMemorySize, LDS_BYTES) != hipSuccess) { fprintf(stderr, "kernel_launch: hipFuncSetAttribute failed\n"); grid = -1; return; }
        if (hipOccupancyMaxActiveBlocksPerMultiprocessor(&per_cu, (const void*)fwd_kernel, NWAVES * 64, LDS_BYTES) != hipSuccess || per_cu < 1) { fprintf(stderr, "kernel_launch: occupancy query says %d\n", per_cu); per_cu = 1; }
        (void)hipGetLastError();
        grid = cus;
        if (grid % 8 != 0 || grid > 256) grid = (grid > 256) ? 256 : (grid / 8) * 8;
        if (M / (grid * NWAVES) != PEER_TPW || M % (grid * NWAVES) != 0) { fprintf(stderr, "kernel_launch: built for a 256-CU device (got %d)\n", grid); grid = -1; return; }
    }
    if (grid <= 0) return;
    (void)hipMemsetAsync((char*)d_ws + WS_CTL, 0, CTL_ZERO_BYTES, stream);
    Args a{};
    for (int i = 0; i < 22; ++i) a.in[i] = (const float*)d_in[i];
    a.out = (float*)d_out; a.ws = (unsigned char*)d_ws;
    hipLaunchKernelGGL(fwd_kernel, dim3(grid), dim3(NWAVES * 64), LDS_BYTES, stream, a);
}
```

```cpp
#include <hip/hip_runtime.h>
#include <cstdio>
#include <cstdint>
#define RGVAR 0
#define PROF_SEL 0
#define PROF_AMP 8
#ifndef REPMASK
#define REPMASK 0
#endif
namespace pg8 {
#define PG8_LAS __attribute__((address_space(3)))
typedef unsigned short bf16_t;
typedef short bf16x8 __attribute__((ext_vector_type(8)));
typedef float f32x4 __attribute__((ext_vector_type(4)));
typedef unsigned u32x4 __attribute__((ext_vector_type(4)));
constexpr int BM = 256, BK = 64, HALF = 128, HTB = HALF * BK * 2  , STAGE_BYTES = 8 * HTB, NXCD = 8, WGM = 8;

__host__ __device__ __forceinline__ int lds_byte(int r, int c) { const int st = (r >> 4) * 2 + (c >> 5), rr = r & 15, cc = c & 31, ob = rr * 64 + cc * 2; return st * 1024 + (ob ^ (((ob >> 9) & 1) << 5)); }
__host__ __device__ __forceinline__ void stage_rc(int b, int& R, int& C) { const int st = b / 1024, sb = b % 1024, swz = sb ^ (((sb >> 9) & 1) << 5); R = (st >> 1) * 16 + swz / 64; C = (st & 1) * 32 + (swz % 64) / 2; }
__host__ __device__ __forceinline__ int perm32(int rho) { const int n = rho >> 4, i = rho & 15; return 8 * (i >> 2) + 4 * n + (i & 3); }

__device__ __forceinline__ int lane_now_pg8() { int l; asm volatile("v_mbcnt_lo_u32_b32 %0, -1, 0\n\tv_mbcnt_hi_u32_b32 %0, -1, %0" : "=v"(l)); return l; }
struct Unit { int pm, pn, seg; };
struct Gemm { const bf16_t* A; const bf16_t* Bt; int M, N, K; const bf16_t* A2; const bf16_t* Bt2; };

struct StaticOrder {
    int nM, nN, nwg, G, c;
    __host__ __device__ void init(int M, int N, int G_, int c_) { nM = M / BM; nN = N / BM; nwg = nM * nN; G = G_; c = c_; }
    __host__ __device__ bool next(int i, Unit& u) const {
        const long L = (long)i * G + c; if (L >= nwg) return false;
        int wgid = (int)L; { const int q = nwg / NXCD, r = nwg % NXCD, xcd = wgid % NXCD, off = wgid / NXCD; wgid = (xcd < r ? xcd * (q + 1) : r * (q + 1) + (xcd - r) * q) + off; }
        const int nig = WGM * nN, gid = wgid / nig, fm = gid * WGM, gsz = (nM - fm) < WGM ? (nM - fm) : WGM;
        u.pm = fm + ((wgid % nig) % gsz); u.pn = (wgid % nig) / gsz; u.seg = 0; return true;
    }
    __device__ __forceinline__ void a_ready(const Unit&) const {}
    __device__ __forceinline__ void done(const Unit&) const {}
};
struct PairOrder : StaticOrder {
    __host__ __device__ bool next(int i, Unit& u) const { if (!StaticOrder::next(i >> 1, u)) return false; u.seg = i & 1; return true; }
};

__device__ __forceinline__ unsigned cvt_pk_bf16(float lo, float hi) { unsigned r; asm volatile("v_cvt_pk_bf16_f32 %0, %1, %2" : "=v"(r) : "v"(lo), "v"(hi)); return r; }
typedef float f32x2 __attribute__((ext_vector_type(2)));
__device__ __forceinline__ f32x2 gelu_pk(f32x2 v) {
    const f32x2 av = __builtin_elementwise_abs(v), d = av * 0.2316418882f + 1.0f;
    f32x2 t; t.x = __builtin_amdgcn_rcpf(d.x); t.y = __builtin_amdgcn_rcpf(d.y);
    f32x2 q = t * 0.5307027145f + (-0.7265760135f); q = q * t + 0.7107068705f; q = q * t + (-0.142248368f); q = q * t + 0.127414796f; q = q * t;
    const f32x2 s = (v * v) * (-0.72134752044f);
    f32x2 e; e.x = __builtin_amdgcn_exp2f(s.x); e.y = __builtin_amdgcn_exp2f(s.y);
    const f32x2 m = v * (q * e), r = v - m;
    f32x2 o; o.x = v.x < 0.f ? m.x : r.x; o.y = v.y < 0.f ? m.y : r.y; return o;
}

__device__ __forceinline__ float bf_lo(unsigned w) { return __uint_as_float(w << 16); }
__device__ __forceinline__ float bf_hi(unsigned w) { return __uint_as_float(w & 0xffff0000u); }
__device__ __forceinline__ float sigmoidf_(float x) { return __builtin_amdgcn_rcpf(1.0f + __expf(-x)); }
typedef unsigned u32x2 __attribute__((ext_vector_type(2)));

struct EpiSplit {
    static constexpr bool PERM = true, AFTER_DRAIN = false, PAIRED = false;
    bf16_t* O; int ldc; int split_cols; size_t split_stride;
    __device__ __forceinline__ void operator()(const f32x4 (&acc)[2][2][4][2], const Unit& u, int wr, int wc, int fr, int fq) const {
        const int row0 = u.pm * BM + wr * 64 + fr; int colt = u.pn * BM; bf16_t* base = O;
        if (split_cols) { const int t = colt / split_cols; base += (size_t)t * split_stride; colt -= t * split_cols; }
        const int col0 = colt + wc * 32 + 8 * fq;
#pragma unroll
        for (int ai = 0; ai < 2; ++ai)
#pragma unroll
            for (int m = 0; m < 4; ++m) { bf16_t* rowp = base + (size_t)(row0 + ai * HALF + m * 16) * ldc + col0;
#pragma unroll
                for (int bj = 0; bj < 2; ++bj) { const f32x4 v0 = acc[ai][bj][m][0], v1 = acc[ai][bj][m][1];
                    u32x4 w; w.x = cvt_pk_bf16(v0[0], v0[1]); w.y = cvt_pk_bf16(v0[2], v0[3]); w.z = cvt_pk_bf16(v1[0], v1[1]); w.w = cvt_pk_bf16(v1[2], v1[3]);
                    *(u32x4*)(rowp + bj * HALF) = w; } }
    }
};
struct EpiRowScale {
    static constexpr bool PERM = true, AFTER_DRAIN = false, PAIRED = false;
    bf16_t* O; int ldc; const float* rsp; float inv_n, eps; float* rstd_out;
    __device__ __forceinline__ void operator()(const f32x4 (&acc)[2][2][4][2], const Unit& u, int wr, int wc, int fr, int fq) const {
        const int row0 = u.pm * BM + wr * 64 + fr; const int col0 = u.pn * BM + wc * 32 + 8 * fq;
#pragma unroll
        for (int ai = 0; ai < 2; ++ai) {
            f32x4 t[4][2];
#pragma unroll
            for (int m = 0; m < 4; ++m) { const f32x4* rp = (const f32x4*)(rsp + (size_t)(row0 + ai * HALF + m * 16) * 32) + 2 * fq; t[m][0] = rp[0]; t[m][1] = rp[1]; }
            __builtin_amdgcn_sched_barrier(0);
#pragma unroll
            for (int m = 0; m < 4; ++m) { const int row = row0 + ai * HALF + m * 16; bf16_t* rowp = O + (size_t)row * ldc + col0;
                float ss = ((t[m][0][0] + t[m][0][1]) + (t[m][0][2] + t[m][0][3])) + ((t[m][1][0] + t[m][1][1]) + (t[m][1][2] + t[m][1][3]));
                ss += __shfl_xor(ss, 16); ss += __shfl_xor(ss, 32);
                const float sc = __builtin_amdgcn_rsqf(ss * inv_n + eps);
                if (u.pn == 0 && wc == 0 && fq == 0) rstd_out[row] = sc;
#pragma unroll
                for (int bj = 0; bj < 2; ++bj) { const f32x4 v0 = acc[ai][bj][m][0] * sc, v1 = acc[ai][bj][m][1] * sc;
                    u32x4 w; w.x = cvt_pk_bf16(v0[0], v0[1]); w.y = cvt_pk_bf16(v0[2], v0[3]); w.z = cvt_pk_bf16(v1[0], v1[1]); w.w = cvt_pk_bf16(v1[2], v1[3]);
                    *(u32x4*)(rowp + bj * HALF) = w; } }
        }
    }
};
struct EpiGateF32 {
    static constexpr bool PERM = false, AFTER_DRAIN = false, PAIRED = false;
    bf16_t* C; const bf16_t* Z; int ldc;
    __device__ __forceinline__ void operator()(const f32x4 (&acc)[2][2][4][2], const Unit& u, int wr, int wc, int fr, int fq) const {
        const int row0 = u.pm * BM + wr * 64 + fr, col0 = u.pn * BM + wc * 32 + 4 * fq;
#pragma unroll
        for (int ai = 0; ai < 2; ++ai)
#pragma unroll
            for (int m = 0; m < 4; ++m) { const size_t off = (size_t)(row0 + ai * HALF + m * 16) * ldc + col0;
#pragma unroll
                for (int bj = 0; bj < 2; ++bj)
#pragma unroll
                    for (int n = 0; n < 2; ++n) { const u32x2 z = *(const u32x2*)(Z + off + bj * HALF + n * 16);
                        const f32x4 g = (f32x4){sigmoidf_(bf_lo(z.x)), sigmoidf_(bf_hi(z.x)), sigmoidf_(bf_lo(z.y)), sigmoidf_(bf_hi(z.y))};
                        const f32x4 t = acc[ai][bj][m][n] * g; u32x2 w; w.x = cvt_pk_bf16(t[0], t[1]); w.y = cvt_pk_bf16(t[2], t[3]); *(u32x2*)(C + off + bj * HALF + n * 16) = w; } }
    }
};
struct EpiMerge {
    static constexpr bool PERM = false, AFTER_DRAIN = false, PAIRED = false;
    const bf16_t* T1; const bf16_t* Z; bf16_t* O; int ldc;
    __device__ __forceinline__ void operator()(const f32x4 (&acc)[2][2][4][2], const Unit& u, int wr, int wc, int fr, int fq) const {
        const int row0 = u.pm * BM + wr * 64 + fr, col0 = u.pn * BM + wc * 32 + 4 * fq;
#pragma unroll
        for (int ai = 0; ai < 2; ++ai)
#pragma unroll
            for (int m = 0; m < 4; ++m) { const size_t off = (size_t)(row0 + ai * HALF + m * 16) * ldc + col0;
#pragma unroll
                for (int bj = 0; bj < 2; ++bj)
#pragma unroll
                    for (int n = 0; n < 2; ++n) { const u32x2 z = *(const u32x2*)(Z + off + bj * HALF + n * 16); const u32x2 tw = *(const u32x2*)(T1 + off + bj * HALF + n * 16); const f32x4 t1 = (f32x4){bf_lo(tw.x), bf_hi(tw.x), bf_lo(tw.y), bf_hi(tw.y)};
                        const f32x4 g = (f32x4){sigmoidf_(bf_lo(z.x)), sigmoidf_(bf_hi(z.x)), sigmoidf_(bf_lo(z.y)), sigmoidf_(bf_hi(z.y))};
                        const f32x4 o = t1 + acc[ai][bj][m][n] * g; u32x2 w; w.x = cvt_pk_bf16(o[0], o[1]); w.y = cvt_pk_bf16(o[2], o[3]);
                        *(u32x2*)(O + off + bj * HALF + n * 16) = w; } }
    }
};
struct EpiPairGate {
    static constexpr bool PERM = false, AFTER_DRAIN = false, PAIRED = true;
    const bf16_t* ZA; const bf16_t* ZB; bf16_t* O; int ldc;
    __device__ __forceinline__ void mid(f32x4 (&acc)[2][2][4][2], const Unit& u, int wr, int wc, int fr, int fq) const {
        const int row0 = u.pm * BM + wr * 64 + fr, col0 = u.pn * BM + wc * 32 + 4 * fq;
#pragma unroll
        for (int ai = 0; ai < 2; ++ai)
#pragma unroll
            for (int mp = 0; mp < 2; ++mp) {
                u32x2 za[2][2][2], zb[2][2][2];
#pragma unroll
                for (int mm = 0; mm < 2; ++mm) { const size_t off = (size_t)(row0 + ai * HALF + (2 * mp + mm) * 16) * ldc + col0;
#pragma unroll
                    for (int bj = 0; bj < 2; ++bj)
#pragma unroll
                        for (int n = 0; n < 2; ++n) { za[mm][bj][n] = *(const u32x2*)(ZA + off + bj * HALF + n * 16); zb[mm][bj][n] = *(const u32x2*)(ZB + off + bj * HALF + n * 16); } }
                __builtin_amdgcn_sched_barrier(0);
#pragma unroll
                for (int mm = 0; mm < 2; ++mm)
#pragma unroll
                    for (int bj = 0; bj < 2; ++bj)
#pragma unroll
                        for (int n = 0; n < 2; ++n) { const u32x2 a = za[mm][bj][n], b = zb[mm][bj][n];
                            const f32x4 ra = (f32x4){sigmoidf_(bf_lo(a.x)), sigmoidf_(bf_hi(a.x)), sigmoidf_(bf_lo(a.y)), sigmoidf_(bf_hi(a.y))};
                            const f32x4 ib = (f32x4){1.0f + __expf(-fmaxf(bf_lo(b.x), -30.f)), 1.0f + __expf(-fmaxf(bf_hi(b.x), -30.f)), 1.0f + __expf(-fmaxf(bf_lo(b.y), -30.f)), 1.0f + __expf(-fmaxf(bf_hi(b.y), -30.f))};
                            acc[ai][bj][2 * mp + mm][n] = acc[ai][bj][2 * mp + mm][n] * ra * ib; }
            }
    }
    __device__ __forceinline__ void operator()(const f32x4 (&acc)[2][2][4][2], const Unit& u, int wr, int wc, int fr, int fq) const {
        const int row0 = u.pm * BM + wr * 64 + fr, col0 = u.pn * BM + wc * 32 + 4 * fq;
#pragma unroll
        for (int ai = 0; ai < 2; ++ai) {
            u32x2 zb[4][2][2];
#pragma unroll
            for (int m = 0; m < 4; ++m) { const size_t off = (size_t)(row0 + ai * HALF + m * 16) * ldc + col0;
#pragma unroll
                for (int bj = 0; bj < 2; ++bj)
#pragma unroll
                    for (int n = 0; n < 2; ++n) zb[m][bj][n] = *(const u32x2*)(ZB + off + bj * HALF + n * 16); }
            __builtin_amdgcn_sched_barrier(0);
#pragma unroll
            for (int m = 0; m < 4; ++m) { const size_t off = (size_t)(row0 + ai * HALF + m * 16) * ldc + col0;
#pragma unroll
                for (int bj = 0; bj < 2; ++bj)
#pragma unroll
                    for (int n = 0; n < 2; ++n) { const u32x2 b = zb[m][bj][n];
                        const f32x4 g = (f32x4){sigmoidf_(fmaxf(bf_lo(b.x), -30.f)), sigmoidf_(fmaxf(bf_hi(b.x), -30.f)), sigmoidf_(fmaxf(bf_lo(b.y), -30.f)), sigmoidf_(fmaxf(bf_hi(b.y), -30.f))};
                        const f32x4 o = acc[ai][bj][m][n] * g; u32x2 w; w.x = cvt_pk_bf16(o[0], o[1]); w.y = cvt_pk_bf16(o[2], o[3]);
                        *(u32x2*)(O + off + bj * HALF + n * 16) = w; } }
        }
    }
};
struct EpiResid {
    static constexpr bool PERM = false, AFTER_DRAIN = false, PAIRED = false;
    const float* X; float* H2; bf16_t* H2B; float* rsp; int ldc;
    __device__ __forceinline__ void operator()(const f32x4 (&acc)[2][2][4][2], const Unit& u, int wr, int wc, int fr, int fq) const {
        const int row0 = u.pm * BM + wr * 64 + fr, col0 = u.pn * BM + wc * 32 + 4 * fq;
#pragma unroll
        for (int ai = 0; ai < 2; ++ai)
#pragma unroll
            for (int mp = 0; mp < 2; ++mp) {
                f32x4 xv[2][2][2];
#pragma unroll
                for (int mm = 0; mm < 2; ++mm) { const size_t off = (size_t)(row0 + ai * HALF + (2 * mp + mm) * 16) * ldc + col0;
#pragma unroll
                    for (int bj = 0; bj < 2; ++bj)
#pragma unroll
                        for (int n = 0; n < 2; ++n) xv[mm][bj][n] = *(const f32x4*)(X + off + bj * HALF + n * 16); }
                __builtin_amdgcn_sched_barrier(0);
#pragma unroll
                for (int mm = 0; mm < 2; ++mm) { const int m = 2 * mp + mm; const int row = row0 + ai * HALF + m * 16; const size_t off = (size_t)row * ldc + col0; float ss = 0.f;
#pragma unroll
                    for (int bj = 0; bj < 2; ++bj)
#pragma unroll
                        for (int n = 0; n < 2; ++n) { const f32x4 o = xv[mm][bj][n] + acc[ai][bj][m][n];
                            ss += (o[0] * o[0] + o[1] * o[1]) + (o[2] * o[2] + o[3] * o[3]);
                            u32x2 w; w.x = cvt_pk_bf16(o[0], o[1]); w.y = cvt_pk_bf16(o[2], o[3]); *(u32x2*)(H2B + off + bj * HALF + n * 16) = w; }
                    ss += __shfl_xor(ss, 16); ss += __shfl_xor(ss, 32);
                    if (fq == 0) rsp[(size_t)row * 32 + 4 * u.pn + wc] = ss; }
            }
    }
};

template <class Epi, class Sched, bool ALIGN_EPI = false, bool SP2 = false>
__device__ __forceinline__ void gemm_phase(PG8_LAS unsigned char* lds, const Gemm g, const Sched& S, const Epi& E, const int wid) {
    const int lane = lane_now_pg8(), tid = wid * 64 + lane, wr = wid >> 2, wc = wid & 3, fr = lane & 15, fq = lane >> 4;
    const int K = g.K, nt = K / BK;
    unsigned voffA[2], voffB[2];
#pragma unroll
    for (int i = 0; i < 2; ++i) { int R, C; stage_rc(tid * 16 + i * 8192, R, C); const int Rb = Epi::PERM ? ((R & ~31) + perm32(R & 31)) : R;
        voffA[i] = (unsigned)(R * K + C) * 2u; voffB[i] = (unsigned)(Rb * K + C) * 2u; }
    const size_t kstep = (size_t)(BK * 2);
    const size_t hstep = (size_t)HALF * K * 2;
    const size_t tstep = 2 * hstep;
    const unsigned ldsw = (unsigned)wid * 1024u;
    const int aoff = lds_byte(wr * 64 + fr, fq * 8), boff = lds_byte(wc * 32 + fr, fq * 8);
#define PG8_SA(b, h) (((b) * 2 + (h)) * HTB)
#define PG8_SB(b, h) ((4 + (b) * 2 + (h)) * HTB)
#define PG8_STAGE(bufoff, gbase, voff) do { _Pragma("unroll") for (int _i = 0; _i < 2; ++_i) \
        __builtin_amdgcn_global_load_lds((const unsigned*)((const char*)(gbase) + (voff)[_i]), (PG8_LAS unsigned*)(lds + (bufoff) + ldsw + _i * 8192), 16, 0, 0); } while (0)
#define PG8_LDA(dst, b, h) do { _Pragma("unroll") for (int m = 0; m < 4; ++m) _Pragma("unroll") for (int k = 0; k < 2; ++k) dst[m][k] = *(const PG8_LAS bf16x8*)(lds + PG8_SA(b, h) + aoff + m * 2048 + k * 1024); } while (0)
#define PG8_LDB(dst, b, h) do { _Pragma("unroll") for (int n = 0; n < 2; ++n) _Pragma("unroll") for (int k = 0; k < 2; ++k) dst[n][k] = *(const PG8_LAS bf16x8*)(lds + PG8_SB(b, h) + boff + n * 2048 + k * 1024); } while (0)
#define PG8_MMA(ai, bj, At, Bt) do { __builtin_amdgcn_s_setprio(1); _Pragma("unroll") for (int m = 0; m < 4; ++m) _Pragma("unroll") for (int n = 0; n < 2; ++n) _Pragma("unroll") for (int k = 0; k < 2; ++k) \
        acc[ai][bj][m][n] = __builtin_amdgcn_mfma_f32_16x16x32_bf16(Bt[n][k], At[m][k], acc[ai][bj][m][n], 0, 0, 0); __builtin_amdgcn_s_setprio(0); } while (0)
#define PG8_WAIT_V(n) asm volatile("s_waitcnt vmcnt(" #n ")" ::: "memory")
#define PG8_WAIT_L(n) asm volatile("s_waitcnt lgkmcnt(" #n ")" ::: "memory")
#define PG8_BAR __builtin_amdgcn_s_barrier()
#define PG8_SCHED __builtin_amdgcn_sched_barrier(0)
    Unit cur, nxt; int ui = 0;
    if (!S.next(0, cur)) return;
    f32x4 acc[2][2][4][2];
#pragma unroll
    for (int a = 0; a < 2; ++a)
#pragma unroll
        for (int b = 0; b < 2; ++b)
#pragma unroll
            for (int m = 0; m < 4; ++m)
#pragma unroll
                for (int n = 0; n < 2; ++n) acc[a][b][m][n] = (f32x4){0.f, 0.f, 0.f, 0.f};
    bf16x8 At[4][2], B0[2][2], B1[2][2];
    const char* cA = (const char*)(cur.seg ? g.A2 : g.A) + (size_t)cur.pm * tstep; const char* cB = (const char*)(cur.seg ? g.Bt2 : g.Bt) + (size_t)cur.pn * tstep;
    S.a_ready(cur);
    if constexpr (SP2) {
        PG8_STAGE(PG8_SB(0, 0), cB, voffB); PG8_STAGE(PG8_SB(0, 1), cB + hstep, voffB); PG8_STAGE(PG8_SA(0, 0), cA, voffA); PG8_STAGE(PG8_SA(0, 1), cA + hstep, voffA);
        if (wr == 1) PG8_BAR;
        PG8_WAIT_V(2); PG8_BAR;
        PG8_STAGE(PG8_SB(1, 0), cB + kstep, voffB); PG8_STAGE(PG8_SA(1, 0), cA + kstep, voffA); PG8_STAGE(PG8_SB(1, 1), cB + hstep + kstep, voffB);
        PG8_WAIT_V(6); PG8_BAR;
    } else {
        PG8_STAGE(PG8_SB(0, 0), cB, voffB); PG8_STAGE(PG8_SA(0, 0), cA, voffA); PG8_STAGE(PG8_SB(0, 1), cB + hstep, voffB); PG8_STAGE(PG8_SA(0, 1), cA + hstep, voffA);
        if (wr == 1) PG8_BAR;
        PG8_WAIT_V(4); PG8_BAR;
        PG8_STAGE(PG8_SB(1, 0), cB + kstep, voffB); PG8_STAGE(PG8_SA(1, 0), cA + kstep, voffA); PG8_STAGE(PG8_SB(1, 1), cB + hstep + kstep, voffB);
        PG8_WAIT_V(6); PG8_BAR;
    }
    for (;;) {
        const bool has_next = S.next(ui + 1, nxt);
        const char* nA = has_next ? (const char*)(nxt.seg ? g.A2 : g.A) + (size_t)nxt.pm * tstep : cA; const char* nB = has_next ? (const char*)(nxt.seg ? g.Bt2 : g.Bt) + (size_t)nxt.pn * tstep : cB;
        for (int t = 0; t < nt; t += 2) {
            const bool last = (t == nt - 2);
            const char* a1 = cA + (size_t)(t + 1) * kstep;
            const char* a2 = last ? nA : cA + (size_t)(t + 2) * kstep; const char* b2 = last ? nB : cB + (size_t)(t + 2) * kstep;
            const char* a3 = a2 + kstep; const char* b3 = b2 + kstep;
            if (last && has_next) S.a_ready(nxt);
            if constexpr (SP2) {
            PG8_LDB(B0, 0, 0); PG8_LDB(B1, 0, 1); PG8_SCHED; PG8_LDA(At, 0, 0); PG8_STAGE(PG8_SA(1, 1), a1 + hstep, voffA);
            PG8_WAIT_V(8); PG8_WAIT_L(0); PG8_BAR; PG8_MMA(0, 0, At, B0); PG8_MMA(0, 1, At, B1); PG8_BAR; PG8_SCHED;
            PG8_LDA(At, 0, 1); PG8_STAGE(PG8_SB(0, 0), b2, voffB); PG8_STAGE(PG8_SB(0, 1), b2 + hstep, voffB); PG8_STAGE(PG8_SA(0, 0), a2, voffA);
            PG8_WAIT_V(8); PG8_WAIT_L(0); PG8_BAR; PG8_MMA(1, 0, At, B0); PG8_MMA(1, 1, At, B1); PG8_BAR; PG8_SCHED;
            PG8_LDB(B0, 1, 0); PG8_LDB(B1, 1, 1); PG8_SCHED; PG8_LDA(At, 1, 0); PG8_STAGE(PG8_SA(0, 1), a2 + hstep, voffA);
            PG8_WAIT_V(8); PG8_WAIT_L(0); PG8_BAR; PG8_MMA(0, 0, At, B0); PG8_MMA(0, 1, At, B1); PG8_BAR; PG8_SCHED;
            PG8_LDA(At, 1, 1); PG8_STAGE(PG8_SB(1, 0), b3, voffB); PG8_STAGE(PG8_SB(1, 1), b3 + hstep, voffB); PG8_STAGE(PG8_SA(1, 0), a3, voffA);
            PG8_WAIT_V(8); PG8_WAIT_L(0); PG8_BAR; PG8_MMA(1, 0, At, B0); PG8_MMA(1, 1, At, B1); PG8_BAR; PG8_SCHED;
            } else {
            PG8_LDB(B0, 0, 0); PG8_SCHED; PG8_LDA(At, 0, 0); PG8_STAGE(PG8_SA(1, 1), a1 + hstep, voffA);
            PG8_WAIT_L(8); PG8_BAR; PG8_WAIT_L(0); PG8_MMA(0, 0, At, B0); PG8_BAR; PG8_SCHED;
            PG8_LDB(B1, 0, 1); PG8_STAGE(PG8_SB(0, 0), b2, voffB);
            PG8_BAR; PG8_WAIT_L(0); PG8_MMA(0, 1, At, B1); PG8_BAR;
            PG8_LDA(At, 0, 1); PG8_STAGE(PG8_SA(0, 0), a2, voffA);
            PG8_BAR; PG8_WAIT_L(0); PG8_MMA(1, 0, At, B0); PG8_BAR; PG8_SCHED;
            PG8_STAGE(PG8_SB(0, 1), b2 + hstep, voffB);
            PG8_WAIT_V(6); PG8_BAR; PG8_MMA(1, 1, At, B1); PG8_BAR;
            PG8_LDB(B0, 1, 0); PG8_SCHED; PG8_LDA(At, 1, 0); PG8_STAGE(PG8_SA(0, 1), a2 + hstep, voffA);
            PG8_WAIT_L(8); PG8_BAR; PG8_WAIT_L(0); PG8_MMA(0, 0, At, B0); PG8_BAR; PG8_SCHED;
            PG8_LDB(B1, 1, 1); PG8_STAGE(PG8_SB(1, 0), b3, voffB);
            PG8_BAR; PG8_WAIT_L(0); PG8_MMA(0, 1, At, B1); PG8_BAR;
            PG8_LDA(At, 1, 1); PG8_STAGE(PG8_SA(1, 0), a3, voffA);
            PG8_BAR; PG8_WAIT_L(0); PG8_MMA(1, 0, At, B0); PG8_BAR; PG8_SCHED;
            PG8_STAGE(PG8_SB(1, 1), b3 + hstep, voffB);
            PG8_WAIT_V(6); PG8_BAR; PG8_MMA(1, 1, At, B1); PG8_BAR;
            }
        }
        if constexpr (ALIGN_EPI) { if (wr == 0) PG8_BAR; }
        bool keep = false;
        if constexpr (Epi::PAIRED) { if (cur.seg == 0) { E.mid(acc, cur, wr, wc, fr, fq); keep = true; } else E(acc, cur, wr, wc, fr, fq); S.done(cur); }
        else if constexpr (!Epi::AFTER_DRAIN) { E(acc, cur, wr, wc, fr, fq); S.done(cur); }
        if (!has_next) break;
        if (!keep)
#pragma unroll
        for (int a = 0; a < 2; ++a)
#pragma unroll
            for (int b = 0; b < 2; ++b)
#pragma unroll
                for (int m = 0; m < 4; ++m)
#pragma unroll
                    for (int n = 0; n < 2; ++n) acc[a][b][m][n] = (f32x4){0.f, 0.f, 0.f, 0.f};
        cur = nxt; cA = nA; cB = nB; ++ui;
        if constexpr (ALIGN_EPI) { if (wr == 1) PG8_BAR; }
    }
    PG8_WAIT_V(0);
    if constexpr (!ALIGN_EPI) { if (wr == 0) PG8_BAR; }
    PG8_BAR;
    if constexpr (Epi::AFTER_DRAIN) { E.fused(acc, cur, wr, wc, fr, fq, lds, wid, lane); S.done(cur); }
#undef PG8_SA
#undef PG8_SB
#undef PG8_STAGE
#undef PG8_LDA
#undef PG8_LDB
#undef PG8_MMA
#undef PG8_WAIT_V
#undef PG8_WAIT_L
#undef PG8_BAR
#undef PG8_SCHED
}
}


constexpr int NWAVES = 8;
constexpr int DM = 2048, BATCH = 4, SEQ = 4096, M = BATCH * SEQ, NMETA = 16, INW = 16384;
constexpr int NH = 16, HD = 128, CH = 64, NCH = SEQ / CH;
constexpr int PH = 8, NKEY = 128, TOPK = 16, NEXP = NKEY * NKEY, NSEL = PH * TOPK;
constexpr float EPS = 1e-6f;

constexpr size_t MiB = 1u << 20;
constexpr size_t WS_CTL = 0, CTL_ZERO_BYTES = 1 * MiB;
constexpr size_t SLAB_BYTES = (size_t)M * DM * 2;
constexpr size_t WS_SLAB = 1 * MiB;
constexpr size_t WS_WPA = 513 * MiB, WS_WPB = 521 * MiB, WS_WOUT = 529 * MiB, WS_WQ = 537 * MiB;
constexpr size_t WS_KEYS = 545 * MiB, WS_WA = WS_KEYS + 512 * 1024, WS_WX = WS_WA + 512 * 1024;
constexpr size_t WS_METAPROJ = 547 * MiB, WS_XNMETA = WS_METAPROJ + 512 * 1024;
constexpr size_t WS_RGSUM = 548 * MiB;
constexpr size_t WS_RGHIN = 553 * MiB;
constexpr size_t WS_HGDEC = 556 * MiB;
constexpr size_t WS_HGMETA = 559 * MiB;
constexpr size_t WS_RSP = 561 * MiB;
constexpr size_t WS_PSC = 563 * MiB;
constexpr size_t WS_END = 564 * MiB;
constexpr int SL_XA = 0, SL_YA = 1, SL_Q = 2, SL_F = 3, SL_I = 4, SL_OG = 5, SL_ZA = 6, SL_ZB = 7;
constexpr int SL_UB = 0, SL_VB = 2, SL_MIX = 3, SL_H2B = 4, SL_QP = 1, SL_SEL = 5;
constexpr int CW_BAR = 4096;

constexpr int RING_BYTES = 131072;
constexpr int LDS_BYTES = 147456;
constexpr int LDSCTL_OFF = LDS_BYTES - 1024, MISC_OFF = LDSCTL_OFF + 320;

#define LAS __attribute__((address_space(3)))
typedef unsigned short bf16;
typedef unsigned v4u __attribute__((ext_vector_type(4)));
typedef unsigned v2u __attribute__((ext_vector_type(2)));
typedef float f32x4 __attribute__((ext_vector_type(4)));
typedef float f32x2 __attribute__((ext_vector_type(2)));
typedef short bf16x8 __attribute__((ext_vector_type(8)));
#define LDS_WAIT() asm volatile("s_waitcnt lgkmcnt(0)" ::: "memory")
__device__ __forceinline__ int lane_now() { int l; asm volatile("v_mbcnt_lo_u32_b32 %0, -1, 0\n\tv_mbcnt_hi_u32_b32 %0, -1, %0" : "=v"(l)); return l; }
#define VM_WAIT() asm volatile("s_waitcnt vmcnt(0)" ::: "memory")
__device__ __forceinline__ unsigned f2bf(float f) { unsigned u = __builtin_bit_cast(unsigned, f); return (u + 0x7fffu + ((u >> 16) & 1u)) >> 16; }
__device__ __forceinline__ unsigned pk2(float lo, float hi) { unsigned r; asm("v_cvt_pk_bf16_f32 %0, %1, %2" : "=v"(r) : "v"(lo), "v"(hi)); return r; }
__device__ __forceinline__ float bflo(unsigned w) { return __uint_as_float(w << 16); }
__device__ __forceinline__ float bfhi(unsigned w) { return __uint_as_float(w & 0xffff0000u); }
__device__ __forceinline__ float bf1(bf16 h) { return __uint_as_float(((unsigned)h) << 16); }
__device__ __forceinline__ float sigm(float x) { return __builtin_amdgcn_rcpf(1.0f + __builtin_amdgcn_exp2f(-1.44269504f * x)); }
__device__ __forceinline__ float gelu1(float v) { pg8::f32x2 t; t.x = v; t.y = 0.f; t = pg8::gelu_pk(t); return t.x; }

#define XB_TMO      128
#define XB_XCNT(j)  (256  + 64 * (j))
#define XB_XSUB(j)  (1280 + 64 * (j))
#define XB_XGEN(j)  (2304 + 64 * (j))
#define XB_TOP      3328
#define XB_TOPGEN   3392
#define XCD_BAR_WORDS 3456
#define XB_SPIN_CAP (1u << 18)
__device__ __forceinline__ unsigned xb_ld(unsigned* p)              { return __hip_atomic_load(p, __ATOMIC_RELAXED, __HIP_MEMORY_SCOPE_AGENT); }
__device__ __forceinline__ unsigned xb_add(unsigned* p, unsigned v) { return __hip_atomic_fetch_add(p, v, __ATOMIC_RELAXED, __HIP_MEMORY_SCOPE_AGENT); }
__device__ __forceinline__ unsigned xb_xcc_id() { return (unsigned)__builtin_amdgcn_s_getreg((3 << 11) | 20) & 0xFu; }
#define XB_SPIN(cond, bar) do { unsigned _sp = 0; while (cond) { __builtin_amdgcn_s_sleep(1); \
    if ((++_sp & 255u) == 0u) { if (xb_ld(&(bar)[XB_TMO])) break; if (_sp > XB_SPIN_CAP) { atomicAdd(&(bar)[XB_TMO], 1u); break; } } } } while (0)
struct XcdBarrier { unsigned* bar; unsigned x; volatile LAS unsigned* st; int wave; };
__device__ __forceinline__ XcdBarrier xcd_barrier_post(unsigned* bar, volatile LAS unsigned* st) {
    XcdBarrier b; b.bar = bar; b.x = xb_xcc_id(); b.st = st; b.wave = __builtin_amdgcn_readfirstlane((int)threadIdx.x >> 6);
    if (threadIdx.x == 0) (void)xb_add(&bar[XB_XCNT(b.x)], 1u);
    return b;
}
__device__ __forceinline__ void xcd_barrier_complete(unsigned* bar, unsigned x, unsigned& nloc, unsigned& nx) {
    const unsigned G = gridDim.x * gridDim.y * gridDim.z;
    unsigned sum, cnt, mine, sp = 0u;
    for (;;) {
        sum = 0u; cnt = 0u; mine = 0u;
#pragma unroll
        for (unsigned j = 0; j < 16; ++j) { const unsigned c = xb_ld(&bar[XB_XCNT(j)]); sum += c; cnt += (c > 0u) ? 1u : 0u; mine = (j == x) ? c : mine; }
        if (sum == G) break;
        __builtin_amdgcn_s_sleep(1);
        if ((++sp & 255u) == 0u) { if (xb_ld(&bar[XB_TMO])) break; if (sp > XB_SPIN_CAP) { atomicAdd(&bar[XB_TMO], 1u); break; } }
    }
    nloc = mine > 0u ? mine : 1u; nx = cnt > 0u ? cnt : 1u;
}
__device__ __forceinline__ void xcd_barrier(const XcdBarrier& b) {
    asm volatile("s_waitcnt vmcnt(0)" ::: "memory");
    __syncthreads();
    if (b.wave == 0 && lane_now() == 0) {
        unsigned* bar = b.bar;
        __builtin_amdgcn_s_waitcnt(0);
        unsigned nloc = b.st[0], nx = b.st[1];
        if (nloc == 0u) { xcd_barrier_complete(bar, b.x, nloc, nx); b.st[0] = nloc; b.st[1] = nx; }
        const unsigned old = xb_add(&bar[XB_XSUB(b.x)], 1u);
        const unsigned gen = old / nloc;
        if (old + 1u == (gen + 1u) * nloc) {
            __builtin_amdgcn_fence(__ATOMIC_RELEASE, "agent");
            asm volatile("s_waitcnt vmcnt(0)" ::: "memory");
            const unsigned og = xb_add(&bar[XB_TOP], 1u);
            const unsigned tg = og / nx;
            if (og + 1u == (tg + 1u) * nx) xb_add(&bar[XB_TOPGEN], 1u);
            else XB_SPIN(xb_ld(&bar[XB_TOPGEN]) == tg, bar);
            __builtin_amdgcn_fence(__ATOMIC_ACQUIRE, "agent");
            xb_add(&bar[XB_XGEN(b.x)], 1u);
            asm volatile("s_waitcnt vmcnt(0)" ::: "memory");
        } else {
            XB_SPIN(xb_ld(&bar[XB_XGEN(b.x)]) == gen, bar);
            __builtin_amdgcn_fence(__ATOMIC_ACQUIRE, "agent");
            asm volatile("s_waitcnt vmcnt(0)" ::: "memory");
        }
    }
    __syncthreads();
}

struct Args { const float* in[22]; float* out; unsigned char* ws; };
struct Frame {
    LAS unsigned char* lds;
    volatile LAS unsigned* MISC;
    int wave, vcu, G;
};
#define IN_(k) (args.in[k])
#define A_x IN_(0)
#define A_meta IN_(1)
#define A_ln1_g IN_(2)
#define A_w_in IN_(3)
#define A_conv_w IN_(4)
#define A_conv_b IN_(5)
#define A_rg_wa IN_(6)
#define A_rg_ba IN_(7)
#define A_rg_wx IN_(8)
#define A_rg_bx IN_(9)
#define A_rg_lambda IN_(10)
#define A_hg_lb IN_(11)
#define A_hg_norm_g IN_(12)
#define A_w_pa IN_(13)
#define A_w_pb IN_(14)
#define A_w_out IN_(15)
#define A_ln2_g IN_(16)
#define A_peer_wq IN_(17)
#define A_peer_keys IN_(18)
#define A_peer_u IN_(19)
#define A_peer_v IN_(20)
#define A_final_g IN_(21)
#define A_out (args.out)
#define W_SLAB(i) ((bf16*)(args.ws + WS_SLAB + (size_t)(i) * SLAB_BYTES))
#define W_WinT ((bf16*)args.out)
#define W_XN ((bf16*)args.out + (size_t)INW * DM)
#define W_WpaT ((bf16*)(args.ws + WS_WPA))
#define W_WpbT ((bf16*)(args.ws + WS_WPB))
#define W_WoutT ((bf16*)(args.ws + WS_WOUT))
#define W_WqT ((bf16*)(args.ws + WS_WQ))
#define W_KEYS ((bf16*)(args.ws + WS_KEYS))
#define W_WAT ((bf16*)(args.ws + WS_WA))
#define W_WXT ((bf16*)(args.ws + WS_WX))
#define W_METAPROJ ((bf16*)(args.ws + WS_METAPROJ))
#define W_XNMETA ((bf16*)(args.ws + WS_XNMETA))
#define W_RGSUM ((float*)(args.ws + WS_RGSUM))
#define W_RGHIN ((float*)(args.ws + WS_RGHIN))
#define W_HGDEC ((float*)(args.ws + WS_HGDEC))
#define W_HGMETA ((float*)(args.ws + WS_HGMETA))
#define W_RSP ((float*)(args.ws + WS_RSP))
#define W_PSC ((float*)(args.ws + WS_PSC))
#define W_RSTD2 ((float*)(args.ws + WS_PSC + 256 * 1024))
__device__ __forceinline__ float wave_sum(float v) {
#pragma unroll
    for (int o = 1; o < 64; o <<= 1) v += __shfl_xor(v, o);
    return v;
}
__device__ __forceinline__ float wave_max(float v) {
#pragma unroll
    for (int o = 1; o < 64; o <<= 1) v = fmaxf(v, __shfl_xor(v, o));
    return v;
}
__device__ __forceinline__ f32x4 mma16(f32x4 acc, const LAS unsigned char* a, int lda, const LAS unsigned char* b, int ldb, int K, int lane) {
    const int r = lane & 15, g = lane >> 4;
    const LAS unsigned char* ap = a + r * lda + g * 16; const LAS unsigned char* bp = b + r * ldb + g * 16;
    for (int k0 = 0; k0 < K; k0 += 32) {
        const bf16x8 av = *(const LAS bf16x8*)(ap + k0 * 2); const bf16x8 bv = *(const LAS bf16x8*)(bp + k0 * 2);
        acc = __builtin_amdgcn_mfma_f32_16x16x32_bf16(av, bv, acc, 0, 0, 0);
    }
    return acc;
}
__device__ __forceinline__ void p0_transpose_item(const float* W, int K, int N, bf16* WT, LAS float* scr, int item, int lane, const float* rs) {
    const int nblk = N / 64, kb = item / nblk, nb = item % nblk, k0 = 64 * kb, n0 = 64 * nb;
    f32x4 v[16];
#pragma unroll
    for (int i = 0; i < 16; ++i) v[i] = *(const f32x4*)(W + (size_t)(k0 + 4 * i + (lane >> 4)) * N + n0 + 4 * (lane & 15));
#pragma unroll
    for (int i = 0; i < 16; ++i) { const int kk = 4 * i + (lane >> 4); f32x4 w = v[i]; if (rs) w = w * rs[k0 + kk]; *(LAS f32x4*)(scr + kk * 68 + 4 * (lane & 15)) = w; }
    LDS_WAIT(); asm volatile("" ::: "memory");
    const int c = lane & 7;
#pragma unroll
    for (int j = 0; j < 8; ++j) { const int n = (lane >> 3) + 8 * j; const LAS float* sp = scr + (8 * c) * 68 + n;
        v4u o; o.x = pk2(sp[0 * 68], sp[1 * 68]); o.y = pk2(sp[2 * 68], sp[3 * 68]); o.z = pk2(sp[4 * 68], sp[5 * 68]); o.w = pk2(sp[6 * 68], sp[7 * 68]);
        *(v4u*)(WT + (size_t)(n0 + n) * K + k0 + 8 * c) = o; }
    LDS_WAIT(); asm volatile("" ::: "memory");
}
__device__ __forceinline__ void rms_row_to_bf16(const float* xrow, const float* g, bf16* orow, int lane) {
    const f32x4* xr = (const f32x4*)xrow + lane; const f32x4* gr = (const f32x4*)g + lane;
    f32x4 v[8]; float s = 0.f;
#pragma unroll
    for (int j = 0; j < 8; ++j) { v[j] = xr[64 * j]; s += (v[j].x * v[j].x + v[j].y * v[j].y) + (v[j].z * v[j].z + v[j].w * v[j].w); }
    const float rstd = 1.0f / sqrtf(wave_sum(s) * (1.f / DM) + EPS);
    unsigned long long* o8 = (unsigned long long*)orow + lane;
#pragma unroll
    for (int j = 0; j < 8; ++j) { const f32x4 gg = gr[64 * j];
        o8[64 * j] = (unsigned long long)pk2(v[j].x * rstd * gg.x, v[j].y * rstd * gg.y) | ((unsigned long long)pk2(v[j].z * rstd * gg.z, v[j].w * rstd * gg.w) << 32); }
}
__device__ __forceinline__ void p0_prologue(Frame& F, const Args& args) {
    const int lane_ = lane_now(), tid_ = F.wave * 64 + lane_; (void)tid_;
    LAS float* scr = (LAS float*)(F.lds + F.wave * 17408);
    const int gw = F.vcu * NWAVES + F.wave, NGW = F.G * NWAVES;
    constexpr int I_IN = (DM / 64) * (INW / 64), I_SQ = (DM / 64) * (DM / 64), I_G = 16 * (HD / 64) * (HD / 64);
    constexpr int NITEMS = I_IN + 4 * I_SQ + 2 * I_G;
    for (int it = gw; it < NITEMS; it += NGW) {
        int r = it;
        if (r < I_IN) { p0_transpose_item(A_w_in, DM, INW, W_WinT, scr, r, lane_, nullptr); continue; } r -= I_IN;
        if (r < I_SQ) { p0_transpose_item(A_w_pa, DM, DM, W_WpaT, scr, r, lane_, nullptr); continue; } r -= I_SQ;
        if (r < I_SQ) { p0_transpose_item(A_w_pb, DM, DM, W_WpbT, scr, r, lane_, nullptr); continue; } r -= I_SQ;
        if (r < I_SQ) { p0_transpose_item(A_w_out, DM, DM, W_WoutT, scr, r, lane_, nullptr); continue; } r -= I_SQ;
        if (r < I_SQ) { p0_transpose_item(A_peer_wq, DM, DM, W_WqT, scr, r, lane_, A_ln2_g); continue; } r -= I_SQ;
        if (r < I_G) { const int h = r / 4; p0_transpose_item(A_rg_wa + (size_t)h * HD * HD, HD, HD, W_WAT + (size_t)h * HD * HD, scr, r % 4, lane_, nullptr); continue; } r -= I_G;
        { const int h = r / 4; p0_transpose_item(A_rg_wx + (size_t)h * HD * HD, HD, HD, W_WXT + (size_t)h * HD * HD, scr, r % 4, lane_, nullptr); }
    }
    for (int m = gw; m < M + NMETA; m += NGW) {
        if (m < M) rms_row_to_bf16(A_x + (size_t)m * DM, A_ln1_g, W_XN + (size_t)m * DM, lane_);
        else rms_row_to_bf16(A_meta + (size_t)(m - M) * DM, A_ln1_g, W_XNMETA + (size_t)(m - M) * DM, lane_);
    }
    for (int i = (F.vcu * NWAVES * 64 + tid_); i < PH * 2 * NKEY * 128 / 2; i += F.G * NWAVES * 64) {
        const f32x2 k2 = ((const f32x2*)A_peer_keys)[i]; ((unsigned*)W_KEYS)[i] = pk2(k2.x, k2.y); }
}

__device__ __forceinline__ void p1_meta(Frame& F, const Args& args) {
    const int lane_ = lane_now(), tid_ = F.wave * 64 + lane_; (void)tid_;
    const int gw = F.vcu * NWAVES + F.wave, NGW = F.G * NWAVES, r = lane_ & 15, g = lane_ >> 4;
    for (int it = gw; it < INW / 16; it += NGW) {
        const int n0 = it * 16;
        const bf16* ap = W_XNMETA + (size_t)r * DM + 8 * g; const bf16* bp = W_WinT + (size_t)(n0 + r) * DM + 8 * g;
        f32x4 acc = (f32x4){0.f, 0.f, 0.f, 0.f};
#pragma unroll 4
        for (int k0 = 0; k0 < DM; k0 += 32) { const bf16x8 a = *(const bf16x8*)(ap + k0); const bf16x8 b = *(const bf16x8*)(bp + k0); acc = __builtin_amdgcn_mfma_f32_16x16x32_bf16(a, b, acc, 0, 0, 0); }
#pragma unroll
        for (int j = 0; j < 4; ++j) W_METAPROJ[(size_t)(4 * g + j) * INW + n0 + r] = (bf16)f2bf(acc[j]);
    }
}

template <int MODE, bool DUMMY, int VAR = 0>
__device__ __forceinline__ void rg_wave_item(const Args& args, const LAS unsigned char* WAl, const LAS unsigned char* WXl, LAS unsigned char* YL, const LAS float* CST, int h, int b, int c, bool meta, int lane) {
    const int r = lane & 15, g = lane >> 4;
    const int nhalf = meta ? 1 : 2, ntile = meta ? 1 : 2;
    bf16x8 SEL0, SEL1;
#pragma unroll
    for (int j = 0; j < 8; ++j) { SEL0[j] = (8 * g + j == r) ? (short)0x3F80 : (short)0; SEL1[j] = (8 * g + j == 16 + r) ? (short)0x3F80 : (short)0; }
    float hc[8], pt[8];
#pragma unroll
    for (int ct = 0; ct < 8; ++ct) { hc[ct] = (MODE == 1) ? W_RGHIN[(size_t)(b * NCH + c) * DM + h * HD + 16 * ct + r] : 0.f; pt[ct] = 1.f; }
#pragma unroll 1
    for (int hf = 0; hf < nhalf; ++hf) {
        v4u yr[8];
        if (MODE == 1) {
#pragma unroll
            for (int i = 0; i < 8; ++i) yr[i] = *(const v4u*)(W_SLAB(SL_YA) + (size_t)(b * SEQ + c * CH + 32 * hf + 4 * i + (lane >> 4)) * DM + h * HD + 8 * (lane & 15));
        }
        bf16x8 A[2][4];
#pragma unroll
        for (int ks = 0; ks < 4; ++ks) {
            const int ch0 = h * HD + 32 * ks + 8 * g;
            f32x4 wk[4][2], cb[2];
#pragma unroll
            for (int k = 0; k < 4; ++k) { wk[k][0] = *(const f32x4*)(A_conv_w + (size_t)k * DM + ch0); wk[k][1] = *(const f32x4*)(A_conv_w + (size_t)k * DM + ch0 + 4); }
            cb[0] = *(const f32x4*)(A_conv_b + ch0); cb[1] = *(const f32x4*)(A_conv_b + ch0 + 4);
#pragma unroll
            for (int rt = 0; rt < 2; ++rt) {
                if (rt < ntile) {
                    const int t = 32 * hf + 16 * rt + r;
                    f32x4 a0 = cb[0], a1 = cb[1];
#pragma unroll
                    for (int k = 0; k < 4; ++k) {
                        const bf16* rowp; bool valid = true;
                        if (meta) { const int s = t + k - 3; valid = s >= 0; rowp = W_METAPROJ + (size_t)(valid ? s : 0) * INW; }
                        else { const int s = c * CH + t + k - 3; rowp = (s >= 0) ? W_SLAB(SL_XA) + (size_t)(b * SEQ + s) * DM : W_METAPROJ + (size_t)(NMETA + s) * INW; }
                        v4u xw = (VAR == 1) ? (v4u){(unsigned)t, (unsigned)k, 0x3f803f80u, 0x3f803f80u} : *(const v4u*)(rowp + ch0);
                        if (!valid) xw = (v4u){0u, 0u, 0u, 0u};
                        a0 += wk[k][0] * (f32x4){bflo(xw.x), bfhi(xw.x), bflo(xw.y), bfhi(xw.y)};
                        a1 += wk[k][1] * (f32x4){bflo(xw.z), bfhi(xw.z), bflo(xw.w), bfhi(xw.w)};
                    }
                    v4u pk; pk.x = pk2(a0[0], a0[1]); pk.y = pk2(a0[2], a0[3]); pk.z = pk2(a1[0], a1[1]); pk.w = pk2(a1[2], a1[3]);
                    A[rt][ks] = __builtin_bit_cast(bf16x8, pk);
                } else A[rt][ks] = (bf16x8){0, 0, 0, 0, 0, 0, 0, 0};
            }
            __builtin_amdgcn_sched_barrier(0);
        }
        if (MODE == 1) {
#pragma unroll
            for (int i = 0; i < 8; ++i) { v4u gw;
#pragma unroll
                for (int w = 0; w < 4; ++w) { const pg8::f32x2 gl = pg8::gelu_pk((pg8::f32x2){bflo(yr[i][w]), bfhi(yr[i][w])}); gw[w] = pk2(gl.x, gl.y); }
                *(LAS v4u*)(YL + (4 * i + (lane >> 4)) * 272 + 16 * (lane & 15)) = gw; }
        }
#pragma unroll
        for (int ct = 0; ct < 8; ++ct) {
            const int col = h * HD + 16 * ct + r;
            const float ba = CST[16 * ct + r], bx = CST[128 + 16 * ct + r], sp2 = CST[256 + 16 * ct + r];
            bf16x8 wa[4], wx[4];
#pragma unroll
            for (int ks = 0; ks < 4; ++ks) { wa[ks] = *(const LAS bf16x8*)(WAl + (16 * ct + r) * 272 + ks * 64 + g * 16); wx[ks] = *(const LAS bf16x8*)(WXl + (16 * ct + r) * 272 + ks * 64 + g * 16); }
#pragma unroll
            for (int rt = 0; rt < 2; ++rt) {
                if (rt < ntile) {
                    f32x4 R = (f32x4){0.f, 0.f, 0.f, 0.f}, I = R, XC = R;
#pragma unroll
                    for (int ks = 0; ks < 4; ++ks) { if (VAR == 4 && ks > 0) continue; R = __builtin_amdgcn_mfma_f32_16x16x32_bf16(A[rt][ks], wa[ks], R, 0, 0, 0); I = __builtin_amdgcn_mfma_f32_16x16x32_bf16(A[rt][ks], wx[ks], I, 0, 0, 0); }
                    XC = __builtin_amdgcn_mfma_f32_16x16x32_bf16(A[rt][ct >> 1], (ct & 1) ? SEL1 : SEL0, XC, 0, 0, 0);
                    float av[4], uv[4];
#pragma unroll
                    for (int j = 0; j < 4; ++j) {
                        const float rr = sigm(R[j] + ba), ii = sigm(I[j] + bx);
                        av[j] = __builtin_amdgcn_exp2f(sp2 * rr); uv[j] = __builtin_amdgcn_sqrtf((1.0f - av[j]) * (1.0f + av[j])) * ii * XC[j]; }
                    const float P = (av[0] * av[1]) * (av[2] * av[3]);
                    const float U = ((uv[0] * av[1] + uv[1]) * av[2] + uv[2]) * av[3] + uv[3];
                    const float P0 = (VAR == 2) ? P : __shfl(P, r), P1 = (VAR == 2) ? P : __shfl(P, r + 16), P2 = (VAR == 2) ? P : __shfl(P, r + 32), P3 = (VAR == 2) ? P : __shfl(P, r + 48);
                    const float U0 = (VAR == 2) ? U : __shfl(U, r), U1 = (VAR == 2) ? U : __shfl(U, r + 16), U2 = (VAR == 2) ? U : __shfl(U, r + 32), U3 = (VAR == 2) ? U : __shfl(U, r + 48);
                    const float h0 = hc[ct], h1 = P0 * h0 + U0, h2 = P1 * h1 + U1, h3 = P2 * h2 + U2, he = P3 * h3 + U3;
                    if (MODE == 1) {
                        float hh = (g == 0) ? h0 : (g == 1) ? h1 : (g == 2) ? h2 : h3;
#pragma unroll
                        for (int j = 0; j < 4; j += 2) { const int tl = 16 * rt + 4 * g + j;
                            const float hA = av[j] * hh + uv[j], hB = av[j + 1] * hA + uv[j + 1]; hh = hB;
                            LAS bf16* yp = (LAS bf16*)(YL + tl * 272 + (16 * ct + r) * 2);
                            const unsigned pw = pk2(bf1(yp[0]) * hA, bf1(yp[136]) * hB);
                            yp[0] = (bf16)(pw & 0xffffu); yp[136] = (bf16)(pw >> 16); }
                    }
                    hc[ct] = he; pt[ct] *= (P0 * P1) * (P2 * P3);
                }
            }
            if (ct & 1) __builtin_amdgcn_sched_barrier(0);
        }
        if (MODE == 1) {
#pragma unroll
            for (int i = 0; i < 8; ++i) { const v4u yv = *(const LAS v4u*)(YL + (4 * i + (lane >> 4)) * 272 + 16 * (lane & 15));
                const size_t eo = (size_t)(b * SEQ + c * CH + 32 * hf + 4 * i + (lane >> 4)) * DM + h * HD + 8 * (lane & 15);
                bf16* yo = DUMMY ? (bf16*)(args.ws + WS_END) + (eo & (size_t)(4 * MiB - 1)) : W_SLAB(SL_YA) + eo;
                *(v4u*)yo = yv; }
        }
    }
    if (MODE == 0 && g == 0) {
#pragma unroll
        for (int ct = 0; ct < 8; ++ct) { const int col = h * HD + 16 * ct + r;
            const size_t o = meta ? ((size_t)BATCH * NCH * DM + col) : ((size_t)(b * NCH + c) * DM + col);
            ((f32x2*)W_RGSUM)[o] = (f32x2){pt[ct], hc[ct]}; }
    }
}
template <int MODE, bool DUMMY = false, int VAR = 0>
__device__ __forceinline__ void rg_phase(Frame& F, const Args& args) {
    const int lane_ = lane_now(), tid_ = F.wave * 64 + lane_; (void)tid_;
    LAS unsigned char* WAl = F.lds;
    LAS unsigned char* WXl = F.lds + 34816;
    LAS unsigned char* YL = F.lds + 69632 + F.wave * 8704;
    LAS float* CST = (LAS float*)(F.lds + 139264);
    const int nit = BATCH * NCH * NH, per = (nit + F.G - 1) / F.G;
    const int it0 = F.vcu * per, it1 = (it0 + per < nit) ? it0 + per : nit;
    for (int seg0 = it0; seg0 < it1;) {
        const int h = seg0 >> 8, hend = (h + 1) << 8, seg1 = hend < it1 ? hend : it1;
        __syncthreads();
        { const v4u* ga = (const v4u*)(W_WAT + (size_t)h * HD * HD); const v4u* gx = (const v4u*)(W_WXT + (size_t)h * HD * HD);
#pragma unroll
          for (int i = 0; i < 4; ++i) { const int p = tid_ + 512 * i, row = p >> 4, c16 = p & 15;
              *(LAS v4u*)(WAl + row * 272 + c16 * 16) = ga[p]; *(LAS v4u*)(WXl + row * 272 + c16 * 16) = gx[p]; } }
        if (tid_ < HD) { const int col = h * HD + tid_; CST[tid_] = A_rg_ba[col]; CST[128 + tid_] = A_rg_bx[col]; CST[256 + tid_] = -8.0f * 1.44269504f * log1pf(__expf(-A_rg_lambda[col])); }
        __syncthreads();
        for (int it = seg0 + F.wave; it < seg1; it += NWAVES) {
            const int bc = it & 255, b = bc >> 6, c = bc & 63;
            if (MODE == 0 && bc == 0) rg_wave_item<MODE, DUMMY, VAR>(args, WAl, WXl, YL, CST, h, 0, 0, true, lane_);
            rg_wave_item<MODE, DUMMY, VAR>(args, WAl, WXl, YL, CST, h, b, c, false, lane_);
        }
        seg0 = seg1;
    }
    __syncthreads();
}
__device__ __forceinline__ void rg_carry(Frame& F, const Args& args) {
    const int lane_ = lane_now(), tid_ = F.wave * 64 + lane_; (void)tid_;
    const int gid = F.vcu * NWAVES * 64 + tid_;
    if (gid < BATCH * DM) {
        const int b = gid >> 11, col = gid & (DM - 1);
        float h = ((const f32x2*)W_RGSUM)[(size_t)BATCH * NCH * DM + col].y;
        for (int c0 = 0; c0 < NCH; c0 += 16) { f32x2 sv[16];
#pragma unroll
            for (int i = 0; i < 16; ++i) sv[i] = ((const f32x2*)W_RGSUM)[(size_t)(b * NCH + c0 + i) * DM + col];
#pragma unroll
            for (int i = 0; i < 16; ++i) { W_RGHIN[(size_t)(b * NCH + c0 + i) * DM + col] = h; h = sv[i].x * h + sv[i].y; } }
    }
}

struct HgRaw { unsigned fw[8], vw[8], qw[8]; v4u stw[4]; v2u ogw[4]; };
template <int MODE>
__device__ __forceinline__ void hg_load(HgRaw& R, const Args& args, const bf16* ST, int it, int tid_, int lane_, int w) {
    const bool meta = it >= BATCH * NH * NCH;
    const int bh = meta ? 0 : (it >> 6), c = meta ? 0 : (it & 63), b = bh >> 4, h = meta ? (it - BATCH * NH * NCH) : (bh & 15);
    const int kp = w * 8 + (lane_ & 7), sg = lane_ >> 3, r = lane_ & 15, g = lane_ >> 4, col = h * HD + 2 * kp;
#pragma unroll
    for (int i = 0; i < 8; ++i) { const int s = 8 * sg + i;
        if (meta) { const bool valid = s < NMETA; const size_t ro = (size_t)(valid ? s : 0) * INW + col;
            const unsigned f = *(const unsigned*)(W_METAPROJ + ro + 3 * DM), v = *(const unsigned*)(W_METAPROJ + ro + 4 * DM); R.fw[i] = valid ? f : 0u; R.vw[i] = valid ? v : 0u; if (MODE == 1) R.qw[i] = 0u; }
        else { const size_t ro = (size_t)(b * SEQ + c * CH + s) * DM + col; R.fw[i] = *(const unsigned*)(W_SLAB(SL_F) + ro); R.vw[i] = *(const unsigned*)(W_SLAB(SL_I) + ro);
               if (MODE == 1) R.qw[i] = *(const unsigned*)(W_SLAB(SL_Q) + ro); } }
    if (MODE == 1) { const v4u* gs = (const v4u*)(ST + ((size_t)(bh * NCH + c)) * HD * HD);
#pragma unroll
        for (int i = 0; i < 4; ++i) R.stw[i] = gs[tid_ + 512 * i];
#pragma unroll
        for (int tt = 0; tt < 4; ++tt) R.ogw[tt] = *(const v2u*)(W_SLAB(SL_OG) + (size_t)(b * SEQ + c * CH + 16 * tt + r) * DM + h * HD + 16 * w + 4 * g); }
}
template <int MODE, bool DUMMY = false>
__device__ __forceinline__ void hg_phase(Frame& F, const Args& args, bf16* ST) {
    const int lane_ = lane_now(), tid_ = F.wave * 64 + lane_; (void)tid_;
    LAS unsigned char* VT = F.lds;
    LAS float* TOT = (LAS float*)(F.lds + 18432);
    LAS unsigned char* KDT = F.lds + 22528;
    LAS unsigned char* QDEC = F.lds + 22528;
    LAS unsigned char* QD2 = F.lds + 39936;
    LAS unsigned char* KD2 = F.lds + 57344;
    LAS unsigned char* STl = F.lds + 74752;
    LAS unsigned char* PB = F.lds + 109568;
    LAS float* SSQ = (LAS float*)(F.lds + 118784);
    const int nit = BATCH * NH * NCH + (MODE == 0 ? NH : 0);
    const int w = F.wave, kp = w * 8 + (lane_ & 7), sg = lane_ >> 3, r = lane_ & 15, g = lane_ >> 4;
    HgRaw cur, nxt;
    if (F.vcu < nit) hg_load<MODE>(cur, args, ST, F.vcu, tid_, lane_, w);
    for (int it = F.vcu; it < nit; it += F.G) {
        const bool meta = it >= BATCH * NH * NCH;
        const int bh = meta ? 0 : (it >> 6), c = meta ? 0 : (it & 63), b = bh >> 4, h = meta ? (it - BATCH * NH * NCH) : (bh & 15);
        const int col = h * HD + 2 * kp;
        __syncthreads();
        float lb0, lb1;
        { const f32x2 l0 = *(const f32x2*)(A_hg_lb + col), l1 = *(const f32x2*)(A_hg_lb + DM + col); lb0 = 1.0f / (1.0f + __expf(l1.x - l0.x)); lb1 = 1.0f / (1.0f + __expf(l1.y - l0.y)); }
        float cs0[8], cs1[8], kk0[8], kk1[8];
        float run0 = 0.f, run1 = 0.f;
#pragma unroll
        for (int i = 0; i < 8; ++i) {
            const int s = 8 * sg + i; const unsigned fw = cur.fw[i]; const bool valid = !meta || s < NMETA;
            const float f0 = lb0 + (1.0f - lb0) * sigm(bflo(fw)), f1 = lb1 + (1.0f - lb1) * sigm(bfhi(fw));
            const float l0 = valid ? __logf(f0) : 0.f, l1 = valid ? __logf(f1) : 0.f;
            kk0[i] = valid ? 1.0f - f0 : 0.f; kk1[i] = valid ? 1.0f - f1 : 0.f;
            run0 += l0; run1 += l1; cs0[i] = run0; cs1[i] = run1;
        }
        float inc0 = run0, inc1 = run1;
        { float t0 = __shfl_up(inc0, 8), t1 = __shfl_up(inc1, 8); if (sg >= 1) { inc0 += t0; inc1 += t1; }
          t0 = __shfl_up(inc0, 16); t1 = __shfl_up(inc1, 16); if (sg >= 2) { inc0 += t0; inc1 += t1; }
          t0 = __shfl_up(inc0, 32); t1 = __shfl_up(inc1, 32); if (sg >= 4) { inc0 += t0; inc1 += t1; } }
        const float pre0 = inc0 - run0, pre1 = inc1 - run1;
        const float tot0 = __shfl(inc0, lane_ | 56), tot1 = __shfl(inc1, lane_ | 56), ref0 = __shfl(inc0, (lane_ & 7) | 24), ref1 = __shfl(inc1, (lane_ & 7) | 24);
        { v4u p0, p1;
          p0.x = (cur.vw[0] & 0xffffu) | (cur.vw[1] << 16); p0.y = (cur.vw[2] & 0xffffu) | (cur.vw[3] << 16); p0.z = (cur.vw[4] & 0xffffu) | (cur.vw[5] << 16); p0.w = (cur.vw[6] & 0xffffu) | (cur.vw[7] << 16);
          p1.x = (cur.vw[0] >> 16) | (cur.vw[1] & 0xffff0000u); p1.y = (cur.vw[2] >> 16) | (cur.vw[3] & 0xffff0000u); p1.z = (cur.vw[4] >> 16) | (cur.vw[5] & 0xffff0000u); p1.w = (cur.vw[6] >> 16) | (cur.vw[7] & 0xffff0000u);
          *(LAS v4u*)(VT + (2 * kp) * 144 + sg * 16) = p0; *(LAS v4u*)(VT + (2 * kp + 1) * 144 + sg * 16) = p1; }
        if (MODE == 0) {
            float d0[8], d1[8];
#pragma unroll
            for (int i = 0; i < 8; ++i) { d0[i] = kk0[i] * __expf(tot0 - (pre0 + cs0[i])); d1[i] = kk1[i] * __expf(tot1 - (pre1 + cs1[i])); }
            v4u p0, p1;
            p0.x = pk2(d0[0], d0[1]); p0.y = pk2(d0[2], d0[3]); p0.z = pk2(d0[4], d0[5]); p0.w = pk2(d0[6], d0[7]);
            p1.x = pk2(d1[0], d1[1]); p1.y = pk2(d1[2], d1[3]); p1.z = pk2(d1[4], d1[5]); p1.w = pk2(d1[6], d1[7]);
            *(LAS v4u*)(KDT + (2 * kp) * 144 + sg * 16) = p0; *(LAS v4u*)(KDT + (2 * kp + 1) * 144 + sg * 16) = p1;
            if (!meta && sg == 0) *(f32x2*)(W_HGDEC + (size_t)(bh * NCH + c) * HD + 2 * kp) = (f32x2){__expf(tot0), __expf(tot1)};
            if (it + F.G < nit) hg_load<MODE>(nxt, args, ST, it + F.G, tid_, lane_, w);
            __syncthreads();
#pragma unroll 2
            for (int kt = 0; kt < 8; ++kt) {
                f32x4 acc = (f32x4){0.f, 0.f, 0.f, 0.f};
                acc = mma16(acc, KDT + kt * 16 * 144, 144, VT + w * 16 * 144, 144, CH, lane_);
                const int v = 16 * w + r, k0 = 16 * kt + 4 * g;
                if (meta) *(f32x4*)(W_HGMETA + ((size_t)h * HD + v) * HD + k0) = acc;
                else { v2u o; o.x = pk2(acc[0], acc[1]); o.y = pk2(acc[2], acc[3]); *(v2u*)(ST + (((size_t)(bh * NCH + c)) * HD + v) * HD + k0) = o; }
            }
        } else {
#pragma unroll
            for (int i = 0; i < 8; ++i) { const int s = 8 * sg + i;
                const float q0 = bflo(cur.qw[i]), q1 = bfhi(cur.qw[i]), qs0 = q0 * sigm(q0), qs1 = q1 * sigm(q1);
                const float bc0 = pre0 + cs0[i], bc1 = pre1 + cs1[i];
                *(LAS unsigned*)(QDEC + s * 272 + 4 * kp) = pk2(qs0 * __expf(bc0), qs1 * __expf(bc1));
                *(LAS unsigned*)(QD2 + s * 272 + 4 * kp) = pk2(qs0 * __expf(fminf(bc0 - ref0, 80.f)), qs1 * __expf(fminf(bc1 - ref1, 80.f)));
                *(LAS unsigned*)(KD2 + s * 272 + 4 * kp) = pk2(kk0[i] * __expf(fminf(ref0 - bc0, 80.f)), kk1[i] * __expf(fminf(ref1 - bc1, 80.f))); }
#pragma unroll
            for (int i = 0; i < 4; ++i) { const int p = tid_ + 512 * i, row = p >> 4, c16 = p & 15; *(LAS v4u*)(STl + row * 272 + c16 * 16) = cur.stw[i]; }
            if (it + F.G < nit) hg_load<MODE>(nxt, args, ST, it + F.G, tid_, lane_, w);
            __syncthreads();
            { const int tt = w >> 1;
#pragma unroll
              for (int e = 0; e < 2; ++e) { const int st = 2 * (w & 1) + e; f32x4 acc = (f32x4){0.f, 0.f, 0.f, 0.f};
                  if (st <= tt) acc = mma16(acc, KD2 + st * 16 * 272, 272, QD2 + tt * 16 * 272, 272, HD, lane_);
                  const int t = 16 * tt + r, s0 = 16 * st + 4 * g;
#pragma unroll
                  for (int j = 0; j < 4; ++j) if (s0 + j > t) acc[j] = 0.f;
                  v2u o; o.x = pk2(acc[0], acc[1]); o.y = pk2(acc[2], acc[3]); *(LAS v2u*)(PB + t * 144 + s0 * 2) = o; } }
            __syncthreads();
            f32x4 o4[4];
#pragma unroll
            for (int tt = 0; tt < 4; ++tt) { f32x4 acc = (f32x4){0.f, 0.f, 0.f, 0.f};
                acc = mma16(acc, STl + w * 16 * 272, 272, QDEC + tt * 16 * 272, 272, HD, lane_);
                acc = mma16(acc, VT + w * 16 * 144, 144, PB + tt * 16 * 144, 144, CH, lane_);
                o4[tt] = acc;
                float q = (acc[0] * acc[0] + acc[1] * acc[1]) + (acc[2] * acc[2] + acc[3] * acc[3]);
                q += __shfl_xor(q, 16); q += __shfl_xor(q, 32);
                if (g == 0) SSQ[(16 * tt + r) * 8 + w] = q; }
            __syncthreads();
            const f32x4 ng = *(const f32x4*)(A_hg_norm_g + h * HD + 16 * w + 4 * g);
#pragma unroll
            for (int tt = 0; tt < 4; ++tt) { const int t = 16 * tt + r;
                const f32x4 sa = *(const LAS f32x4*)(SSQ + t * 8), sb = *(const LAS f32x4*)(SSQ + t * 8 + 4);
                const float rs = __builtin_amdgcn_rsqf(((sa[0] + sa[1]) + (sa[2] + sa[3]) + (sb[0] + sb[1]) + (sb[2] + sb[3])) * (1.0f / HD) + EPS);
                v2u* op = (v2u*)(W_SLAB(SL_OG) + (size_t)(b * SEQ + c * CH + t) * DM + h * HD + 16 * w + 4 * g);
                const v2u ow = cur.ogw[tt]; const float g0 = bflo(ow.x), g1 = bfhi(ow.x), g2 = bflo(ow.y), g3 = bfhi(ow.y);
                v2u y; y.x = pk2(o4[tt][0] * rs * ng[0] * (g0 * sigm(g0)), o4[tt][1] * rs * ng[1] * (g1 * sigm(g1)));
                y.y = pk2(o4[tt][2] * rs * ng[2] * (g2 * sigm(g2)), o4[tt][3] * rs * ng[3] * (g3 * sigm(g3)));
                if (DUMMY) *(v2u*)((bf16*)(args.ws + WS_END) + ((((size_t)(b * SEQ + c * CH + t) * DM + h * HD + 16 * w + 4 * g)) & (size_t)(4 * MiB - 1))) = y; else *op = y; }
        }
#pragma unroll
        for (int i = 0; i < 8; ++i) { cur.fw[i] = nxt.fw[i]; cur.vw[i] = nxt.vw[i]; if (MODE == 1) cur.qw[i] = nxt.qw[i]; }
        if (MODE == 1) {
#pragma unroll
            for (int i = 0; i < 4; ++i) { cur.stw[i] = nxt.stw[i]; cur.ogw[i] = nxt.ogw[i]; } }
    }
}
__device__ __forceinline__ void hg_carry(Frame& F, const Args& args, bf16* ST) {
    const int lane_ = lane_now(), tid_ = F.wave * 64 + lane_; (void)tid_;
    for (int gid = F.vcu * NWAVES * 64 + tid_; gid < BATCH * NH * HD * (HD / 8); gid += F.G * NWAVES * 64) {
        const int k8 = gid & 15, v = (gid >> 4) & 127, bh = gid >> 11, h = bh & 15;
        float S[8];
        { const f32x4 a = *(const f32x4*)(W_HGMETA + ((size_t)h * HD + v) * HD + 8 * k8), b2 = *(const f32x4*)(W_HGMETA + ((size_t)h * HD + v) * HD + 8 * k8 + 4);
          S[0] = a[0]; S[1] = a[1]; S[2] = a[2]; S[3] = a[3]; S[4] = b2[0]; S[5] = b2[1]; S[6] = b2[2]; S[7] = b2[3]; }
        v4u* p0 = (v4u*)(ST + (((size_t)(bh * NCH)) * HD + v) * HD + 8 * k8);
        const f32x4* d0 = (const f32x4*)(W_HGDEC + (size_t)(bh * NCH) * HD + 8 * k8);
        for (int c0 = 0; c0 < NCH; c0 += 8) {
            v4u d[8]; f32x4 da[8], db[8];
#pragma unroll
            for (int i = 0; i < 8; ++i) { d[i] = p0[(size_t)(c0 + i) * 2048]; da[i] = d0[(c0 + i) * 32]; db[i] = d0[(c0 + i) * 32 + 1]; }
#pragma unroll
            for (int i = 0; i < 8; ++i) {
                v4u o; o.x = pk2(S[0], S[1]); o.y = pk2(S[2], S[3]); o.z = pk2(S[4], S[5]); o.w = pk2(S[6], S[7]); p0[(size_t)(c0 + i) * 2048] = o;
                S[0] = da[i][0] * S[0] + bflo(d[i].x); S[1] = da[i][1] * S[1] + bfhi(d[i].x); S[2] = da[i][2] * S[2] + bflo(d[i].y); S[3] = da[i][3] * S[3] + bfhi(d[i].y);
                S[4] = db[i][0] * S[4] + bflo(d[i].z); S[5] = db[i][1] * S[5] + bfhi(d[i].z); S[6] = db[i][2] * S[6] + bflo(d[i].w); S[7] = db[i][3] * S[7] + bfhi(d[i].w);
            }
        }
    }
}

__device__ __forceinline__ void p3_convert_uv(Frame& F, const Args& args) {
    const int lane_ = lane_now(), tid_ = F.wave * 64 + lane_; (void)tid_;
    const int gw = F.vcu * NWAVES + F.wave, NGW = F.G * NWAVES, lane = lane_;
    unsigned char* U8 = (unsigned char*)W_SLAB(SL_UB); unsigned char* V8 = (unsigned char*)W_SLAB(SL_VB);
    for (int it = gw; it < 2 * NEXP; it += NGW) {
        const bool isv = it >= NEXP; const int e = isv ? it - NEXP : it;
        const float* src = (isv ? A_peer_v : A_peer_u) + (size_t)e * DM;
        f32x4 a[8];
        { LAS f32x4* T = (LAS f32x4*)(F.lds + F.wave * 8192);
          f32x4 raw[8];
#pragma unroll
          for (int j = 0; j < 8; ++j) raw[j] = *((const f32x4*)src + lane + 64 * j);
#pragma unroll
          for (int j = 0; j < 8; ++j) { const int c = lane + 64 * j; T[c ^ ((c >> 4) & 3)] = raw[j]; }
#pragma unroll
          for (int q = 0; q < 4; ++q) { const int c0 = 4 * lane + q, c1 = 256 + 4 * lane + q; a[q] = T[c0 ^ ((c0 >> 4) & 3)]; a[4 + q] = T[c1 ^ ((c1 >> 4) & 3)]; } }
        if (!isv) {
#pragma unroll
            for (int q = 0; q < 4; ++q) { a[q] = a[q] * *(const f32x4*)(A_ln2_g + 16 * lane + 4 * q); a[4 + q] = a[4 + q] * *(const f32x4*)(A_ln2_g + 1024 + 16 * lane + 4 * q); }
        }
        float mx = 0.f;
#pragma unroll
        for (int q = 0; q < 8; ++q) mx = fmaxf(mx, fmaxf(fmaxf(fabsf(a[q][0]), fabsf(a[q][1])), fmaxf(fabsf(a[q][2]), fabsf(a[q][3]))));
        mx = wave_max(mx);
        const float sc = mx > 0.f ? 256.0f / mx : 0.f;
        v4u o0, o1;
#pragma unroll
        for (int q = 0; q < 4; ++q) {
            int w0 = __builtin_amdgcn_cvt_pk_fp8_f32(a[q][0] * sc, a[q][1] * sc, 0, false); w0 = __builtin_amdgcn_cvt_pk_fp8_f32(a[q][2] * sc, a[q][3] * sc, w0, true);
            int w1 = __builtin_amdgcn_cvt_pk_fp8_f32(a[4 + q][0] * sc, a[4 + q][1] * sc, 0, false); w1 = __builtin_amdgcn_cvt_pk_fp8_f32(a[4 + q][2] * sc, a[4 + q][3] * sc, w1, true);
            o0[q] = (unsigned)w0; o1[q] = (unsigned)w1; }
        unsigned char* dst = (isv ? V8 : U8) + (size_t)e * DM + 16 * lane;
        *(v4u*)dst = o0; *(v4u*)(dst + 1024) = o1;
        if (lane == 0) W_PSC[it] = mx * (1.0f / 256.0f);
    }
}

#define CEU(x, y) do { const unsigned _h = (x) > (y) ? (x) : (y), _l = (x) > (y) ? (y) : (x); (x) = _h; (y) = _l; } while (0)
#define CEP(vx, ix, vy, iy) do { const bool _s = (vy) > (vx); const float _hv = _s ? (vy) : (vx), _lv = _s ? (vx) : (vy); const int _hi = _s ? (iy) : (ix), _li = _s ? (ix) : (iy); (vx) = _hv; (vy) = _lv; (ix) = _hi; (iy) = _li; } while (0)
#define SEL4(g, x0, x1, x2, x3) (((g) & 2) ? (((g) & 1) ? (x3) : (x2)) : (((g) & 1) ? (x1) : (x0)))
__device__ __forceinline__ unsigned sel_key(float f, int idx) { const unsigned u = __float_as_uint(f); const unsigned k = u ^ ((unsigned)((int)u >> 31) | 0x80000000u); return (k & ~127u) | (unsigned)idx; }
__device__ __forceinline__ float sel_val(unsigned k) { const unsigned u = k & ~127u; return __uint_as_float(u ^ (~(unsigned)((int)u >> 31) | 0x80000000u)); }
__device__ __forceinline__ void sel_top16(unsigned (&a)[32], unsigned (&t)[16]) {
    CEU(a[0], a[1]);
    CEU(a[3], a[2]);
    CEU(a[4], a[5]);
    CEU(a[7], a[6]);
    CEU(a[8], a[9]);
    CEU(a[11], a[10]);
    CEU(a[12], a[13]);
    CEU(a[15], a[14]);
    CEU(a[0], a[2]);
    CEU(a[1], a[3]);
    CEU(a[6], a[4]);
    CEU(a[7], a[5]);
    CEU(a[8], a[10]);
    CEU(a[9], a[11]);
    CEU(a[14], a[12]);
    CEU(a[15], a[13]);
    CEU(a[0], a[1]);
    CEU(a[2], a[3]);
    CEU(a[5], a[4]);
    CEU(a[7], a[6]);
    CEU(a[8], a[9]);
    CEU(a[10], a[11]);
    CEU(a[13], a[12]);
    CEU(a[15], a[14]);
    CEU(a[0], a[4]);
    CEU(a[1], a[5]);
    CEU(a[2], a[6]);
    CEU(a[3], a[7]);
    CEU(a[12], a[8]);
    CEU(a[13], a[9]);
    CEU(a[14], a[10]);
    CEU(a[15], a[11]);
    CEU(a[0], a[2]);
    CEU(a[1], a[3]);
    CEU(a[4], a[6]);
    CEU(a[5], a[7]);
    CEU(a[10], a[8]);
    CEU(a[11], a[9]);
    CEU(a[14], a[12]);
    CEU(a[15], a[13]);
    CEU(a[0], a[1]);
    CEU(a[2], a[3]);
    CEU(a[4], a[5]);
    CEU(a[6], a[7]);
    CEU(a[9], a[8]);
    CEU(a[11], a[10]);
    CEU(a[13], a[12]);
    CEU(a[15], a[14]);
    CEU(a[0], a[8]);
    CEU(a[1], a[9]);
    CEU(a[2], a[10]);
    CEU(a[3], a[11]);
    CEU(a[4], a[12]);
    CEU(a[5], a[13]);
    CEU(a[6], a[14]);
    CEU(a[7], a[15]);
    CEU(a[0], a[4]);
    CEU(a[1], a[5]);
    CEU(a[2], a[6]);
    CEU(a[3], a[7]);
    CEU(a[8], a[12]);
    CEU(a[9], a[13]);
    CEU(a[10], a[14]);
    CEU(a[11], a[15]);
    CEU(a[0], a[2]);
    CEU(a[1], a[3]);
    CEU(a[4], a[6]);
    CEU(a[5], a[7]);
    CEU(a[8], a[10]);
    CEU(a[9], a[11]);
    CEU(a[12], a[14]);
    CEU(a[13], a[15]);
    CEU(a[0], a[1]);
    CEU(a[2], a[3]);
    CEU(a[4], a[5]);
    CEU(a[6], a[7]);
    CEU(a[8], a[9]);
    CEU(a[10], a[11]);
    CEU(a[12], a[13]);
    CEU(a[14], a[15]);
    CEU(a[16], a[17]);
    CEU(a[19], a[18]);
    CEU(a[20], a[21]);
    CEU(a[23], a[22]);
    CEU(a[24], a[25]);
    CEU(a[27], a[26]);
    CEU(a[28], a[29]);
    CEU(a[31], a[30]);
    CEU(a[16], a[18]);
    CEU(a[17], a[19]);
    CEU(a[22], a[20]);
    CEU(a[23], a[21]);
    CEU(a[24], a[26]);
    CEU(a[25], a[27]);
    CEU(a[30], a[28]);
    CEU(a[31], a[29]);
    CEU(a[16], a[17]);
    CEU(a[18], a[19]);
    CEU(a[21], a[20]);
    CEU(a[23], a[22]);
    CEU(a[24], a[25]);
    CEU(a[26], a[27]);
    CEU(a[29], a[28]);
    CEU(a[31], a[30]);
    CEU(a[16], a[20]);
    CEU(a[17], a[21]);
    CEU(a[18], a[22]);
    CEU(a[19], a[23]);
    CEU(a[28], a[24]);
    CEU(a[29], a[25]);
    CEU(a[30], a[26]);
    CEU(a[31], a[27]);
    CEU(a[16], a[18]);
    CEU(a[17], a[19]);
    CEU(a[20], a[22]);
    CEU(a[21], a[23]);
    CEU(a[26], a[24]);
    CEU(a[27], a[25]);
    CEU(a[30], a[28]);
    CEU(a[31], a[29]);
    CEU(a[16], a[17]);
    CEU(a[18], a[19]);
    CEU(a[20], a[21]);
    CEU(a[22], a[23]);
    CEU(a[25], a[24]);
    CEU(a[27], a[26]);
    CEU(a[29], a[28]);
    CEU(a[31], a[30]);
    CEU(a[16], a[24]);
    CEU(a[17], a[25]);
    CEU(a[18], a[26]);
    CEU(a[19], a[27]);
    CEU(a[20], a[28]);
    CEU(a[21], a[29]);
    CEU(a[22], a[30]);
    CEU(a[23], a[31]);
    CEU(a[16], a[20]);
    CEU(a[17], a[21]);
    CEU(a[18], a[22]);
    CEU(a[19], a[23]);
    CEU(a[24], a[28]);
    CEU(a[25], a[29]);
    CEU(a[26], a[30]);
    CEU(a[27], a[31]);
    CEU(a[16], a[18]);
    CEU(a[17], a[19]);
    CEU(a[20], a[22]);
    CEU(a[21], a[23]);
    CEU(a[24], a[26]);
    CEU(a[25], a[27]);
    CEU(a[28], a[30]);
    CEU(a[29], a[31]);
    CEU(a[16], a[17]);
    CEU(a[18], a[19]);
    CEU(a[20], a[21]);
    CEU(a[22], a[23]);
    CEU(a[24], a[25]);
    CEU(a[26], a[27]);
    CEU(a[28], a[29]);
    CEU(a[30], a[31]);
    t[0] = a[0] > a[31] ? a[0] : a[31];
    t[1] = a[1] > a[30] ? a[1] : a[30];
    t[2] = a[2] > a[29] ? a[2] : a[29];
    t[3] = a[3] > a[28] ? a[3] : a[28];
    t[4] = a[4] > a[27] ? a[4] : a[27];
    t[5] = a[5] > a[26] ? a[5] : a[26];
    t[6] = a[6] > a[25] ? a[6] : a[25];
    t[7] = a[7] > a[24] ? a[7] : a[24];
    t[8] = a[8] > a[23] ? a[8] : a[23];
    t[9] = a[9] > a[22] ? a[9] : a[22];
    t[10] = a[10] > a[21] ? a[10] : a[21];
    t[11] = a[11] > a[20] ? a[11] : a[20];
    t[12] = a[12] > a[19] ? a[12] : a[19];
    t[13] = a[13] > a[18] ? a[13] : a[18];
    t[14] = a[14] > a[17] ? a[14] : a[17];
    t[15] = a[15] > a[16] ? a[15] : a[16];
    CEU(t[0], t[8]);
    CEU(t[1], t[9]);
    CEU(t[2], t[10]);
    CEU(t[3], t[11]);
    CEU(t[4], t[12]);
    CEU(t[5], t[13]);
    CEU(t[6], t[14]);
    CEU(t[7], t[15]);
    CEU(t[0], t[4]);
    CEU(t[1], t[5]);
    CEU(t[2], t[6]);
    CEU(t[3], t[7]);
    CEU(t[8], t[12]);
    CEU(t[9], t[13]);
    CEU(t[10], t[14]);
    CEU(t[11], t[15]);
    CEU(t[0], t[2]);
    CEU(t[1], t[3]);
    CEU(t[4], t[6]);
    CEU(t[5], t[7]);
    CEU(t[8], t[10]);
    CEU(t[9], t[11]);
    CEU(t[12], t[14]);
    CEU(t[13], t[15]);
    CEU(t[0], t[1]);
    CEU(t[2], t[3]);
    CEU(t[4], t[5]);
    CEU(t[6], t[7]);
    CEU(t[8], t[9]);
    CEU(t[10], t[11]);
    CEU(t[12], t[13]);
    CEU(t[14], t[15]);
    { unsigned o[16];
      o[0] = (unsigned)__shfl_xor((int)t[15], 16);
      o[1] = (unsigned)__shfl_xor((int)t[14], 16);
      o[2] = (unsigned)__shfl_xor((int)t[13], 16);
      o[3] = (unsigned)__shfl_xor((int)t[12], 16);
      o[4] = (unsigned)__shfl_xor((int)t[11], 16);
      o[5] = (unsigned)__shfl_xor((int)t[10], 16);
      o[6] = (unsigned)__shfl_xor((int)t[9], 16);
      o[7] = (unsigned)__shfl_xor((int)t[8], 16);
      o[8] = (unsigned)__shfl_xor((int)t[7], 16);
      o[9] = (unsigned)__shfl_xor((int)t[6], 16);
      o[10] = (unsigned)__shfl_xor((int)t[5], 16);
      o[11] = (unsigned)__shfl_xor((int)t[4], 16);
      o[12] = (unsigned)__shfl_xor((int)t[3], 16);
      o[13] = (unsigned)__shfl_xor((int)t[2], 16);
      o[14] = (unsigned)__shfl_xor((int)t[1], 16);
      o[15] = (unsigned)__shfl_xor((int)t[0], 16);
      t[0] = t[0] > o[0] ? t[0] : o[0];
      t[1] = t[1] > o[1] ? t[1] : o[1];
      t[2] = t[2] > o[2] ? t[2] : o[2];
      t[3] = t[3] > o[3] ? t[3] : o[3];
      t[4] = t[4] > o[4] ? t[4] : o[4];
      t[5] = t[5] > o[5] ? t[5] : o[5];
      t[6] = t[6] > o[6] ? t[6] : o[6];
      t[7] = t[7] > o[7] ? t[7] : o[7];
      t[8] = t[8] > o[8] ? t[8] : o[8];
      t[9] = t[9] > o[9] ? t[9] : o[9];
      t[10] = t[10] > o[10] ? t[10] : o[10];
      t[11] = t[11] > o[11] ? t[11] : o[11];
      t[12] = t[12] > o[12] ? t[12] : o[12];
      t[13] = t[13] > o[13] ? t[13] : o[13];
      t[14] = t[14] > o[14] ? t[14] : o[14];
      t[15] = t[15] > o[15] ? t[15] : o[15];
    }
    CEU(t[0], t[8]);
    CEU(t[1], t[9]);
    CEU(t[2], t[10]);
    CEU(t[3], t[11]);
    CEU(t[4], t[12]);
    CEU(t[5], t[13]);
    CEU(t[6], t[14]);
    CEU(t[7], t[15]);
    CEU(t[0], t[4]);
    CEU(t[1], t[5]);
    CEU(t[2], t[6]);
    CEU(t[3], t[7]);
    CEU(t[8], t[12]);
    CEU(t[9], t[13]);
    CEU(t[10], t[14]);
    CEU(t[11], t[15]);
    CEU(t[0], t[2]);
    CEU(t[1], t[3]);
    CEU(t[4], t[6]);
    CEU(t[5], t[7]);
    CEU(t[8], t[10]);
    CEU(t[9], t[11]);
    CEU(t[12], t[14]);
    CEU(t[13], t[15]);
    CEU(t[0], t[1]);
    CEU(t[2], t[3]);
    CEU(t[4], t[5]);
    CEU(t[6], t[7]);
    CEU(t[8], t[9]);
    CEU(t[10], t[11]);
    CEU(t[12], t[13]);
    CEU(t[14], t[15]);
    { unsigned o[16];
      o[0] = (unsigned)__shfl_xor((int)t[15], 32);
      o[1] = (unsigned)__shfl_xor((int)t[14], 32);
      o[2] = (unsigned)__shfl_xor((int)t[13], 32);
      o[3] = (unsigned)__shfl_xor((int)t[12], 32);
      o[4] = (unsigned)__shfl_xor((int)t[11], 32);
      o[5] = (unsigned)__shfl_xor((int)t[10], 32);
      o[6] = (unsigned)__shfl_xor((int)t[9], 32);
      o[7] = (unsigned)__shfl_xor((int)t[8], 32);
      o[8] = (unsigned)__shfl_xor((int)t[7], 32);
      o[9] = (unsigned)__shfl_xor((int)t[6], 32);
      o[10] = (unsigned)__shfl_xor((int)t[5], 32);
      o[11] = (unsigned)__shfl_xor((int)t[4], 32);
      o[12] = (unsigned)__shfl_xor((int)t[3], 32);
      o[13] = (unsigned)__shfl_xor((int)t[2], 32);
      o[14] = (unsigned)__shfl_xor((int)t[1], 32);
      o[15] = (unsigned)__shfl_xor((int)t[0], 32);
      t[0] = t[0] > o[0] ? t[0] : o[0];
      t[1] = t[1] > o[1] ? t[1] : o[1];
      t[2] = t[2] > o[2] ? t[2] : o[2];
      t[3] = t[3] > o[3] ? t[3] : o[3];
      t[4] = t[4] > o[4] ? t[4] : o[4];
      t[5] = t[5] > o[5] ? t[5] : o[5];
      t[6] = t[6] > o[6] ? t[6] : o[6];
      t[7] = t[7] > o[7] ? t[7] : o[7];
      t[8] = t[8] > o[8] ? t[8] : o[8];
      t[9] = t[9] > o[9] ? t[9] : o[9];
      t[10] = t[10] > o[10] ? t[10] : o[10];
      t[11] = t[11] > o[11] ? t[11] : o[11];
      t[12] = t[12] > o[12] ? t[12] : o[12];
      t[13] = t[13] > o[13] ? t[13] : o[13];
      t[14] = t[14] > o[14] ? t[14] : o[14];
      t[15] = t[15] > o[15] ? t[15] : o[15];
    }
    CEU(t[0], t[8]);
    CEU(t[1], t[9]);
    CEU(t[2], t[10]);
    CEU(t[3], t[11]);
    CEU(t[4], t[12]);
    CEU(t[5], t[13]);
    CEU(t[6], t[14]);
    CEU(t[7], t[15]);
    CEU(t[0], t[4]);
    CEU(t[1], t[5]);
    CEU(t[2], t[6]);
    CEU(t[3], t[7]);
    CEU(t[8], t[12]);
    CEU(t[9], t[13]);
    CEU(t[10], t[14]);
    CEU(t[11], t[15]);
    CEU(t[0], t[2]);
    CEU(t[1], t[3]);
    CEU(t[4], t[6]);
    CEU(t[5], t[7]);
    CEU(t[8], t[10]);
    CEU(t[9], t[11]);
    CEU(t[12], t[14]);
    CEU(t[13], t[15]);
    CEU(t[0], t[1]);
    CEU(t[2], t[3]);
    CEU(t[4], t[5]);
    CEU(t[6], t[7]);
    CEU(t[8], t[9]);
    CEU(t[10], t[11]);
    CEU(t[12], t[13]);
    CEU(t[14], t[15]);
}
__device__ __forceinline__ void sel_phase(Frame& F, const Args& args) {
    const int lane_ = lane_now(), tid_ = F.wave * 64 + lane_; (void)tid_;
    LAS unsigned char* KL = F.lds;
    const int h = F.vcu & 7, r = lane_ & 15, g = lane_ >> 4;
    unsigned short* SELI = (unsigned short*)W_SLAB(SL_SEL); float* SELG = (float*)(W_SLAB(SL_SEL)) + (size_t)M * NSEL;
    { const v4u* gk = (const v4u*)(W_KEYS + (size_t)h * 2 * NKEY * 128);
#pragma unroll
      for (int i = 0; i < 8; ++i) { const int p = tid_ + 512 * i, row = p >> 4, c16 = p & 15; *(LAS v4u*)(KL + row * 272 + c16 * 16) = gk[p]; } }
    __syncthreads();
    const int njob = M / 16, jstride = (F.G >> 3) * NWAVES;
    const int job0 = (F.vcu >> 3) * NWAVES + F.wave;
    bf16x8 bqn[8];
    if (job0 < njob) { const bf16* qp = W_SLAB(SL_QP) + (size_t)(job0 * 16 + r) * DM + h * 256 + 8 * g;
#pragma unroll
        for (int i = 0; i < 8; ++i) bqn[i] = *(const bf16x8*)(qp + 32 * i); }
    for (int job = job0; job < njob; job += jstride) {
        const int tok = job * 16 + r;
        unsigned ta[16], tb[16];
        bf16x8 bqc[8];
#pragma unroll
        for (int i = 0; i < 8; ++i) bqc[i] = bqn[i];
        if (job + jstride < njob) { const bf16* qp = W_SLAB(SL_QP) + (size_t)((job + jstride) * 16 + r) * DM + h * 256 + 8 * g;
#pragma unroll
            for (int i = 0; i < 8; ++i) bqn[i] = *(const bf16x8*)(qp + 32 * i); }
#pragma unroll
        for (int pp = 0; pp < 2; ++pp) {
            bf16x8 bq[4];
#pragma unroll
            for (int ks = 0; ks < 4; ++ks) bq[ks] = bqc[4 * pp + ks];
            unsigned a[32];
#pragma unroll
            for (int kt = 0; kt < 8; ++kt) { f32x4 acc = (f32x4){0.f, 0.f, 0.f, 0.f};
#pragma unroll
                for (int ks = 0; ks < 4; ++ks) { const bf16x8 av = *(const LAS bf16x8*)(KL + (pp * 128 + kt * 16 + r) * 272 + ks * 64 + g * 16); acc = __builtin_amdgcn_mfma_f32_16x16x32_bf16(av, bq[ks], acc, 0, 0, 0); }
#pragma unroll
                for (int j = 0; j < 4; ++j) a[kt * 4 + j] = sel_key(acc[j], kt * 16 + 4 * g + j);
                __builtin_amdgcn_sched_barrier(0); }
            if (pp == 0) sel_top16(a, ta); else sel_top16(a, tb);
        }
        float va[16], vb[16]; int ia[16], ib[16];
#pragma unroll
        for (int i = 0; i < 16; ++i) { va[i] = sel_val(ta[i]); vb[i] = sel_val(tb[i]); ia[i] = (int)(ta[i] & 127u); ib[i] = (int)(tb[i] & 127u); }
        float cv[16]; int ci[16];
        cv[0] = va[0] + SEL4(g, vb[0], vb[1], vb[2], vb[3]); ci[0] = ia[0] * NKEY + SEL4(g, ib[0], ib[1], ib[2], ib[3]);
        cv[1] = va[0] + SEL4(g, vb[4], vb[5], vb[6], vb[7]); ci[1] = ia[0] * NKEY + SEL4(g, ib[4], ib[5], ib[6], ib[7]);
        cv[2] = va[0] + SEL4(g, vb[8], vb[9], vb[10], vb[11]); ci[2] = ia[0] * NKEY + SEL4(g, ib[8], ib[9], ib[10], ib[11]);
        cv[3] = va[0] + SEL4(g, vb[12], vb[13], vb[14], vb[15]); ci[3] = ia[0] * NKEY + SEL4(g, ib[12], ib[13], ib[14], ib[15]);
        cv[4] = va[1] + SEL4(g, vb[0], vb[1], vb[2], vb[3]); ci[4] = ia[1] * NKEY + SEL4(g, ib[0], ib[1], ib[2], ib[3]);
        cv[5] = va[1] + SEL4(g, vb[4], vb[5], vb[6], vb[7]); ci[5] = ia[1] * NKEY + SEL4(g, ib[4], ib[5], ib[6], ib[7]);
        cv[6] = va[2] + SEL4(g, vb[0], vb[1], vb[2], vb[3]); ci[6] = ia[2] * NKEY + SEL4(g, ib[0], ib[1], ib[2], ib[3]);
        cv[7] = SEL4(g, va[2], va[3], va[3], va[3]) + SEL4(g, vb[4], vb[0], vb[1], vb[2]); ci[7] = SEL4(g, ia[2], ia[3], ia[3], ia[3]) * NKEY + SEL4(g, ib[4], ib[0], ib[1], ib[2]);
        cv[8] = SEL4(g, va[3], va[4], va[4], va[4]) + SEL4(g, vb[3], vb[0], vb[1], vb[2]); ci[8] = SEL4(g, ia[3], ia[4], ia[4], ia[4]) * NKEY + SEL4(g, ib[3], ib[0], ib[1], ib[2]);
        cv[9] = SEL4(g, va[5], va[5], va[6], va[6]) + SEL4(g, vb[0], vb[1], vb[0], vb[1]); ci[9] = SEL4(g, ia[5], ia[5], ia[6], ia[6]) * NKEY + SEL4(g, ib[0], ib[1], ib[0], ib[1]);
        cv[10] = SEL4(g, va[7], va[7], va[8], va[9]) + SEL4(g, vb[0], vb[1], vb[0], vb[0]); ci[10] = SEL4(g, ia[7], ia[7], ia[8], ia[9]) * NKEY + SEL4(g, ib[0], ib[1], ib[0], ib[0]);
        cv[11] = SEL4(g, va[10], va[11], va[12], va[13]) + vb[0]; ci[11] = SEL4(g, ia[10], ia[11], ia[12], ia[13]) * NKEY + ib[0];
        { const float sa = SEL4(g, va[14], va[15], 0.f, 0.f), sb = SEL4(g, vb[0], vb[0], 0.f, 0.f); const bool pad = g == 2 || g == 3;
          cv[12] = pad ? -3.0e38f : sa + sb; ci[12] = SEL4(g, ia[14], ia[15], 0, 0) * NKEY + SEL4(g, ib[0], ib[0], 0, 0); }
        cv[13] = -3.0e38f; ci[13] = 0;
        cv[14] = -3.0e38f; ci[14] = 0;
        cv[15] = -3.0e38f; ci[15] = 0;
        CEP(cv[0], ci[0], cv[1], ci[1]);
        CEP(cv[3], ci[3], cv[2], ci[2]);
        CEP(cv[4], ci[4], cv[5], ci[5]);
        CEP(cv[7], ci[7], cv[6], ci[6]);
        CEP(cv[8], ci[8], cv[9], ci[9]);
        CEP(cv[11], ci[11], cv[10], ci[10]);
        CEP(cv[12], ci[12], cv[13], ci[13]);
        CEP(cv[15], ci[15], cv[14], ci[14]);
        CEP(cv[0], ci[0], cv[2], ci[2]);
        CEP(cv[1], ci[1], cv[3], ci[3]);
        CEP(cv[6], ci[6], cv[4], ci[4]);
        CEP(cv[7], ci[7], cv[5], ci[5]);
        CEP(cv[8], ci[8], cv[10], ci[10]);
        CEP(cv[9], ci[9], cv[11], ci[11]);
        CEP(cv[14], ci[14], cv[12], ci[12]);
        CEP(cv[15], ci[15], cv[13], ci[13]);
        CEP(cv[0], ci[0], cv[1], ci[1]);
        CEP(cv[2], ci[2], cv[3], ci[3]);
        CEP(cv[5], ci[5], cv[4], ci[4]);
        CEP(cv[7], ci[7], cv[6], ci[6]);
        CEP(cv[8], ci[8], cv[9], ci[9]);
        CEP(cv[10], ci[10], cv[11], ci[11]);
        CEP(cv[13], ci[13], cv[12], ci[12]);
        CEP(cv[15], ci[15], cv[14], ci[14]);
        CEP(cv[0], ci[0], cv[4], ci[4]);
        CEP(cv[1], ci[1], cv[5], ci[5]);
        CEP(cv[2], ci[2], cv[6], ci[6]);
        CEP(cv[3], ci[3], cv[7], ci[7]);
        CEP(cv[12], ci[12], cv[8], ci[8]);
        CEP(cv[13], ci[13], cv[9], ci[9]);
        CEP(cv[14], ci[14], cv[10], ci[10]);
        CEP(cv[15], ci[15], cv[11], ci[11]);
        CEP(cv[0], ci[0], cv[2], ci[2]);
        CEP(cv[1], ci[1], cv[3], ci[3]);
        CEP(cv[4], ci[4], cv[6], ci[6]);
        CEP(cv[5], ci[5], cv[7], ci[7]);
        CEP(cv[10], ci[10], cv[8], ci[8]);
        CEP(cv[11], ci[11], cv[9], ci[9]);
        CEP(cv[14], ci[14], cv[12], ci[12]);
        CEP(cv[15], ci[15], cv[13], ci[13]);
        CEP(cv[0], ci[0], cv[1], ci[1]);
        CEP(cv[2], ci[2], cv[3], ci[3]);
        CEP(cv[4], ci[4], cv[5], ci[5]);
        CEP(cv[6], ci[6], cv[7], ci[7]);
        CEP(cv[9], ci[9], cv[8], ci[8]);
        CEP(cv[11], ci[11], cv[10], ci[10]);
        CEP(cv[13], ci[13], cv[12], ci[12]);
        CEP(cv[15], ci[15], cv[14], ci[14]);
        CEP(cv[0], ci[0], cv[8], ci[8]);
        CEP(cv[1], ci[1], cv[9], ci[9]);
        CEP(cv[2], ci[2], cv[10], ci[10]);
        CEP(cv[3], ci[3], cv[11], ci[11]);
        CEP(cv[4], ci[4], cv[12], ci[12]);
        CEP(cv[5], ci[5], cv[13], ci[13]);
        CEP(cv[6], ci[6], cv[14], ci[14]);
        CEP(cv[7], ci[7], cv[15], ci[15]);
        CEP(cv[0], ci[0], cv[4], ci[4]);
        CEP(cv[1], ci[1], cv[5], ci[5]);
        CEP(cv[2], ci[2], cv[6], ci[6]);
        CEP(cv[3], ci[3], cv[7], ci[7]);
        CEP(cv[8], ci[8], cv[12], ci[12]);
        CEP(cv[9], ci[9], cv[13], ci[13]);
        CEP(cv[10], ci[10], cv[14], ci[14]);
        CEP(cv[11], ci[11], cv[15], ci[15]);
        CEP(cv[0], ci[0], cv[2], ci[2]);
        CEP(cv[1], ci[1], cv[3], ci[3]);
        CEP(cv[4], ci[4], cv[6], ci[6]);
        CEP(cv[5], ci[5], cv[7], ci[7]);
        CEP(cv[8], ci[8], cv[10], ci[10]);
        CEP(cv[9], ci[9], cv[11], ci[11]);
        CEP(cv[12], ci[12], cv[14], ci[14]);
        CEP(cv[13], ci[13], cv[15], ci[15]);
        CEP(cv[0], ci[0], cv[1], ci[1]);
        CEP(cv[2], ci[2], cv[3], ci[3]);
        CEP(cv[4], ci[4], cv[5], ci[5]);
        CEP(cv[6], ci[6], cv[7], ci[7]);
        CEP(cv[8], ci[8], cv[9], ci[9]);
        CEP(cv[10], ci[10], cv[11], ci[11]);
        CEP(cv[12], ci[12], cv[13], ci[13]);
        CEP(cv[14], ci[14], cv[15], ci[15]);
        { float ov[16]; int oi[16];
          ov[0] = __shfl_xor(cv[15], 16); oi[0] = __shfl_xor(ci[15], 16);
          ov[1] = __shfl_xor(cv[14], 16); oi[1] = __shfl_xor(ci[14], 16);
          ov[2] = __shfl_xor(cv[13], 16); oi[2] = __shfl_xor(ci[13], 16);
          ov[3] = __shfl_xor(cv[12], 16); oi[3] = __shfl_xor(ci[12], 16);
          ov[4] = __shfl_xor(cv[11], 16); oi[4] = __shfl_xor(ci[11], 16);
          ov[5] = __shfl_xor(cv[10], 16); oi[5] = __shfl_xor(ci[10], 16);
          ov[6] = __shfl_xor(cv[9], 16); oi[6] = __shfl_xor(ci[9], 16);
          ov[7] = __shfl_xor(cv[8], 16); oi[7] = __shfl_xor(ci[8], 16);
          ov[8] = __shfl_xor(cv[7], 16); oi[8] = __shfl_xor(ci[7], 16);
          ov[9] = __shfl_xor(cv[6], 16); oi[9] = __shfl_xor(ci[6], 16);
          ov[10] = __shfl_xor(cv[5], 16); oi[10] = __shfl_xor(ci[5], 16);
          ov[11] = __shfl_xor(cv[4], 16); oi[11] = __shfl_xor(ci[4], 16);
          ov[12] = __shfl_xor(cv[3], 16); oi[12] = __shfl_xor(ci[3], 16);
          ov[13] = __shfl_xor(cv[2], 16); oi[13] = __shfl_xor(ci[2], 16);
          ov[14] = __shfl_xor(cv[1], 16); oi[14] = __shfl_xor(ci[1], 16);
          ov[15] = __shfl_xor(cv[0], 16); oi[15] = __shfl_xor(ci[0], 16);
          { const bool s_ = ov[0] > cv[0]; cv[0] = s_ ? ov[0] : cv[0]; ci[0] = s_ ? oi[0] : ci[0]; }
          { const bool s_ = ov[1] > cv[1]; cv[1] = s_ ? ov[1] : cv[1]; ci[1] = s_ ? oi[1] : ci[1]; }
          { const bool s_ = ov[2] > cv[2]; cv[2] = s_ ? ov[2] : cv[2]; ci[2] = s_ ? oi[2] : ci[2]; }
          { const bool s_ = ov[3] > cv[3]; cv[3] = s_ ? ov[3] : cv[3]; ci[3] = s_ ? oi[3] : ci[3]; }
          { const bool s_ = ov[4] > cv[4]; cv[4] = s_ ? ov[4] : cv[4]; ci[4] = s_ ? oi[4] : ci[4]; }
          { const bool s_ = ov[5] > cv[5]; cv[5] = s_ ? ov[5] : cv[5]; ci[5] = s_ ? oi[5] : ci[5]; }
          { const bool s_ = ov[6] > cv[6]; cv[6] = s_ ? ov[6] : cv[6]; ci[6] = s_ ? oi[6] : ci[6]; }
          { const bool s_ = ov[7] > cv[7]; cv[7] = s_ ? ov[7] : cv[7]; ci[7] = s_ ? oi[7] : ci[7]; }
          { const bool s_ = ov[8] > cv[8]; cv[8] = s_ ? ov[8] : cv[8]; ci[8] = s_ ? oi[8] : ci[8]; }
          { const bool s_ = ov[9] > cv[9]; cv[9] = s_ ? ov[9] : cv[9]; ci[9] = s_ ? oi[9] : ci[9]; }
          { const bool s_ = ov[10] > cv[10]; cv[10] = s_ ? ov[10] : cv[10]; ci[10] = s_ ? oi[10] : ci[10]; }
          { const bool s_ = ov[11] > cv[11]; cv[11] = s_ ? ov[11] : cv[11]; ci[11] = s_ ? oi[11] : ci[11]; }
          { const bool s_ = ov[12] > cv[12]; cv[12] = s_ ? ov[12] : cv[12]; ci[12] = s_ ? oi[12] : ci[12]; }
          { const bool s_ = ov[13] > cv[13]; cv[13] = s_ ? ov[13] : cv[13]; ci[13] = s_ ? oi[13] : ci[13]; }
          { const bool s_ = ov[14] > cv[14]; cv[14] = s_ ? ov[14] : cv[14]; ci[14] = s_ ? oi[14] : ci[14]; }
          { const bool s_ = ov[15] > cv[15]; cv[15] = s_ ? ov[15] : cv[15]; ci[15] = s_ ? oi[15] : ci[15]; }
        }
        CEP(cv[0], ci[0], cv[8], ci[8]);
        CEP(cv[1], ci[1], cv[9], ci[9]);
        CEP(cv[2], ci[2], cv[10], ci[10]);
        CEP(cv[3], ci[3], cv[11], ci[11]);
        CEP(cv[4], ci[4], cv[12], ci[12]);
        CEP(cv[5], ci[5], cv[13], ci[13]);
        CEP(cv[6], ci[6], cv[14], ci[14]);
        CEP(cv[7], ci[7], cv[15], ci[15]);
        CEP(cv[0], ci[0], cv[4], ci[4]);
        CEP(cv[1], ci[1], cv[5], ci[5]);
        CEP(cv[2], ci[2], cv[6], ci[6]);
        CEP(cv[3], ci[3], cv[7], ci[7]);
        CEP(cv[8], ci[8], cv[12], ci[12]);
        CEP(cv[9], ci[9], cv[13], ci[13]);
        CEP(cv[10], ci[10], cv[14], ci[14]);
        CEP(cv[11], ci[11], cv[15], ci[15]);
        CEP(cv[0], ci[0], cv[2], ci[2]);
        CEP(cv[1], ci[1], cv[3], ci[3]);
        CEP(cv[4], ci[4], cv[6], ci[6]);
        CEP(cv[5], ci[5], cv[7], ci[7]);
        CEP(cv[8], ci[8], cv[10], ci[10]);
        CEP(cv[9], ci[9], cv[11], ci[11]);
        CEP(cv[12], ci[12], cv[14], ci[14]);
        CEP(cv[13], ci[13], cv[15], ci[15]);
        CEP(cv[0], ci[0], cv[1], ci[1]);
        CEP(cv[2], ci[2], cv[3], ci[3]);
        CEP(cv[4], ci[4], cv[5], ci[5]);
        CEP(cv[6], ci[6], cv[7], ci[7]);
        CEP(cv[8], ci[8], cv[9], ci[9]);
        CEP(cv[10], ci[10], cv[11], ci[11]);
        CEP(cv[12], ci[12], cv[13], ci[13]);
        CEP(cv[14], ci[14], cv[15], ci[15]);
        { float ov[16]; int oi[16];
          ov[0] = __shfl_xor(cv[15], 32); oi[0] = __shfl_xor(ci[15], 32);
          ov[1] = __shfl_xor(cv[14], 32); oi[1] = __shfl_xor(ci[14], 32);
          ov[2] = __shfl_xor(cv[13], 32); oi[2] = __shfl_xor(ci[13], 32);
          ov[3] = __shfl_xor(cv[12], 32); oi[3] = __shfl_xor(ci[12], 32);
          ov[4] = __shfl_xor(cv[11], 32); oi[4] = __shfl_xor(ci[11], 32);
          ov[5] = __shfl_xor(cv[10], 32); oi[5] = __shfl_xor(ci[10], 32);
          ov[6] = __shfl_xor(cv[9], 32); oi[6] = __shfl_xor(ci[9], 32);
          ov[7] = __shfl_xor(cv[8], 32); oi[7] = __shfl_xor(ci[8], 32);
          ov[8] = __shfl_xor(cv[7], 32); oi[8] = __shfl_xor(ci[7], 32);
          ov[9] = __shfl_xor(cv[6], 32); oi[9] = __shfl_xor(ci[6], 32);
          ov[10] = __shfl_xor(cv[5], 32); oi[10] = __shfl_xor(ci[5], 32);
          ov[11] = __shfl_xor(cv[4], 32); oi[11] = __shfl_xor(ci[4], 32);
          ov[12] = __shfl_xor(cv[3], 32); oi[12] = __shfl_xor(ci[3], 32);
          ov[13] = __shfl_xor(cv[2], 32); oi[13] = __shfl_xor(ci[2], 32);
          ov[14] = __shfl_xor(cv[1], 32); oi[14] = __shfl_xor(ci[1], 32);
          ov[15] = __shfl_xor(cv[0], 32); oi[15] = __shfl_xor(ci[0], 32);
          { const bool s_ = ov[0] > cv[0]; cv[0] = s_ ? ov[0] : cv[0]; ci[0] = s_ ? oi[0] : ci[0]; }
          { const bool s_ = ov[1] > cv[1]; cv[1] = s_ ? ov[1] : cv[1]; ci[1] = s_ ? oi[1] : ci[1]; }
          { const bool s_ = ov[2] > cv[2]; cv[2] = s_ ? ov[2] : cv[2]; ci[2] = s_ ? oi[2] : ci[2]; }
          { const bool s_ = ov[3] > cv[3]; cv[3] = s_ ? ov[3] : cv[3]; ci[3] = s_ ? oi[3] : ci[3]; }
          { const bool s_ = ov[4] > cv[4]; cv[4] = s_ ? ov[4] : cv[4]; ci[4] = s_ ? oi[4] : ci[4]; }
          { const bool s_ = ov[5] > cv[5]; cv[5] = s_ ? ov[5] : cv[5]; ci[5] = s_ ? oi[5] : ci[5]; }
          { const bool s_ = ov[6] > cv[6]; cv[6] = s_ ? ov[6] : cv[6]; ci[6] = s_ ? oi[6] : ci[6]; }
          { const bool s_ = ov[7] > cv[7]; cv[7] = s_ ? ov[7] : cv[7]; ci[7] = s_ ? oi[7] : ci[7]; }
          { const bool s_ = ov[8] > cv[8]; cv[8] = s_ ? ov[8] : cv[8]; ci[8] = s_ ? oi[8] : ci[8]; }
          { const bool s_ = ov[9] > cv[9]; cv[9] = s_ ? ov[9] : cv[9]; ci[9] = s_ ? oi[9] : ci[9]; }
          { const bool s_ = ov[10] > cv[10]; cv[10] = s_ ? ov[10] : cv[10]; ci[10] = s_ ? oi[10] : ci[10]; }
          { const bool s_ = ov[11] > cv[11]; cv[11] = s_ ? ov[11] : cv[11]; ci[11] = s_ ? oi[11] : ci[11]; }
          { const bool s_ = ov[12] > cv[12]; cv[12] = s_ ? ov[12] : cv[12]; ci[12] = s_ ? oi[12] : ci[12]; }
          { const bool s_ = ov[13] > cv[13]; cv[13] = s_ ? ov[13] : cv[13]; ci[13] = s_ ? oi[13] : ci[13]; }
          { const bool s_ = ov[14] > cv[14]; cv[14] = s_ ? ov[14] : cv[14]; ci[14] = s_ ? oi[14] : ci[14]; }
          { const bool s_ = ov[15] > cv[15]; cv[15] = s_ ? ov[15] : cv[15]; ci[15] = s_ ? oi[15] : ci[15]; }
        }
        CEP(cv[0], ci[0], cv[8], ci[8]);
        CEP(cv[1], ci[1], cv[9], ci[9]);
        CEP(cv[2], ci[2], cv[10], ci[10]);
        CEP(cv[3], ci[3], cv[11], ci[11]);
        CEP(cv[4], ci[4], cv[12], ci[12]);
        CEP(cv[5], ci[5], cv[13], ci[13]);
        CEP(cv[6], ci[6], cv[14], ci[14]);
        CEP(cv[7], ci[7], cv[15], ci[15]);
        CEP(cv[0], ci[0], cv[4], ci[4]);
        CEP(cv[1], ci[1], cv[5], ci[5]);
        CEP(cv[2], ci[2], cv[6], ci[6]);
        CEP(cv[3], ci[3], cv[7], ci[7]);
        CEP(cv[8], ci[8], cv[12], ci[12]);
        CEP(cv[9], ci[9], cv[13], ci[13]);
        CEP(cv[10], ci[10], cv[14], ci[14]);
        CEP(cv[11], ci[11], cv[15], ci[15]);
        CEP(cv[0], ci[0], cv[2], ci[2]);
        CEP(cv[1], ci[1], cv[3], ci[3]);
        CEP(cv[4], ci[4], cv[6], ci[6]);
        CEP(cv[5], ci[5], cv[7], ci[7]);
        CEP(cv[8], ci[8], cv[10], ci[10]);
        CEP(cv[9], ci[9], cv[11], ci[11]);
        CEP(cv[12], ci[12], cv[14], ci[14]);
        CEP(cv[13], ci[13], cv[15], ci[15]);
        CEP(cv[0], ci[0], cv[1], ci[1]);
        CEP(cv[2], ci[2], cv[3], ci[3]);
        CEP(cv[4], ci[4], cv[5], ci[5]);
        CEP(cv[6], ci[6], cv[7], ci[7]);
        CEP(cv[8], ci[8], cv[9], ci[9]);
        CEP(cv[10], ci[10], cv[11], ci[11]);
        CEP(cv[12], ci[12], cv[13], ci[13]);
        CEP(cv[14], ci[14], cv[15], ci[15]);
        float ex[16], sum = 0.f;
#pragma unroll
        for (int i = 0; i < 16; ++i) { ex[i] = __expf(cv[i] - cv[0]); sum += ex[i]; }
        const float inv = 1.0f / sum;
        v4u oi4; f32x4 og4;
        oi4[0] = (unsigned)SEL4(g, ci[0], ci[4], ci[8], ci[12]); og4[0] = SEL4(g, ex[0], ex[4], ex[8], ex[12]) * inv;
        oi4[1] = (unsigned)SEL4(g, ci[1], ci[5], ci[9], ci[13]); og4[1] = SEL4(g, ex[1], ex[5], ex[9], ex[13]) * inv;
        oi4[2] = (unsigned)SEL4(g, ci[2], ci[6], ci[10], ci[14]); og4[2] = SEL4(g, ex[2], ex[6], ex[10], ex[14]) * inv;
        oi4[3] = (unsigned)SEL4(g, ci[3], ci[7], ci[11], ci[15]); og4[3] = SEL4(g, ex[3], ex[7], ex[11], ex[15]) * inv;
        { v2u o2; o2.x = oi4[0] | (oi4[1] << 16); o2.y = oi4[2] | (oi4[3] << 16); *(v2u*)(SELI + (size_t)tok * NSEL + h * TOPK + 4 * g) = o2; } *(f32x4*)(SELG + (size_t)tok * NSEL + h * TOPK + 4 * g) = og4;
    }
}

constexpr int NSLICE = 16;
struct DotsPre { v4u idv[2]; v4u xw[2]; float rstd; };
struct AxpyPre { v4u idv[2]; f32x2 hv; };
#define SLICE_EID(idv, i) (((idv)[(i) >> 3][((i) >> 1) & 3] >> (16 * ((i) & 1))) & 0xffffu)
__device__ __forceinline__ void dots_pre(DotsPre& P, const Args& args, int tok, int sl, int lane) {
    const int m = lane & 7, sg = lane >> 3;
    const unsigned short* SELI = (const unsigned short*)W_SLAB(SL_SEL);
    P.idv[0] = *(const v4u*)(SELI + (size_t)tok * NSEL + 16 * sg); P.idv[1] = *(const v4u*)(SELI + (size_t)tok * NSEL + 16 * sg + 8);
    const bf16* xp = W_SLAB(SL_H2B) + (size_t)tok * DM + 128 * sl + 16 * m;
    P.xw[0] = *(const v4u*)xp; P.xw[1] = *(const v4u*)(xp + 8);
    P.rstd = W_RSTD2[tok];
}
__device__ __forceinline__ void axpy_pre(AxpyPre& P, const Args& args, int tok, int sl, int lane) {
    const int m = lane & 7, sg = lane >> 3;
    const unsigned short* SELI = (const unsigned short*)W_SLAB(SL_SEL);
    P.idv[0] = *(const v4u*)(SELI + (size_t)tok * NSEL + 16 * sg); P.idv[1] = *(const v4u*)(SELI + (size_t)tok * NSEL + 16 * sg + 8);
    { const unsigned hw = *(const unsigned*)(W_SLAB(SL_H2B) + (size_t)tok * DM + 128 * sl + 16 * m + 2 * sg); P.hv = (f32x2){bflo(hw), bfhi(hw)}; }
}
__device__ __forceinline__ void slice_rows(v4u (&R)[16], const v4u (&idv)[2], const unsigned char* tb) {
#pragma unroll
    for (int i = 0; i < 16; ++i) R[i] = *(const v4u*)(tb + (size_t)SLICE_EID(idv, i) * DM);
}
__device__ __forceinline__ void dots_comp(const v4u (&R)[16], const DotsPre& P, LAS float* acc_row, bool first, int lane) {
    const bool m4 = lane & 4, m2 = lane & 2, m1 = lane & 1;
    const float rstd = P.rstd;
    f32x2 xs[8];
#pragma unroll
    for (int q = 0; q < 2; ++q)
#pragma unroll
        for (int w = 0; w < 4; ++w) xs[4 * q + w] = (f32x2){bflo(P.xw[q][w]) * rstd, bfhi(P.xw[q][w]) * rstd};
    float p[16];
#pragma unroll
    for (int i = 0; i < 16; ++i) { f32x2 d2 = (f32x2){0.f, 0.f};
#pragma unroll
        for (int w = 0; w < 4; ++w) { d2 += xs[2 * w] * __builtin_amdgcn_cvt_pk_f32_fp8((int)R[i][w], false); d2 += xs[2 * w + 1] * __builtin_amdgcn_cvt_pk_f32_fp8((int)R[i][w], true); }
        p[i] = d2.x + d2.y; }
    float qd4[8];
    { const float kp = m4 ? p[8] : p[0], sd = m4 ? p[0] : p[8]; qd4[0] = kp + __shfl_xor(sd, 4); }
    { const float kp = m4 ? p[9] : p[1], sd = m4 ? p[1] : p[9]; qd4[1] = kp + __shfl_xor(sd, 4); }
    { const float kp = m4 ? p[10] : p[2], sd = m4 ? p[2] : p[10]; qd4[2] = kp + __shfl_xor(sd, 4); }
    { const float kp = m4 ? p[11] : p[3], sd = m4 ? p[3] : p[11]; qd4[3] = kp + __shfl_xor(sd, 4); }
    { const float kp = m4 ? p[12] : p[4], sd = m4 ? p[4] : p[12]; qd4[4] = kp + __shfl_xor(sd, 4); }
    { const float kp = m4 ? p[13] : p[5], sd = m4 ? p[5] : p[13]; qd4[5] = kp + __shfl_xor(sd, 4); }
    { const float kp = m4 ? p[14] : p[6], sd = m4 ? p[6] : p[14]; qd4[6] = kp + __shfl_xor(sd, 4); }
    { const float kp = m4 ? p[15] : p[7], sd = m4 ? p[7] : p[15]; qd4[7] = kp + __shfl_xor(sd, 4); }
    float qd2[4];
    { const float kp = m2 ? qd4[4] : qd4[0], sd = m2 ? qd4[0] : qd4[4]; qd2[0] = kp + __shfl_xor(sd, 2); }
    { const float kp = m2 ? qd4[5] : qd4[1], sd = m2 ? qd4[1] : qd4[5]; qd2[1] = kp + __shfl_xor(sd, 2); }
    { const float kp = m2 ? qd4[6] : qd4[2], sd = m2 ? qd4[2] : qd4[6]; qd2[2] = kp + __shfl_xor(sd, 2); }
    { const float kp = m2 ? qd4[7] : qd4[3], sd = m2 ? qd4[3] : qd4[7]; qd2[3] = kp + __shfl_xor(sd, 2); }
    float qd1[2];
    { const float kp = m1 ? qd2[2] : qd2[0], sd = m1 ? qd2[0] : qd2[2]; qd1[0] = kp + __shfl_xor(sd, 1); }
    { const float kp = m1 ? qd2[3] : qd2[1], sd = m1 ? qd2[1] : qd2[3]; qd1[1] = kp + __shfl_xor(sd, 1); }
    LAS f32x2* ap = (LAS f32x2*)(acc_row + 2 * lane);
    f32x2 o = (f32x2){qd1[0], qd1[1]};
    if (!first) o += *ap;
    *ap = o;
}
__device__ __forceinline__ float axpy_comp(const v4u (&R)[16], const AxpyPre& P, const Args& args, const LAS float* coef_row, int tok, int sl, int lane) {
    const int m = lane & 7, sg = lane >> 3;
    const bool s4 = lane & 32, s2 = lane & 16, s1 = lane & 8;
    f32x4 cf[4];
#pragma unroll
    for (int q = 0; q < 4; ++q) cf[q] = *(const LAS f32x4*)(coef_row + 16 * sg + 4 * q);
    f32x2 a2[8];
#pragma unroll
    for (int w = 0; w < 8; ++w) a2[w] = (f32x2){0.f, 0.f};
#pragma unroll
    for (int i = 0; i < 16; ++i) { const float c = cf[i >> 2][i & 3]; const f32x2 c2 = (f32x2){c, c};
#pragma unroll
        for (int w = 0; w < 4; ++w) { a2[2 * w] += c2 * __builtin_amdgcn_cvt_pk_f32_fp8((int)R[i][w], false); a2[2 * w + 1] += c2 * __builtin_amdgcn_cvt_pk_f32_fp8((int)R[i][w], true); } }
    float acc[16];
#pragma unroll
    for (int w = 0; w < 8; ++w) { acc[2 * w] = a2[w].x; acc[2 * w + 1] = a2[w].y; }
    float qv32[8];
    { const float kp = s4 ? acc[8] : acc[0], sd = s4 ? acc[0] : acc[8]; qv32[0] = kp + __shfl_xor(sd, 32); }
    { const float kp = s4 ? acc[9] : acc[1], sd = s4 ? acc[1] : acc[9]; qv32[1] = kp + __shfl_xor(sd, 32); }
    { const float kp = s4 ? acc[10] : acc[2], sd = s4 ? acc[2] : acc[10]; qv32[2] = kp + __shfl_xor(sd, 32); }
    { const float kp = s4 ? acc[11] : acc[3], sd = s4 ? acc[3] : acc[11]; qv32[3] = kp + __shfl_xor(sd, 32); }
    { const float kp = s4 ? acc[12] : acc[4], sd = s4 ? acc[4] : acc[12]; qv32[4] = kp + __shfl_xor(sd, 32); }
    { const float kp = s4 ? acc[13] : acc[5], sd = s4 ? acc[5] : acc[13]; qv32[5] = kp + __shfl_xor(sd, 32); }
    { const float kp = s4 ? acc[14] : acc[6], sd = s4 ? acc[6] : acc[14]; qv32[6] = kp + __shfl_xor(sd, 32); }
    { const float kp = s4 ? acc[15] : acc[7], sd = s4 ? acc[7] : acc[15]; qv32[7] = kp + __shfl_xor(sd, 32); }
    float qv16[4];
    { const float kp = s2 ? qv32[4] : qv32[0], sd = s2 ? qv32[0] : qv32[4]; qv16[0] = kp + __shfl_xor(sd, 16); }
    { const float kp = s2 ? qv32[5] : qv32[1], sd = s2 ? qv32[1] : qv32[5]; qv16[1] = kp + __shfl_xor(sd, 16); }
    { const float kp = s2 ? qv32[6] : qv32[2], sd = s2 ? qv32[2] : qv32[6]; qv16[2] = kp + __shfl_xor(sd, 16); }
    { const float kp = s2 ? qv32[7] : qv32[3], sd = s2 ? qv32[3] : qv32[7]; qv16[3] = kp + __shfl_xor(sd, 16); }
    float qv8[2];
    { const float kp = s1 ? qv16[2] : qv16[0], sd = s1 ? qv16[0] : qv16[2]; qv8[0] = kp + __shfl_xor(sd, 8); }
    { const float kp = s1 ? qv16[3] : qv16[1], sd = s1 ? qv16[1] : qv16[3]; qv8[1] = kp + __shfl_xor(sd, 8); }
    const f32x2 o = (f32x2){P.hv.x + qv8[0], P.hv.y + qv8[1]};
    *(unsigned*)(W_SLAB(SL_ZA) + (size_t)tok * DM + 128 * sl + 16 * m + 2 * sg) = pk2(o.x, o.y);
    return wave_sum(o.x * o.x + o.y * o.y);
}
constexpr int PEER_TPW = 8;
#define PEER_TOK(n) (tokbase + ((n) & (PEER_TPW - 1)))
#define PEER_SL(n) ((n) / PEER_TPW)
#define DOTS_STEP(RX, RY, PX, PY, n) do { if ((n) < NU) { \
        slice_rows(RY, PY.idv, U8 + 128 * PEER_SL(((n) + 1 < NU) ? (n) + 1 : 0) + 16 * m); __builtin_amdgcn_sched_barrier(0); \
        dots_comp(RX, PX, ACC + ((n) & (PEER_TPW - 1)) * NSEL, PEER_SL(n) == 0, lane); __builtin_amdgcn_sched_barrier(0); \
        { const int n3 = ((n) + 3 < NU) ? (n) + 3 : 0; dots_pre(PX, args, PEER_TOK(n3), PEER_SL(n3), lane); } __builtin_amdgcn_sched_barrier(0); } } while (0)
#define AXPY_STEP(RX, RY, PX, PY, n) do { if ((n) < NU) { \
        slice_rows(RY, PY.idv, V8 + 128 * PEER_SL(((n) + 1 < NU) ? (n) + 1 : 0) + 16 * m); __builtin_amdgcn_sched_barrier(0); \
        { const float q_ = axpy_comp(RX, PX, args, ACC + ((n) & (PEER_TPW - 1)) * NSEL, PEER_TOK(n), PEER_SL(n), lane); \
          if (lane == 0) { LAS float* sp_ = SSQl + ((n) & (PEER_TPW - 1)); *sp_ = (PEER_SL(n) == 0) ? q_ : *sp_ + q_; } } __builtin_amdgcn_sched_barrier(0); \
        { const int n3 = ((n) + 3 < NU) ? (n) + 3 : 0; axpy_pre(PX, args, PEER_TOK(n3), PEER_SL(n3), lane); } __builtin_amdgcn_sched_barrier(0); } } while (0)
__device__ __forceinline__ void peer_phase(Frame& F, const Args& args, unsigned long long* prof = nullptr, int prof_k = 0) {
    const int lane = lane_now(), m = lane & 7;
    LAS float* ACC = (LAS float*)(F.lds + F.wave * 8192);
    LAS float* SSQl = (LAS float*)(F.lds + F.wave * 8192 + 4096);
    const unsigned char* U8 = (const unsigned char*)W_SLAB(SL_UB); const unsigned char* V8 = (const unsigned char*)W_SLAB(SL_VB);
    const int tpw = M / (F.G * NWAVES);
    const int tokbase = (F.vcu * NWAVES + F.wave) * tpw;
    constexpr int NU = NSLICE * PEER_TPW;
    v4u RA[16], RB[16];
    { DotsPre PA, PB, PC;
      dots_pre(PA, args, PEER_TOK(0), PEER_SL(0), lane); dots_pre(PB, args, PEER_TOK(1), PEER_SL(1), lane); dots_pre(PC, args, PEER_TOK(2), PEER_SL(2), lane);
      slice_rows(RA, PA.idv, U8 + 128 * PEER_SL(0) + 16 * m);
      for (int nb = 0; nb < NU; nb += 6) {
          DOTS_STEP(RA, RB, PA, PB, nb); DOTS_STEP(RB, RA, PB, PC, nb + 1); DOTS_STEP(RA, RB, PC, PA, nb + 2);
          DOTS_STEP(RB, RA, PA, PB, nb + 3); DOTS_STEP(RA, RB, PB, PC, nb + 4); DOTS_STEP(RB, RA, PC, PA, nb + 5); } }
    { const unsigned short* SELI = (const unsigned short*)W_SLAB(SL_SEL); const float* SELG = (const float*)(W_SLAB(SL_SEL)) + (size_t)M * NSEL;
#pragma unroll 2
      for (int i = 0; i < PEER_TPW; ++i) { const int tok = tokbase + i;
          const unsigned idw = *(const unsigned*)(SELI + (size_t)tok * NSEL + 2 * lane); const int e0 = (int)(idw & 0xffffu), e1 = (int)(idw >> 16);
          const f32x2 gt = *(const f32x2*)(SELG + (size_t)tok * NSEL + 2 * lane);
          LAS f32x2* ap = (LAS f32x2*)(ACC + i * NSEL + 2 * lane); const f32x2 d = *ap;
          const pg8::f32x2 ge = pg8::gelu_pk((pg8::f32x2){d.x * W_PSC[e0], d.y * W_PSC[e1]});
          *ap = (f32x2){ge.x * gt.x * W_PSC[NEXP + e0], ge.y * gt.y * W_PSC[NEXP + e1]}; } }
    if (prof && F.wave == 0 && lane == 0) { const unsigned long long t_ = __builtin_amdgcn_s_memrealtime(); __hip_atomic_fetch_max(prof + prof_k, t_, __ATOMIC_RELAXED, __HIP_MEMORY_SCOPE_AGENT); __hip_atomic_fetch_max(prof + 32 + prof_k, ~t_, __ATOMIC_RELAXED, __HIP_MEMORY_SCOPE_AGENT); }
    { AxpyPre PA, PB, PC;
      axpy_pre(PA, args, PEER_TOK(0), PEER_SL(0), lane); axpy_pre(PB, args, PEER_TOK(1), PEER_SL(1), lane); axpy_pre(PC, args, PEER_TOK(2), PEER_SL(2), lane);
      slice_rows(RA, PA.idv, V8 + 128 * PEER_SL(0) + 16 * m);
      for (int nb = 0; nb < NU; nb += 6) {
          AXPY_STEP(RA, RB, PA, PB, nb); AXPY_STEP(RB, RA, PB, PC, nb + 1); AXPY_STEP(RA, RB, PC, PA, nb + 2);
          AXPY_STEP(RB, RA, PA, PB, nb + 3); AXPY_STEP(RA, RB, PB, PC, nb + 4); AXPY_STEP(RB, RA, PC, PA, nb + 5); } }
    asm volatile("s_waitcnt vmcnt(0) lgkmcnt(0)" ::: "memory");
    for (int i = 0; i < PEER_TPW; ++i) { const int tok = tokbase + i;
        const float r3 = __builtin_amdgcn_rsqf(SSQl[i] * (1.0f / DM) + EPS);
        const v4u* ur = (const v4u*)(W_SLAB(SL_ZA) + (size_t)tok * DM) + lane;
        f32x4* xr = (f32x4*)(A_out + (size_t)tok * DM); const f32x4* gr = (const f32x4*)A_final_g;
        v4u v[4];
#pragma unroll
        for (int j = 0; j < 4; ++j) v[j] = __builtin_nontemporal_load(ur + 64 * j);
#pragma unroll
        for (int j = 0; j < 4; ++j) { const int e4 = 2 * lane + 128 * j;
            xr[e4] = (f32x4){bflo(v[j].x), bfhi(v[j].x), bflo(v[j].y), bfhi(v[j].y)} * r3 * gr[e4];
            xr[e4 + 1] = (f32x4){bflo(v[j].z), bfhi(v[j].z), bflo(v[j].w), bfhi(v[j].w)} * r3 * gr[e4 + 1]; } }
}

__global__ void __launch_bounds__(NWAVES * 64, 2) fwd_kernel(Args args) {
    extern __shared__ __attribute__((aligned(16))) unsigned char lds[];
    Frame F;
    F.lds = (LAS unsigned char*)lds;
    F.MISC = (volatile LAS unsigned*)(F.lds + MISC_OFF);
    F.wave = __builtin_amdgcn_readfirstlane((int)threadIdx.x >> 6);
    F.G = gridDim.x; { const int bx = blockIdx.x; F.vcu = (F.G % 8 == 0) ? (bx % 8) * (F.G / 8) + bx / 8 : bx; }
    for (int u = F.wave * 64 + lane_now(); u < (LDS_BYTES - LDSCTL_OFF) / 4; u += NWAVES * 64) ((LAS unsigned*)(F.lds + LDSCTL_OFF))[u] = 0u;
    __syncthreads();
    XcdBarrier bar = xcd_barrier_post((unsigned*)(args.ws + WS_CTL) + CW_BAR, F.MISC + 8);
#define ST_ ((bf16*)args.out)
#if PROF_SEL
    unsigned long long* PROFW = (unsigned long long*)(args.ws + WS_CTL + 256 * 1024);
    int prof_k = 0;
#define PROF_ARRIVE() do { if (F.wave == 0 && lane_now() == 0) { const unsigned long long t_ = __builtin_amdgcn_s_memrealtime(); \
        __hip_atomic_fetch_max(PROFW + prof_k, t_, __ATOMIC_RELAXED, __HIP_MEMORY_SCOPE_AGENT); __hip_atomic_fetch_max(PROFW + 32 + prof_k, ~t_, __ATOMIC_RELAXED, __HIP_MEMORY_SCOPE_AGENT); } } while (0)
#define GRID_BAR() do { PROF_ARRIVE(); xcd_barrier(bar); if (blockIdx.x == 0 && F.wave == 0 && lane_now() == 0) PROFW[64 + prof_k] = __builtin_amdgcn_s_memrealtime(); ++prof_k; } while (0)
#else
#define GRID_BAR() xcd_barrier(bar)
#endif

#define PH_P0() do { p0_prologue(F, args); GRID_BAR(); } while (0)
#define PH_G1() do { { pg8::Gemm gm{W_XN, W_WinT, M, INW, DM, nullptr, nullptr}; pg8::StaticOrder S; S.init(M, INW, F.G, (int)blockIdx.x); \
      pg8::EpiSplit E{W_SLAB(0), DM, DM, (size_t)M * DM}; \
      pg8::gemm_phase<pg8::EpiSplit, pg8::StaticOrder, true, true>(F.lds, gm, S, E, F.wave); } \
    p1_meta(F, args); GRID_BAR(); } while (0)
#define PH_P2A() do { rg_phase<0>(F, args); hg_phase<0>(F, args, ST_); GRID_BAR(); } while (0)
#define PH_G345(QPSLAB) do { \
    p3_convert_uv(F, args); __syncthreads(); \
    { pg8::Gemm gm{W_SLAB(SL_YA), W_WpaT, M, DM, DM, W_SLAB(SL_OG), W_WpbT}; pg8::PairOrder S; S.init(M, DM, F.G, (int)blockIdx.x); \
      pg8::EpiPairGate E{W_SLAB(SL_ZA), W_SLAB(SL_ZB), W_SLAB(SL_MIX), DM}; \
      pg8::gemm_phase<pg8::EpiPairGate, pg8::PairOrder, true, true>(F.lds, gm, S, E, F.wave); } \
    GRID_BAR(); \
    { pg8::Gemm gm{W_SLAB(SL_MIX), W_WoutT, M, DM, DM, nullptr, nullptr}; pg8::StaticOrder S; S.init(M, DM, F.G, (int)blockIdx.x); \
      pg8::EpiResid E{A_x, A_out, W_SLAB(SL_H2B), W_RSP, DM}; \
      pg8::gemm_phase<pg8::EpiResid, pg8::StaticOrder, true, true>(F.lds, gm, S, E, F.wave); } \
    GRID_BAR(); \
    { pg8::Gemm gm{W_SLAB(SL_H2B), W_WqT, M, DM, DM, nullptr, nullptr}; pg8::StaticOrder S; S.init(M, DM, F.G, (int)blockIdx.x); \
      pg8::EpiRowScale E{W_SLAB(QPSLAB), DM, W_RSP, 1.0f / DM, EPS, W_RSTD2}; \
      pg8::gemm_phase<pg8::EpiRowScale, pg8::StaticOrder, true, true>(F.lds, gm, S, E, F.wave); } \
    GRID_BAR(); } while (0)
#define PH_SEL() do { sel_phase(F, args); GRID_BAR(); } while (0)

#if defined(TEST_ONLY)
#if TEST_ONLY == 1
    rg_phase<0>(F, args);
#elif TEST_ONLY == 2
    rg_phase<1>(F, args);
#elif TEST_ONLY == 3
    hg_phase<0>(F, args, ST_);
#elif TEST_ONLY == 4
    hg_phase<1>(F, args, ST_);
#elif TEST_ONLY == 5
    sel_phase(F, args);
#elif TEST_ONLY == 6
    peer_phase(F, args);
#elif TEST_ONLY == 7
    p0_prologue(F, args);
#endif
    return;
#endif
#if PROF_SEL
    if (blockIdx.x == 0 && F.wave == 0 && lane_now() == 0) PROFW[95] = __builtin_amdgcn_s_memrealtime();
#endif
    PH_P0();
#if REPMASK & 1
    PH_P0();
#endif
    PH_G1();
#if REPMASK & 2
    PH_G1();
#endif
#if REPMASK & 64
    rg_phase<0, false, RGVAR>(F, args); GRID_BAR();
#endif
    PH_P2A();
#if REPMASK & 4
    PH_P2A();
#endif
#if REPMASK & 128
    hg_phase<0>(F, args, ST_); GRID_BAR();
#endif
    rg_carry(F, args);
    hg_carry(F, args, ST_);
    GRID_BAR();
#if REPMASK & 256
    rg_phase<1, true>(F, args); GRID_BAR();
#endif
#if REPMASK & 512
    hg_phase<1, true>(F, args, ST_); GRID_BAR();
#endif
    rg_phase<1>(F, args);
    hg_phase<1>(F, args, ST_);
    GRID_BAR();
#if REPMASK & 8
    PH_G345(SL_MIX);
#endif
    PH_G345(SL_QP);
    PH_SEL();
#if REPMASK & 16
    PH_SEL();
#endif
#if PROF_SEL
    peer_phase(F, args, PROFW, prof_k); if (blockIdx.x == 0 && F.wave == 0 && lane_now() == 0) PROFW[64 + prof_k] = PROFW[64 + prof_k - 1]; ++prof_k;
#else
    peer_phase(F, args);
#endif
#if PROF_SEL
    PROF_ARRIVE();
    asm volatile("s_waitcnt vmcnt(0)" ::: "memory");
    if (blockIdx.x == 0) {
        if (F.wave == 0 && lane_now() == 0) {
            const unsigned long long t0 = __builtin_amdgcn_s_memrealtime();
            while (__builtin_amdgcn_s_memrealtime() - t0 < 30000ull) __builtin_amdgcn_s_sleep(8);
            const int k = PROF_SEL % 100;
            const unsigned long long last = __hip_atomic_load(PROFW + k, __ATOMIC_RELAXED, __HIP_MEMORY_SCOPE_AGENT), first = ~__hip_atomic_load(PROFW + 32 + k, __ATOMIC_RELAXED, __HIP_MEMORY_SCOPE_AGENT);
            const unsigned long long rel = (k == 0) ? PROFW[95] : PROFW[64 + k - 1];
            unsigned long long q = (PROF_SEL >= 200) ? (last - first) : (last - rel);
            if (PROF_SEL == 300) q = 0ull; if (PROF_SEL == 301) q = 10000ull;
            if (q > 200000ull) q = 200000ull;
            const unsigned long long t1 = __builtin_amdgcn_s_memrealtime();
            while (__builtin_amdgcn_s_memrealtime() - t1 < q * PROF_AMP) __builtin_amdgcn_s_sleep(8);
        }
    }
#endif
}

extern "C" void kernel_launch(void* const* d_in, const int* in_sizes, int n_in, void* d_out, int out_size, void* d_ws, size_t ws_size, hipStream_t stream) {
    static int grid = 0;
    if (grid == 0) {
        if (n_in != 22 || in_sizes[0] != M * DM || out_size != M * DM || ws_size < WS_END) { fprintf(stderr, "kernel_launch: unexpected shapes (n_in %d in0 %d out %d ws %zu)\n", n_in, n_in > 0 ? in_sizes[0] : -1, out_size, ws_size); grid = -1; return; }
        int dev = 0, cus = 0, per_cu = 0;
        if (hipGetDevice(&dev) != hipSuccess || hipDeviceGetAttribute(&cus, hipDeviceAttributeMultiprocessorCount, dev) != hipSuccess) { grid = -1; return; }
        if (hipFuncSetAttribute((const void*)fwd_kernel, hipFuncAttributeMaxDynamicSharedMemorySize, LDS_BYTES) != hipSuccess) { fprintf(stderr, "kernel_launch: hipFuncSetAttribute failed\n"); grid = -1; return; }
        if (hipOccupancyMaxActiveBlocksPerMultiprocessor(&per_cu, (const void*)fwd_kernel, NWAVES * 64, LDS_BYTES) != hipSuccess || per_cu < 1) { fprintf(stderr, "kernel_launch: occupancy query says %d\n", per_cu); per_cu = 1; }
        (void)hipGetLastError();
        grid = cus;
        if (grid % 8 != 0 || grid > 256) grid = (grid > 256) ? 256 : (grid / 8) * 8;
        if (M / (grid * NWAVES) != PEER_TPW || M % (grid * NWAVES) != 0) { fprintf(stderr, "kernel_launch: built for a 256-CU device (got %d)\n", grid); grid = -1; return; }
    }
    if (grid <= 0) return;
    (void)hipMemsetAsync((char*)d_ws + WS_CTL, 0, CTL_ZERO_BYTES, stream);
    Args a{};
    for (int i = 0; i < 22; ++i) a.in[i] = (const float*)d_in[i];
    a.out = (float*)d_out; a.ws = (unsigned char*)d_ws;
    hipLaunchKernelGGL(fwd_kernel, dim3(grid), dim3(NWAVES * 64), LDS_BYTES, stream, a);
}
```

```cpp
#include <hip/hip_runtime.h>
#include <cstdio>
#include <cstdint>
#define RGVAR 0
#define PROF_SEL 0
#define PROF_AMP 8
#ifndef REPMASK
#define REPMASK 0
#endif
namespace pg8 {
#define PG8_LAS __attribute__((address_space(3)))
typedef unsigned short bf16_t;
typedef short bf16x8 __attribute__((ext_vector_type(8)));
typedef float f32x4 __attribute__((ext_vector_type(4)));
typedef unsigned u32x4 __attribute__((ext_vector_type(4)));
constexpr int BM = 256, BK = 64, HALF = 128, HTB = HALF * BK * 2  , STAGE_BYTES = 8 * HTB, NXCD = 8, WGM = 8;

__host__ __device__ __forceinline__ int lds_byte(int r, int c) { const int st = (r >> 4) * 2 + (c >> 5), rr = r & 15, cc = c & 31, ob = rr * 64 + cc * 2; return st * 1024 + (ob ^ (((ob >> 9) & 1) << 5)); }
__host__ __device__ __forceinline__ void stage_rc(int b, int& R, int& C) { const int st = b / 1024, sb = b % 1024, swz = sb ^ (((sb >> 9) & 1) << 5); R = (st >> 1) * 16 + swz / 64; C = (st & 1) * 32 + (swz % 64) / 2; }
__host__ __device__ __forceinline__ int perm32(int rho) { const int n = rho >> 4, i = rho & 15; return 8 * (i >> 2) + 4 * n + (i & 3); }

__device__ __forceinline__ int lane_now_pg8() { int l; asm volatile("v_mbcnt_lo_u32_b32 %0, -1, 0\n\tv_mbcnt_hi_u32_b32 %0, -1, %0" : "=v"(l)); return l; }
struct Unit { int pm, pn, seg; };
struct Gemm { const bf16_t* A; const bf16_t* Bt; int M, N, K; const bf16_t* A2; const bf16_t* Bt2; };

struct StaticOrder {
    int nM, nN, nwg, G, c;
    __host__ __device__ void init(int M, int N, int G_, int c_) { nM = M / BM; nN = N / BM; nwg = nM * nN; G = G_; c = c_; }
    __host__ __device__ bool next(int i, Unit& u) const {
        const long L = (long)i * G + c; if (L >= nwg) return false;
        int wgid = (int)L; { const int q = nwg / NXCD, r = nwg % NXCD, xcd = wgid % NXCD, off = wgid / NXCD; wgid = (xcd < r ? xcd * (q + 1) : r * (q + 1) + (xcd - r) * q) + off; }
        const int nig = WGM * nN, gid = wgid / nig, fm = gid * WGM, gsz = (nM - fm) < WGM ? (nM - fm) : WGM;
        u.pm = fm + ((wgid % nig) % gsz); u.pn = (wgid % nig) / gsz; u.seg = 0; return true;
    }
    __device__ __forceinline__ void a_ready(const Unit&) const {}
    __device__ __forceinline__ void done(const Unit&) const {}
};
struct PairOrder : StaticOrder {
    __host__ __device__ bool next(int i, Unit& u) const { if (!StaticOrder::next(i >> 1, u)) return false; u.seg = i & 1; return true; }
};

__device__ __forceinline__ unsigned cvt_pk_bf16(float lo, float hi) { unsigned r; asm volatile("v_cvt_pk_bf16_f32 %0, %1, %2" : "=v"(r) : "v"(lo), "v"(hi)); return r; }
typedef float f32x2 __attribute__((ext_vector_type(2)));
__device__ __forceinline__ f32x2 gelu_pk(f32x2 v) {
    const f32x2 av = __builtin_elementwise_abs(v), d = av * 0.2316418882f + 1.0f;
    f32x2 t; t.x = __builtin_amdgcn_rcpf(d.x); t.y = __builtin_amdgcn_rcpf(d.y);
    f32x2 q = t * 0.5307027145f + (-0.7265760135f); q = q * t + 0.7107068705f; q = q * t + (-0.142248368f); q = q * t + 0.127414796f; q = q * t;
    const f32x2 s = (v * v) * (-0.72134752044f);
    f32x2 e; e.x = __builtin_amdgcn_exp2f(s.x); e.y = __builtin_amdgcn_exp2f(s.y);
    const f32x2 m = v * (q * e), r = v - m;
    f32x2 o; o.x = v.x < 0.f ? m.x : r.x; o.y = v.y < 0.f ? m.y : r.y; return o;
}

__device__ __forceinline__ float bf_lo(unsigned w) { return __uint_as_float(w << 16); }
__device__ __forceinline__ float bf_hi(unsigned w) { return __uint_as_float(w & 0xffff0000u); }
__device__ __forceinline__ float sigmoidf_(float x) { return __builtin_amdgcn_rcpf(1.0f + __expf(-x)); }
typedef unsigned u32x2 __attribute__((ext_vector_type(2)));

struct EpiSplit {
    static constexpr bool PERM = true, AFTER_DRAIN = false, PAIRED = false;
    bf16_t* O; int ldc; int split_cols; size_t split_stride;
    __device__ __forceinline__ void operator()(const f32x4 (&acc)[2][2][4][2], const Unit& u, int wr, int wc, int fr, int fq) const {
        const int row0 = u.pm * BM + wr * 64 + fr; int colt = u.pn * BM; bf16_t* base = O;
        if (split_cols) { const int t = colt / split_cols; base += (size_t)t * split_stride; colt -= t * split_cols; }
        const int col0 = colt + wc * 32 + 8 * fq;
#pragma unroll
        for (int ai = 0; ai < 2; ++ai)
#pragma unroll
            for (int m = 0; m < 4; ++m) { bf16_t* rowp = base + (size_t)(row0 + ai * HALF + m * 16) * ldc + col0;
#pragma unroll
                for (int bj = 0; bj < 2; ++bj) { const f32x4 v0 = acc[ai][bj][m][0], v1 = acc[ai][bj][m][1];
                    u32x4 w; w.x = cvt_pk_bf16(v0[0], v0[1]); w.y = cvt_pk_bf16(v0[2], v0[3]); w.z = cvt_pk_bf16(v1[0], v1[1]); w.w = cvt_pk_bf16(v1[2], v1[3]);
                    *(u32x4*)(rowp + bj * HALF) = w; } }
    }
};
struct EpiRowScale {
    static constexpr bool PERM = true, AFTER_DRAIN = false, PAIRED = false;
    bf16_t* O; int ldc; const float* rsp; float inv_n, eps; float* rstd_out;
    __device__ __forceinline__ void operator()(const f32x4 (&acc)[2][2][4][2], const Unit& u, int wr, int wc, int fr, int fq) const {
        const int row0 = u.pm * BM + wr * 64 + fr; const int col0 = u.pn * BM + wc * 32 + 8 * fq;
#pragma unroll
        for (int ai = 0; ai < 2; ++ai) {
            f32x4 t[4][2];
#pragma unroll
            for (int m = 0; m < 4; ++m) { const f32x4* rp = (const f32x4*)(rsp + (size_t)(row0 + ai * HALF + m * 16) * 32) + 2 * fq; t[m][0] = rp[0]; t[m][1] = rp[1]; }
            __builtin_amdgcn_sched_barrier(0);
#pragma unroll
            for (int m = 0; m < 4; ++m) { const int row = row0 + ai * HALF + m * 16; bf16_t* rowp = O + (size_t)row * ldc + col0;
                float ss = ((t[m][0][0] + t[m][0][1]) + (t[m][0][2] + t[m][0][3])) + ((t[m][1][0] + t[m][1][1]) + (t[m][1][2] + t[m][1][3]));
                ss += __shfl_xor(ss, 16); ss += __shfl_xor(ss, 32);
                const float sc = __builtin_amdgcn_rsqf(ss * inv_n + eps);
                if (u.pn == 0 && wc == 0 && fq == 0) rstd_out[row] = sc;
#pragma unroll
                for (int bj = 0; bj < 2; ++bj) { const f32x4 v0 = acc[ai][bj][m][0] * sc, v1 = acc[ai][bj][m][1] * sc;
                    u32x4 w; w.x = cvt_pk_bf16(v0[0], v0[1]); w.y = cvt_pk_bf16(v0[2], v0[3]); w.z = cvt_pk_bf16(v1[0], v1[1]); w.w = cvt_pk_bf16(v1[2], v1[3]);
                    *(u32x4*)(rowp + bj * HALF) = w; } }
        }
    }
};
struct EpiGateF32 {
    static constexpr bool PERM = false, AFTER_DRAIN = false, PAIRED = false;
    bf16_t* C; const bf16_t* Z; int ldc;
    __device__ __forceinline__ void operator()(const f32x4 (&acc)[2][2][4][2], const Unit& u, int wr, int wc, int fr, int fq) const {
        const int row0 = u.pm * BM + wr * 64 + fr, col0 = u.pn * BM + wc * 32 + 4 * fq;
#pragma unroll
        for (int ai = 0; ai < 2; ++ai)
#pragma unroll
            for (int m = 0; m < 4; ++m) { const size_t off = (size_t)(row0 + ai * HALF + m * 16) * ldc + col0;
#pragma unroll
                for (int bj = 0; bj < 2; ++bj)
#pragma unroll
                    for (int n = 0; n < 2; ++n) { const u32x2 z = *(const u32x2*)(Z + off + bj * HALF + n * 16);
                        const f32x4 g = (f32x4){sigmoidf_(bf_lo(z.x)), sigmoidf_(bf_hi(z.x)), sigmoidf_(bf_lo(z.y)), sigmoidf_(bf_hi(z.y))};
                        const f32x4 t = acc[ai][bj][m][n] * g; u32x2 w; w.x = cvt_pk_bf16(t[0], t[1]); w.y = cvt_pk_bf16(t[2], t[3]); *(u32x2*)(C + off + bj * HALF + n * 16) = w; } }
    }
};
struct EpiMerge {
    static constexpr bool PERM = false, AFTER_DRAIN = false, PAIRED = false;
    const bf16_t* T1; const bf16_t* Z; bf16_t* O; int ldc;
    __device__ __forceinline__ void operator()(const f32x4 (&acc)[2][2][4][2], const Unit& u, int wr, int wc, int fr, int fq) const {
        const int row0 = u.pm * BM + wr * 64 + fr, col0 = u.pn * BM + wc * 32 + 4 * fq;
#pragma unroll
        for (int ai = 0; ai < 2; ++ai)
#pragma unroll
            for (int m = 0; m < 4; ++m) { const size_t off = (size_t)(row0 + ai * HALF + m * 16) * ldc + col0;
#pragma unroll
                for (int bj = 0; bj < 2; ++bj)
#pragma unroll
                    for (int n = 0; n < 2; ++n) { const u32x2 z = *(const u32x2*)(Z + off + bj * HALF + n * 16); const u32x2 tw = *(const u32x2*)(T1 + off + bj * HALF + n * 16); const f32x4 t1 = (f32x4){bf_lo(tw.x), bf_hi(tw.x), bf_lo(tw.y), bf_hi(tw.y)};
                        const f32x4 g = (f32x4){sigmoidf_(bf_lo(z.x)), sigmoidf_(bf_hi(z.x)), sigmoidf_(bf_lo(z.y)), sigmoidf_(bf_hi(z.y))};
                        const f32x4 o = t1 + acc[ai][bj][m][n] * g; u32x2 w; w.x = cvt_pk_bf16(o[0], o[1]); w.y = cvt_pk_bf16(o[2], o[3]);
                        *(u32x2*)(O + off + bj * HALF + n * 16) = w; } }
    }
};
struct EpiPairGate {
    static constexpr bool PERM = false, AFTER_DRAIN = false, PAIRED = true;
    const bf16_t* ZA; const bf16_t* ZB; bf16_t* O; int ldc;
    __device__ __forceinline__ void mid(f32x4 (&acc)[2][2][4][2], const Unit& u, int wr, int wc, int fr, int fq) const {
        const int row0 = u.pm * BM + wr * 64 + fr, col0 = u.pn * BM + wc * 32 + 4 * fq;
#pragma unroll
        for (int ai = 0; ai < 2; ++ai)
#pragma unroll
            for (int mp = 0; mp < 2; ++mp) {
                u32x2 za[2][2][2], zb[2][2][2];
#pragma unroll
                for (int mm = 0; mm < 2; ++mm) { const size_t off = (size_t)(row0 + ai * HALF + (2 * mp + mm) * 16) * ldc + col0;
#pragma unroll
                    for (int bj = 0; bj < 2; ++bj)
#pragma unroll
                        for (int n = 0; n < 2; ++n) { za[mm][bj][n] = *(const u32x2*)(ZA + off + bj * HALF + n * 16); zb[mm][bj][n] = *(const u32x2*)(ZB + off + bj * HALF + n * 16); } }
                __builtin_amdgcn_sched_barrier(0);
#pragma unroll
                for (int mm = 0; mm < 2; ++mm)
#pragma unroll
                    for (int bj = 0; bj < 2; ++bj)
#pragma unroll
                        for (int n = 0; n < 2; ++n) { const u32x2 a = za[mm][bj][n], b = zb[mm][bj][n];
                            const f32x4 ra = (f32x4){sigmoidf_(bf_lo(a.x)), sigmoidf_(bf_hi(a.x)), sigmoidf_(bf_lo(a.y)), sigmoidf_(bf_hi(a.y))};
                            const f32x4 ib = (f32x4){1.0f + __expf(-fmaxf(bf_lo(b.x), -30.f)), 1.0f + __expf(-fmaxf(bf_hi(b.x), -30.f)), 1.0f + __expf(-fmaxf(bf_lo(b.y), -30.f)), 1.0f + __expf(-fmaxf(bf_hi(b.y), -30.f))};
                            acc[ai][bj][2 * mp + mm][n] = acc[ai][bj][2 * mp + mm][n] * ra * ib; }
            }
    }
    __device__ __forceinline__ void operator()(const f32x4 (&acc)[2][2][4][2], const Unit& u, int wr, int wc, int fr, int fq) const {
        const int row0 = u.pm * BM + wr * 64 + fr, col0 = u.pn * BM + wc * 32 + 4 * fq;
#pragma unroll
        for (int ai = 0; ai < 2; ++ai) {
            u32x2 zb[4][2][2];
#pragma unroll
            for (int m = 0; m < 4; ++m) { const size_t off = (size_t)(row0 + ai * HALF + m * 16) * ldc + col0;
#pragma unroll
                for (int bj = 0; bj < 2; ++bj)
#pragma unroll
                    for (int n = 0; n < 2; ++n) zb[m][bj][n] = *(const u32x2*)(ZB + off + bj * HALF + n * 16); }
            __builtin_amdgcn_sched_barrier(0);
#pragma unroll
            for (int m = 0; m < 4; ++m) { const size_t off = (size_t)(row0 + ai * HALF + m * 16) * ldc + col0;
#pragma unroll
                for (int bj = 0; bj < 2; ++bj)
#pragma unroll
                    for (int n = 0; n < 2; ++n) { const u32x2 b = zb[m][bj][n];
                        const f32x4 g = (f32x4){sigmoidf_(fmaxf(bf_lo(b.x), -30.f)), sigmoidf_(fmaxf(bf_hi(b.x), -30.f)), sigmoidf_(fmaxf(bf_lo(b.y), -30.f)), sigmoidf_(fmaxf(bf_hi(b.y), -30.f))};
                        const f32x4 o = acc[ai][bj][m][n] * g; u32x2 w; w.x = cvt_pk_bf16(o[0], o[1]); w.y = cvt_pk_bf16(o[2], o[3]);
                        *(u32x2*)(O + off + bj * HALF + n * 16) = w; } }
        }
    }
};
struct EpiResid {
    static constexpr bool PERM = false, AFTER_DRAIN = false, PAIRED = false;
    const float* X; float* H2; bf16_t* H2B; float* rsp; int ldc;
    __device__ __forceinline__ void operator()(const f32x4 (&acc)[2][2][4][2], const Unit& u, int wr, int wc, int fr, int fq) const {
        const int row0 = u.pm * BM + wr * 64 + fr, col0 = u.pn * BM + wc * 32 + 4 * fq;
#pragma unroll
        for (int ai = 0; ai < 2; ++ai)
#pragma unroll
            for (int mp = 0; mp < 2; ++mp) {
                f32x4 xv[2][2][2];
#pragma unroll
                for (int mm = 0; mm < 2; ++mm) { const size_t off = (size_t)(row0 + ai * HALF + (2 * mp + mm) * 16) * ldc + col0;
#pragma unroll
                    for (int bj = 0; bj < 2; ++bj)
#pragma unroll
                        for (int n = 0; n < 2; ++n) xv[mm][bj][n] = *(const f32x4*)(X + off + bj * HALF + n * 16); }
                __builtin_amdgcn_sched_barrier(0);
#pragma unroll
                for (int mm = 0; mm < 2; ++mm) { const int m = 2 * mp + mm; const int row = row0 + ai * HALF + m * 16; const size_t off = (size_t)row * ldc + col0; float ss = 0.f;
#pragma unroll
                    for (int bj = 0; bj < 2; ++bj)
#pragma unroll
                        for (int n = 0; n < 2; ++n) { const f32x4 o = xv[mm][bj][n] + acc[ai][bj][m][n];
                            ss += (o[0] * o[0] + o[1] * o[1]) + (o[2] * o[2] + o[3] * o[3]);
                            u32x2 w; w.x = cvt_pk_bf16(o[0], o[1]); w.y = cvt_pk_bf16(o[2], o[3]); *(u32x2*)(H2B + off + bj * HALF + n * 16) = w; }
                    ss += __shfl_xor(ss, 16); ss += __shfl_xor(ss, 32);
                    if (fq == 0) rsp[(size_t)row * 32 + 4 * u.pn + wc] = ss; }
            }
    }
};

template <class Epi, class Sched, bool ALIGN_EPI = false, bool SP2 = false>
__device__ __forceinline__ void gemm_phase(PG8_LAS unsigned char* lds, const Gemm g, const Sched& S, const Epi& E, const int wid) {
    const int lane = lane_now_pg8(), tid = wid * 64 + lane, wr = wid >> 2, wc = wid & 3, fr = lane & 15, fq = lane >> 4;
    const int K = g.K, nt = K / BK;
    unsigned voffA[2], voffB[2];
#pragma unroll
    for (int i = 0; i < 2; ++i) { int R, C; stage_rc(tid * 16 + i * 8192, R, C); const int Rb = Epi::PERM ? ((R & ~31) + perm32(R & 31)) : R;
        voffA[i] = (unsigned)(R * K + C) * 2u; voffB[i] = (unsigned)(Rb * K + C) * 2u; }
    const size_t kstep = (size_t)(BK * 2);
    const size_t hstep = (size_t)HALF * K * 2;
    const size_t tstep = 2 * hstep;
    const unsigned ldsw = (unsigned)wid * 1024u;
    const int aoff = lds_byte(wr * 64 + fr, fq * 8), boff = lds_byte(wc * 32 + fr, fq * 8);
#define PG8_SA(b, h) (((b) * 2 + (h)) * HTB)
#define PG8_SB(b, h) ((4 + (b) * 2 + (h)) * HTB)
#define PG8_STAGE(bufoff, gbase, voff) do { _Pragma("unroll") for (int _i = 0; _i < 2; ++_i) \
        __builtin_amdgcn_global_load_lds((const unsigned*)((const char*)(gbase) + (voff)[_i]), (PG8_LAS unsigned*)(lds + (bufoff) + ldsw + _i * 8192), 16, 0, 0); } while (0)
#define PG8_LDA(dst, b, h) do { _Pragma("unroll") for (int m = 0; m < 4; ++m) _Pragma("unroll") for (int k = 0; k < 2; ++k) dst[m][k] = *(const PG8_LAS bf16x8*)(lds + PG8_SA(b, h) + aoff + m * 2048 + k * 1024); } while (0)
#define PG8_LDB(dst, b, h) do { _Pragma("unroll") for (int n = 0; n < 2; ++n) _Pragma("unroll") for (int k = 0; k < 2; ++k) dst[n][k] = *(const PG8_LAS bf16x8*)(lds + PG8_SB(b, h) + boff + n * 2048 + k * 1024); } while (0)
#define PG8_MMA(ai, bj, At, Bt) do { __builtin_amdgcn_s_setprio(1); _Pragma("unroll") for (int m = 0; m < 4; ++m) _Pragma("unroll") for (int n = 0; n < 2; ++n) _Pragma("unroll") for (int k = 0; k < 2; ++k) \
        acc[ai][bj][m][n] = __builtin_amdgcn_mfma_f32_16x16x32_bf16(Bt[n][k], At[m][k], acc[ai][bj][m][n], 0, 0, 0); __builtin_amdgcn_s_setprio(0); } while (0)
#define PG8_WAIT_V(n) asm volatile("s_waitcnt vmcnt(" #n ")" ::: "memory")
#define PG8_WAIT_L(n) asm volatile("s_waitcnt lgkmcnt(" #n ")" ::: "memory")
#define PG8_BAR __builtin_amdgcn_s_barrier()
#define PG8_SCHED __builtin_amdgcn_sched_barrier(0)
    Unit cur, nxt; int ui = 0;
    if (!S.next(0, cur)) return;
    f32x4 acc[2][2][4][2];
#pragma unroll
    for (int a = 0; a < 2; ++a)
#pragma unroll
        for (int b = 0; b < 2; ++b)
#pragma unroll
            for (int m = 0; m < 4; ++m)
#pragma unroll
                for (int n = 0; n < 2; ++n) acc[a][b][m][n] = (f32x4){0.f, 0.f, 0.f, 0.f};
    bf16x8 At[4][2], B0[2][2], B1[2][2];
    const char* cA = (const char*)(cur.seg ? g.A2 : g.A) + (size_t)cur.pm * tstep; const char* cB = (const char*)(cur.seg ? g.Bt2 : g.Bt) + (size_t)cur.pn * tstep;
    S.a_ready(cur);
    if constexpr (SP2) {
        PG8_STAGE(PG8_SB(0, 0), cB, voffB); PG8_STAGE(PG8_SB(0, 1), cB + hstep, voffB); PG8_STAGE(PG8_SA(0, 0), cA, voffA); PG8_STAGE(PG8_SA(0, 1), cA + hstep, voffA);
        if (wr == 1) PG8_BAR;
        PG8_WAIT_V(2); PG8_BAR;
        PG8_STAGE(PG8_SB(1, 0), cB + kstep, voffB); PG8_STAGE(PG8_SA(1, 0), cA + kstep, voffA); PG8_STAGE(PG8_SB(1, 1), cB + hstep + kstep, voffB);
        PG8_WAIT_V(6); PG8_BAR;
    } else {
        PG8_STAGE(PG8_SB(0, 0), cB, voffB); PG8_STAGE(PG8_SA(0, 0), cA, voffA); PG8_STAGE(PG8_SB(0, 1), cB + hstep, voffB); PG8_STAGE(PG8_SA(0, 1), cA + hstep, voffA);
        if (wr == 1) PG8_BAR;
        PG8_WAIT_V(4); PG8_BAR;
        PG8_STAGE(PG8_SB(1, 0), cB + kstep, voffB); PG8_STAGE(PG8_SA(1, 0), cA + kstep, voffA); PG8_STAGE(PG8_SB(1, 1), cB + hstep + kstep, voffB);
        PG8_WAIT_V(6); PG8_BAR;
    }
    for (;;) {
        const bool has_next = S.next(ui + 1, nxt);
        const char* nA = has_next ? (const char*)(nxt.seg ? g.A2 : g.A) + (size_t)nxt.pm * tstep : cA; const char* nB = has_next ? (const char*)(nxt.seg ? g.Bt2 : g.Bt) + (size_t)nxt.pn * tstep : cB;
        for (int t = 0; t < nt; t += 2) {
            const bool last = (t == nt - 2);
            const char* a1 = cA + (size_t)(t + 1) * kstep;
            const char* a2 = last ? nA : cA + (size_t)(t + 2) * kstep; const char* b2 = last ? nB : cB + (size_t)(t + 2) * kstep;
            const char* a3 = a2 + kstep; const char* b3 = b2 + kstep;
            if (last && has_next) S.a_ready(nxt);
            if constexpr (SP2) {
            PG8_LDB(B0, 0, 0); PG8_LDB(B1, 0, 1); PG8_SCHED; PG8_LDA(At, 0, 0); PG8_STAGE(PG8_SA(1, 1), a1 + hstep, voffA);
            PG8_WAIT_V(8); PG8_WAIT_L(0); PG8_BAR; PG8_MMA(0, 0, At, B0); PG8_MMA(0, 1, At, B1); PG8_BAR; PG8_SCHED;
            PG8_LDA(At, 0, 1); PG8_STAGE(PG8_SB(0, 0), b2, voffB); PG8_STAGE(PG8_SB(0, 1), b2 + hstep, voffB); PG8_STAGE(PG8_SA(0, 0), a2, voffA);
            PG8_WAIT_V(8); PG8_WAIT_L(0); PG8_BAR; PG8_MMA(1, 0, At, B0); PG8_MMA(1, 1, At, B1); PG8_BAR; PG8_SCHED;
            PG8_LDB(B0, 1, 0); PG8_LDB(B1, 1, 1); PG8_SCHED; PG8_LDA(At, 1, 0); PG8_STAGE(PG8_SA(0, 1), a2 + hstep, voffA);
            PG8_WAIT_V(8); PG8_WAIT_L(0); PG8_BAR; PG8_MMA(0, 0, At, B0); PG8_MMA(0, 1, At, B1); PG8_BAR; PG8_SCHED;
            PG8_LDA(At, 1, 1); PG8_STAGE(PG8_SB(1, 0), b3, voffB); PG8_STAGE(PG8_SB(1, 1), b3 + hstep, voffB); PG8_STAGE(PG8_SA(1, 0), a3, voffA);
            PG8_WAIT_V(8); PG8_WAIT_L(0); PG8_BAR; PG8_MMA(1, 0, At, B0); PG8_MMA(1, 1, At, B1); PG8_BAR; PG8_SCHED;
            } else {
            PG8_LDB(B0, 0, 0); PG8_SCHED; PG8_LDA(At, 0, 0); PG8_STAGE(PG8_SA(1, 1), a1 + hstep, voffA);
            PG8_WAIT_L(8); PG8_BAR; PG8_WAIT_L(0); PG8_MMA(0, 0, At, B0); PG8_BAR; PG8_SCHED;
            PG8_LDB(B1, 0, 1); PG8_STAGE(PG8_SB(0, 0), b2, voffB);
            PG8_BAR; PG8_WAIT_L(0); PG8_MMA(0, 1, At, B1); PG8_BAR;
            PG8_LDA(At, 0, 1); PG8_STAGE(PG8_SA(0, 0), a2, voffA);
            PG8_BAR; PG8_WAIT_L(0); PG8_MMA(1, 0, At, B0); PG8_BAR; PG8_SCHED;
            PG8_STAGE(PG8_SB(0, 1), b2 + hstep, voffB);
            PG8_WAIT_V(6); PG8_BAR; PG8_MMA(1, 1, At, B1); PG8_BAR;
            PG8_LDB(B0, 1, 0); PG8_SCHED; PG8_LDA(At, 1, 0); PG8_STAGE(PG8_SA(0, 1), a2 + hstep, voffA);
            PG8_WAIT_L(8); PG8_BAR; PG8_WAIT_L(0); PG8_MMA(0, 0, At, B0); PG8_BAR; PG8_SCHED;
            PG8_LDB(B1, 1, 1); PG8_STAGE(PG8_SB(1, 0), b3, voffB);
            PG8_BAR; PG8_WAIT_L(0); PG8_MMA(0, 1, At, B1); PG8_BAR;
            PG8_LDA(At, 1, 1); PG8_STAGE(PG8_SA(1, 0), a3, voffA);
            PG8_BAR; PG8_WAIT_L(0); PG8_MMA(1, 0, At, B0); PG8_BAR; PG8_SCHED;
            PG8_STAGE(PG8_SB(1, 1), b3 + hstep, voffB);
            PG8_WAIT_V(6); PG8_BAR; PG8_MMA(1, 1, At, B1); PG8_BAR;
            }
        }
        if constexpr (ALIGN_EPI) { if (wr == 0) PG8_BAR; }
        bool keep = false;
        if constexpr (Epi::PAIRED) { if (cur.seg == 0) { E.mid(acc, cur, wr, wc, fr, fq); keep = true; } else E(acc, cur, wr, wc, fr, fq); S.done(cur); }
        else if constexpr (!Epi::AFTER_DRAIN) { E(acc, cur, wr, wc, fr, fq); S.done(cur); }
        if (!has_next) break;
        if (!keep)
#pragma unroll
        for (int a = 0; a < 2; ++a)
#pragma unroll
            for (int b = 0; b < 2; ++b)
#pragma unroll
                for (int m = 0; m < 4; ++m)
#pragma unroll
                    for (int n = 0; n < 2; ++n) acc[a][b][m][n] = (f32x4){0.f, 0.f, 0.f, 0.f};
        cur = nxt; cA = nA; cB = nB; ++ui;
        if constexpr (ALIGN_EPI) { if (wr == 1) PG8_BAR; }
    }
    PG8_WAIT_V(0);
    if constexpr (!ALIGN_EPI) { if (wr == 0) PG8_BAR; }
    PG8_BAR;
    if constexpr (Epi::AFTER_DRAIN) { E.fused(acc, cur, wr, wc, fr, fq, lds, wid, lane); S.done(cur); }
#undef PG8_SA
#undef PG8_SB
#undef PG8_STAGE
#undef PG8_LDA
#undef PG8_LDB
#undef PG8_MMA
#undef PG8_WAIT_V
#undef PG8_WAIT_L
#undef PG8_BAR
#undef PG8_SCHED
}
}


constexpr int NWAVES = 8;
constexpr int DM = 2048, BATCH = 4, SEQ = 4096, M = BATCH * SEQ, NMETA = 16, INW = 16384;
constexpr int NH = 16, HD = 128, CH = 64, NCH = SEQ / CH;
constexpr int PH = 8, NKEY = 128, TOPK = 16, NEXP = NKEY * NKEY, NSEL = PH * TOPK;
constexpr float EPS = 1e-6f;

constexpr size_t MiB = 1u << 20;
constexpr size_t WS_CTL = 0, CTL_ZERO_BYTES = 1 * MiB;
constexpr size_t SLAB_BYTES = (size_t)M * DM * 2;
constexpr size_t WS_SLAB = 1 * MiB;
constexpr size_t WS_WPA = 513 * MiB, WS_WPB = 521 * MiB, WS_WOUT = 529 * MiB, WS_WQ = 537 * MiB;
constexpr size_t WS_KEYS = 545 * MiB, WS_WA = WS_KEYS + 512 * 1024, WS_WX = WS_WA + 512 * 1024;
constexpr size_t WS_METAPROJ = 547 * MiB, WS_XNMETA = WS_METAPROJ + 512 * 1024;
constexpr size_t WS_RGSUM = 548 * MiB;
constexpr size_t WS_RGHIN = 553 * MiB;
constexpr size_t WS_HGDEC = 556 * MiB;
constexpr size_t WS_HGMETA = 559 * MiB;
constexpr size_t WS_RSP = 561 * MiB;
constexpr size_t WS_PSC = 563 * MiB;
constexpr size_t WS_END = 564 * MiB;
constexpr int SL_XA = 0, SL_YA = 1, SL_Q = 2, SL_F = 3, SL_I = 4, SL_OG = 5, SL_ZA = 6, SL_ZB = 7;
constexpr int SL_UB = 0, SL_VB = 2, SL_MIX = 3, SL_H2B = 4, SL_QP = 1, SL_SEL = 5;
constexpr int CW_BAR = 4096;

constexpr int RING_BYTES = 131072;
constexpr int LDS_BYTES = 147456;
constexpr int LDSCTL_OFF = LDS_BYTES - 1024, MISC_OFF = LDSCTL_OFF + 320;

#define LAS __attribute__((address_space(3)))
typedef unsigned short bf16;
typedef unsigned v4u __attribute__((ext_vector_type(4)));
typedef unsigned v2u __attribute__((ext_vector_type(2)));
typedef float f32x4 __attribute__((ext_vector_type(4)));
typedef float f32x2 __attribute__((ext_vector_type(2)));
typedef short bf16x8 __attribute__((ext_vector_type(8)));
#define LDS_WAIT() asm volatile("s_waitcnt lgkmcnt(0)" ::: "memory")
__device__ __forceinline__ int lane_now() { int l; asm volatile("v_mbcnt_lo_u32_b32 %0, -1, 0\n\tv_mbcnt_hi_u32_b32 %0, -1, %0" : "=v"(l)); return l; }
#define VM_WAIT() asm volatile("s_waitcnt vmcnt(0)" ::: "memory")
__device__ __forceinline__ unsigned f2bf(float f) { unsigned u = __builtin_bit_cast(unsigned, f); return (u + 0x7fffu + ((u >> 16) & 1u)) >> 16; }
__device__ __forceinline__ unsigned pk2(float lo, float hi) { unsigned r; asm("v_cvt_pk_bf16_f32 %0, %1, %2" : "=v"(r) : "v"(lo), "v"(hi)); return r; }
__device__ __forceinline__ float bflo(unsigned w) { return __uint_as_float(w << 16); }
__device__ __forceinline__ float bfhi(unsigned w) { return __uint_as_float(w & 0xffff0000u); }
__device__ __forceinline__ float bf1(bf16 h) { return __uint_as_float(((unsigned)h) << 16); }
__device__ __forceinline__ float sigm(float x) { return __builtin_amdgcn_rcpf(1.0f + __builtin_amdgcn_exp2f(-1.44269504f * x)); }
__device__ __forceinline__ float gelu1(float v) { pg8::f32x2 t; t.x = v; t.y = 0.f; t = pg8::gelu_pk(t); return t.x; }

#define XB_TMO      128
#define XB_XCNT(j)  (256  + 64 * (j))
#define XB_XSUB(j)  (1280 + 64 * (j))
#define XB_XGEN(j)  (2304 + 64 * (j))
#define XB_TOP      3328
#define XB_TOPGEN   3392
#define XCD_BAR_WORDS 3456
#define XB_SPIN_CAP (1u << 18)
__device__ __forceinline__ unsigned xb_ld(unsigned* p)              { return __hip_atomic_load(p, __ATOMIC_RELAXED, __HIP_MEMORY_SCOPE_AGENT); }
__device__ __forceinline__ unsigned xb_add(unsigned* p, unsigned v) { return __hip_atomic_fetch_add(p, v, __ATOMIC_RELAXED, __HIP_MEMORY_SCOPE_AGENT); }
__device__ __forceinline__ unsigned xb_xcc_id() { return (unsigned)__builtin_amdgcn_s_getreg((3 << 11) | 20) & 0xFu; }
#define XB_SPIN(cond, bar) do { unsigned _sp = 0; while (cond) { __builtin_amdgcn_s_sleep(1); \
    if ((++_sp & 255u) == 0u) { if (xb_ld(&(bar)[XB_TMO])) break; if (_sp > XB_SPIN_CAP) { atomicAdd(&(bar)[XB_TMO], 1u); break; } } } } while (0)
struct XcdBarrier { unsigned* bar; unsigned x; volatile LAS unsigned* st; int wave; };
__device__ __forceinline__ XcdBarrier xcd_barrier_post(unsigned* bar, volatile LAS unsigned* st) {
    XcdBarrier b; b.bar = bar; b.x = xb_xcc_id(); b.st = st; b.wave = __builtin_amdgcn_readfirstlane((int)threadIdx.x >> 6);
    if (threadIdx.x == 0) (void)xb_add(&bar[XB_XCNT(b.x)], 1u);
    return b;
}
__device__ __forceinline__ void xcd_barrier_complete(unsigned* bar, unsigned x, unsigned& nloc, unsigned& nx) {
    const unsigned G = gridDim.x * gridDim.y * gridDim.z;
    unsigned sum, cnt, mine, sp = 0u;
    for (;;) {
        sum = 0u; cnt = 0u; mine = 0u;
#pragma unroll
        for (unsigned j = 0; j < 16; ++j) { const unsigned c = xb_ld(&bar[XB_XCNT(j)]); sum += c; cnt += (c > 0u) ? 1u : 0u; mine = (j == x) ? c : mine; }
        if (sum == G) break;
        __builtin_amdgcn_s_sleep(1);
        if ((++sp & 255u) == 0u) { if (xb_ld(&bar[XB_TMO])) break; if (sp > XB_SPIN_CAP) { atomicAdd(&bar[XB_TMO], 1u); break; } }
    }
    nloc = mine > 0u ? mine : 1u; nx = cnt > 0u ? cnt : 1u;
}
__device__ __forceinline__ void xcd_barrier(const XcdBarrier& b) {
    asm volatile("s_waitcnt vmcnt(0)" ::: "memory");
    __syncthreads();
    if (b.wave == 0 && lane_now() == 0) {
        unsigned* bar = b.bar;
        __builtin_amdgcn_s_waitcnt(0);
        unsigned nloc = b.st[0], nx = b.st[1];
        if (nloc == 0u) { xcd_barrier_complete(bar, b.x, nloc, nx); b.st[0] = nloc; b.st[1] = nx; }
        const unsigned old = xb_add(&bar[XB_XSUB(b.x)], 1u);
        const unsigned gen = old / nloc;
        if (old + 1u == (gen + 1u) * nloc) {
            __builtin_amdgcn_fence(__ATOMIC_RELEASE, "agent");
            asm volatile("s_waitcnt vmcnt(0)" ::: "memory");
            const unsigned og = xb_add(&bar[XB_TOP], 1u);
            const unsigned tg = og / nx;
            if (og + 1u == (tg + 1u) * nx) xb_add(&bar[XB_TOPGEN], 1u);
            else XB_SPIN(xb_ld(&bar[XB_TOPGEN]) == tg, bar);
            __builtin_amdgcn_fence(__ATOMIC_ACQUIRE, "agent");
            xb_add(&bar[XB_XGEN(b.x)], 1u);
            asm volatile("s_waitcnt vmcnt(0)" ::: "memory");
        } else {
            XB_SPIN(xb_ld(&bar[XB_XGEN(b.x)]) == gen, bar);
            __builtin_amdgcn_fence(__ATOMIC_ACQUIRE, "agent");
            asm volatile("s_waitcnt vmcnt(0)" ::: "memory");
        }
    }
    __syncthreads();
}

struct Args { const float* in[22]; float* out; unsigned char* ws; };
struct Frame {
    LAS unsigned char* lds;
    volatile LAS unsigned* MISC;
    int wave, vcu, G;
};
#define IN_(k) (args.in[k])
#define A_x IN_(0)
#define A_meta IN_(1)
#define A_ln1_g IN_(2)
#define A_w_in IN_(3)
#define A_conv_w IN_(4)
#define A_conv_b IN_(5)
#define A_rg_wa IN_(6)
#define A_rg_ba IN_(7)
#define A_rg_wx IN_(8)
#define A_rg_bx IN_(9)
#define A_rg_lambda IN_(10)
#define A_hg_lb IN_(11)
#define A_hg_norm_g IN_(12)
#define A_w_pa IN_(13)
#define A_w_pb IN_(14)
#define A_w_out IN_(15)
#define A_ln2_g IN_(16)
#define A_peer_wq IN_(17)
#define A_peer_keys IN_(18)
#define A_peer_u IN_(19)
#define A_peer_v IN_(20)
#define A_final_g IN_(21)
#define A_out (args.out)
#define W_SLAB(i) ((bf16*)(args.ws + WS_SLAB + (size_t)(i) * SLAB_BYTES))
#define W_WinT ((bf16*)args.out)
#define W_XN ((bf16*)args.out + (size_t)INW * DM)
#define W_WpaT ((bf16*)(args.ws + WS_WPA))
#define W_WpbT ((bf16*)(args.ws + WS_WPB))
#define W_WoutT ((bf16*)(args.ws + WS_WOUT))
#define W_WqT ((bf16*)(args.ws + WS_WQ))
#define W_KEYS ((bf16*)(args.ws + WS_KEYS))
#define W_WAT ((bf16*)(args.ws + WS_WA))
#define W_WXT ((bf16*)(args.ws + WS_WX))
#define W_METAPROJ ((bf16*)(args.ws + WS_METAPROJ))
#define W_XNMETA ((bf16*)(args.ws + WS_XNMETA))
#define W_RGSUM ((float*)(args.ws + WS_RGSUM))
#define W_RGHIN ((float*)(args.ws + WS_RGHIN))
#define W_HGDEC ((float*)(args.ws + WS_HGDEC))
#define W_HGMETA ((float*)(args.ws + WS_HGMETA))
#define W_RSP ((float*)(args.ws + WS_RSP))
#define W_PSC ((float*)(args.ws + WS_PSC))
#define W_RSTD2 ((float*)(args.ws + WS_PSC + 256 * 1024))
__device__ __forceinline__ float wave_sum(float v) {
#pragma unroll
    for (int o = 1; o < 64; o <<= 1) v += __shfl_xor(v, o);
    return v;
}
__device__ __forceinline__ float wave_max(float v) {
#pragma unroll
    for (int o = 1; o < 64; o <<= 1) v = fmaxf(v, __shfl_xor(v, o));
    return v;
}
__device__ __forceinline__ f32x4 mma16(f32x4 acc, const LAS unsigned char* a, int lda, const LAS unsigned char* b, int ldb, int K, int lane) {
    const int r = lane & 15, g = lane >> 4;
    const LAS unsigned char* ap = a + r * lda + g * 16; const LAS unsigned char* bp = b + r * ldb + g * 16;
    for (int k0 = 0; k0 < K; k0 += 32) {
        const bf16x8 av = *(const LAS bf16x8*)(ap + k0 * 2); const bf16x8 bv = *(const LAS bf16x8*)(bp + k0 * 2);
        acc = __builtin_amdgcn_mfma_f32_16x16x32_bf16(av, bv, acc, 0, 0, 0);
    }
    return acc;
}
__device__ __forceinline__ void p0_transpose_item(const float* W, int K, int N, bf16* WT, LAS float* scr, int item, int lane, const float* rs) {
    const int nblk = N / 64, kb = item / nblk, nb = item % nblk, k0 = 64 * kb, n0 = 64 * nb;
    f32x4 v[16];
#pragma unroll
    for (int i = 0; i < 16; ++i) v[i] = *(const f32x4*)(W + (size_t)(k0 + 4 * i + (lane >> 4)) * N + n0 + 4 * (lane & 15));
#pragma unroll
    for (int i = 0; i < 16; ++i) { const int kk = 4 * i + (lane >> 4); f32x4 w = v[i]; if (rs) w = w * rs[k0 + kk]; *(LAS f32x4*)(scr + kk * 68 + 4 * (lane & 15)) = w; }
    LDS_WAIT(); asm volatile("" ::: "memory");
    const int c = lane & 7;
#pragma unroll
    for (int j = 0; j < 8; ++j) { const int n = (lane >> 3) + 8 * j; const LAS float* sp = scr + (8 * c) * 68 + n;
        v4u o; o.x = pk2(sp[0 * 68], sp[1 * 68]); o.y = pk2(sp[2 * 68], sp[3 * 68]); o.z = pk2(sp[4 * 68], sp[5 * 68]); o.w = pk2(sp[6 * 68], sp[7 * 68]);
        *(v4u*)(WT + (size_t)(n0 + n) * K + k0 + 8 * c) = o; }
    LDS_WAIT(); asm volatile("" ::: "memory");
}
__device__ __forceinline__ void rms_row_to_bf16(const float* xrow, const float* g, bf16* orow, int lane) {
    const f32x4* xr = (const f32x4*)xrow + lane; const f32x4* gr = (const f32x4*)g + lane;
    f32x4 v[8]; float s = 0.f;
#pragma unroll
    for (int j = 0; j < 8; ++j) { v[j] = xr[64 * j]; s += (v[j].x * v[j].x + v[j].y * v[j].y) + (v[j].z * v[j].z + v[j].w * v[j].w); }
    const float rstd = 1.0f / sqrtf(wave_sum(s) * (1.f / DM) + EPS);
    unsigned long long* o8 = (unsigned long long*)orow + lane;
#pragma unroll
    for (int j = 0; j < 8; ++j) { const f32x4 gg = gr[64 * j];
        o8[64 * j] = (unsigned long long)pk2(v[j].x * rstd * gg.x, v[j].y * rstd * gg.y) | ((unsigned long long)pk2(v[j].z * rstd * gg.z, v[j].w * rstd * gg.w) << 32); }
}
__device__ __forceinline__ void p0_prologue(Frame& F, const Args& args) {
    const int lane_ = lane_now(), tid_ = F.wave * 64 + lane_; (void)tid_;
    LAS float* scr = (LAS float*)(F.lds + F.wave * 17408);
    const int gw = F.vcu * NWAVES + F.wave, NGW = F.G * NWAVES;
    constexpr int I_IN = (DM / 64) * (INW / 64), I_SQ = (DM / 64) * (DM / 64), I_G = 16 * (HD / 64) * (HD / 64);
    constexpr int NITEMS = I_IN + 4 * I_SQ + 2 * I_G;
    for (int it = gw; it < NITEMS; it += NGW) {
        int r = it;
        if (r < I_IN) { p0_transpose_item(A_w_in, DM, INW, W_WinT, scr, r, lane_, nullptr); continue; } r -= I_IN;
        if (r < I_SQ) { p0_transpose_item(A_w_pa, DM, DM, W_WpaT, scr, r, lane_, nullptr); continue; } r -= I_SQ;
        if (r < I_SQ) { p0_transpose_item(A_w_pb, DM, DM, W_WpbT, scr, r, lane_, nullptr); continue; } r -= I_SQ;
        if (r < I_SQ) { p0_transpose_item(A_w_out, DM, DM, W_WoutT, scr, r, lane_, nullptr); continue; } r -= I_SQ;
        if (r < I_SQ) { p0_transpose_item(A_peer_wq, DM, DM, W_WqT, scr, r, lane_, A_ln2_g); continue; } r -= I_SQ;
        if (r < I_G) { const int h = r / 4; p0_transpose_item(A_rg_wa + (size_t)h * HD * HD, HD, HD, W_WAT + (size_t)h * HD * HD, scr, r % 4, lane_, nullptr); continue; } r -= I_G;
        { const int h = r / 4; p0_transpose_item(A_rg_wx + (size_t)h * HD * HD, HD, HD, W_WXT + (size_t)h * HD * HD, scr, r % 4, lane_, nullptr); }
    }
    for (int m = gw; m < M + NMETA; m += NGW) {
        if (m < M) rms_row_to_bf16(A_x + (size_t)m * DM, A_ln1_g, W_XN + (size_t)m * DM, lane_);
        else rms_row_to_bf16(A_meta + (size_t)(m - M) * DM, A_ln1_g, W_XNMETA + (size_t)(m - M) * DM, lane_);
    }
    for (int i = (F.vcu * NWAVES * 64 + tid_); i < PH * 2 * NKEY * 128 / 2; i += F.G * NWAVES * 64) {
        const f32x2 k2 = ((const f32x2*)A_peer_keys)[i]; ((unsigned*)W_KEYS)[i] = pk2(k2.x, k2.y); }
}

__device__ __forceinline__ void p1_meta(Frame& F, const Args& args) {
    const int lane_ = lane_now(), tid_ = F.wave * 64 + lane_; (void)tid_;
    const int gw = F.vcu * NWAVES + F.wave, NGW = F.G * NWAVES, r = lane_ & 15, g = lane_ >> 4;
    for (int it = gw; it < INW / 16; it += NGW) {
        const int n0 = it * 16;
        const bf16* ap = W_XNMETA + (size_t)r * DM + 8 * g; const bf16* bp = W_WinT + (size_t)(n0 + r) * DM + 8 * g;
        f32x4 acc = (f32x4){0.f, 0.f, 0.f, 0.f};
#pragma unroll 4
        for (int k0 = 0; k0 < DM; k0 += 32) { const bf16x8 a = *(const bf16x8*)(ap + k0); const bf16x8 b = *(const bf16x8*)(bp + k0); acc = __builtin_amdgcn_mfma_f32_16x16x32_bf16(a, b, acc, 0, 0, 0); }
#pragma unroll
        for (int j = 0; j < 4; ++j) W_METAPROJ[(size_t)(4 * g + j) * INW + n0 + r] = (bf16)f2bf(acc[j]);
    }
}

template <int MODE, bool DUMMY, int VAR = 0>
__device__ __forceinline__ void rg_wave_item(const Args& args, const LAS unsigned char* WAl, const LAS unsigned char* WXl, LAS unsigned char* YL, const LAS float* CST, int h, int b, int c, bool meta, int lane) {
    const int r = lane & 15, g = lane >> 4;
    const int nhalf = meta ? 1 : 2, ntile = meta ? 1 : 2;
    bf16x8 SEL0, SEL1;
#pragma unroll
    for (int j = 0; j < 8; ++j) { SEL0[j] = (8 * g + j == r) ? (short)0x3F80 : (short)0; SEL1[j] = (8 * g + j == 16 + r) ? (short)0x3F80 : (short)0; }
    float hc[8], pt[8];
#pragma unroll
    for (int ct = 0; ct < 8; ++ct) { hc[ct] = (MODE == 1) ? W_RGHIN[(size_t)(b * NCH + c) * DM + h * HD + 16 * ct + r] : 0.f; pt[ct] = 1.f; }
#pragma unroll 1
    for (int hf = 0; hf < nhalf; ++hf) {
        v4u yr[8];
        if (MODE == 1) {
#pragma unroll
            for (int i = 0; i < 8; ++i) yr[i] = *(const v4u*)(W_SLAB(SL_YA) + (size_t)(b * SEQ + c * CH + 32 * hf + 4 * i + (lane >> 4)) * DM + h * HD + 8 * (lane & 15));
        }
        bf16x8 A[2][4];
#pragma unroll
        for (int rt = 0; rt < 2; ++rt) {
            if (rt < ntile) {
                v4u xr[4][4];
                const int t = 32 * hf + 16 * rt + r;
#pragma unroll
                for (int k = 0; k < 4; ++k) {
                    const bf16* rowp; bool valid = true;
                    if (meta) { const int s = t + k - 3; valid = s >= 0; rowp = W_METAPROJ + (size_t)(valid ? s : 0) * INW; }
                    else { const int s = c * CH + t + k - 3; rowp = (s >= 0) ? W_SLAB(SL_XA) + (size_t)(b * SEQ + s) * DM : W_METAPROJ + (size_t)(NMETA + s) * INW; }
#pragma unroll
                    for (int ks = 0; ks < 4; ++ks) { v4u xw = *(const v4u*)(rowp + h * HD + 32 * ks + 8 * g); if (!valid) xw = (v4u){0u, 0u, 0u, 0u}; xr[ks][k] = xw; }
                }
                __builtin_amdgcn_sched_barrier(0);
#pragma unroll
                for (int ks = 0; ks < 4; ++ks) {
                    f32x4 a0 = *(const LAS f32x4*)(CST + 896 + 32 * ks + 8 * g), a1 = *(const LAS f32x4*)(CST + 896 + 32 * ks + 8 * g + 4);
#pragma unroll
                    for (int k = 0; k < 4; ++k) { const v4u xw = xr[ks][k];
                        const f32x4 w0 = *(const LAS f32x4*)(CST + 384 + k * 128 + 32 * ks + 8 * g), w1 = *(const LAS f32x4*)(CST + 384 + k * 128 + 32 * ks + 8 * g + 4);
                        a0 += w0 * (f32x4){bflo(xw.x), bfhi(xw.x), bflo(xw.y), bfhi(xw.y)};
                        a1 += w1 * (f32x4){bflo(xw.z), bfhi(xw.z), bflo(xw.w), bfhi(xw.w)}; }
                    v4u pk; pk.x = pk2(a0[0], a0[1]); pk.y = pk2(a0[2], a0[3]); pk.z = pk2(a1[0], a1[1]); pk.w = pk2(a1[2], a1[3]);
                    A[rt][ks] = __builtin_bit_cast(bf16x8, pk);
                }
                __builtin_amdgcn_sched_barrier(0);
            } else {
#pragma unroll
                for (int ks = 0; ks < 4; ++ks) A[rt][ks] = (bf16x8){0, 0, 0, 0, 0, 0, 0, 0};
            }
        }
        if (MODE == 1) {
#pragma unroll
            for (int i = 0; i < 8; ++i) { v4u gw;
#pragma unroll
                for (int w = 0; w < 4; ++w) { const pg8::f32x2 gl = pg8::gelu_pk((pg8::f32x2){bflo(yr[i][w]), bfhi(yr[i][w])}); gw[w] = pk2(gl.x, gl.y); }
                *(LAS v4u*)(YL + (4 * i + (lane >> 4)) * 272 + 16 * (lane & 15)) = gw; }
        }
#pragma unroll
        for (int ct = 0; ct < 8; ++ct) {
            const int col = h * HD + 16 * ct + r;
            const float ba = CST[16 * ct + r], bx = CST[128 + 16 * ct + r], sp2 = CST[256 + 16 * ct + r];
            bf16x8 wa[4], wx[4];
#pragma unroll
            for (int ks = 0; ks < 4; ++ks) { wa[ks] = *(const LAS bf16x8*)(WAl + (16 * ct + r) * 272 + ks * 64 + g * 16); wx[ks] = *(const LAS bf16x8*)(WXl + (16 * ct + r) * 272 + ks * 64 + g * 16); }
#pragma unroll
            for (int rt = 0; rt < 2; ++rt) {
                if (rt < ntile) {
                    f32x4 R = (f32x4){0.f, 0.f, 0.f, 0.f}, I = R, XC = R;
#pragma unroll
                    for (int ks = 0; ks < 4; ++ks) { if (VAR == 4 && ks > 0) continue; R = __builtin_amdgcn_mfma_f32_16x16x32_bf16(A[rt][ks], wa[ks], R, 0, 0, 0); I = __builtin_amdgcn_mfma_f32_16x16x32_bf16(A[rt][ks], wx[ks], I, 0, 0, 0); }
                    XC = __builtin_amdgcn_mfma_f32_16x16x32_bf16(A[rt][ct >> 1], (ct & 1) ? SEL1 : SEL0, XC, 0, 0, 0);
                    float av[4], uv[4];
#pragma unroll
                    for (int j = 0; j < 4; ++j) {
                        const float rr = sigm(R[j] + ba), ii = sigm(I[j] + bx);
                        av[j] = __builtin_amdgcn_exp2f(sp2 * rr); uv[j] = __builtin_amdgcn_sqrtf((1.0f - av[j]) * (1.0f + av[j])) * ii * XC[j]; }
                    const float P = (av[0] * av[1]) * (av[2] * av[3]);
                    const float U = ((uv[0] * av[1] + uv[1]) * av[2] + uv[2]) * av[3] + uv[3];
                    const float P0 = (VAR == 2) ? P : __shfl(P, r), P1 = (VAR == 2) ? P : __shfl(P, r + 16), P2 = (VAR == 2) ? P : __shfl(P, r + 32), P3 = (VAR == 2) ? P : __shfl(P, r + 48);
                    const float U0 = (VAR == 2) ? U : __shfl(U, r), U1 = (VAR == 2) ? U : __shfl(U, r + 16), U2 = (VAR == 2) ? U : __shfl(U, r + 32), U3 = (VAR == 2) ? U : __shfl(U, r + 48);
                    const float h0 = hc[ct], h1 = P0 * h0 + U0, h2 = P1 * h1 + U1, h3 = P2 * h2 + U2, he = P3 * h3 + U3;
                    if (MODE == 1) {
                        float hh = (g == 0) ? h0 : (g == 1) ? h1 : (g == 2) ? h2 : h3;
#pragma unroll
                        for (int j = 0; j < 4; j += 2) { const int tl = 16 * rt + 4 * g + j;
                            const float hA = av[j] * hh + uv[j], hB = av[j + 1] * hA + uv[j + 1]; hh = hB;
                            LAS bf16* yp = (LAS bf16*)(YL + tl * 272 + (16 * ct + r) * 2);
                            const unsigned pw = pk2(bf1(yp[0]) * hA, bf1(yp[136]) * hB);
                            yp[0] = (bf16)(pw & 0xffffu); yp[136] = (bf16)(pw >> 16); }
                    }
                    hc[ct] = he; pt[ct] *= (P0 * P1) * (P2 * P3);
                }
            }
            if (ct & 1) __builtin_amdgcn_sched_barrier(0);
        }
        if (MODE == 1) {
#pragma unroll
            for (int i = 0; i < 8; ++i) { const v4u yv = *(const LAS v4u*)(YL + (4 * i + (lane >> 4)) * 272 + 16 * (lane & 15));
                const size_t eo = (size_t)(b * SEQ + c * CH + 32 * hf + 4 * i + (lane >> 4)) * DM + h * HD + 8 * (lane & 15);
                bf16* yo = DUMMY ? (bf16*)(args.ws + WS_END) + (eo & (size_t)(4 * MiB - 1)) : W_SLAB(SL_YA) + eo;
                *(v4u*)yo = yv; }
        }
    }
    if (MODE == 0 && g == 0) {
#pragma unroll
        for (int ct = 0; ct < 8; ++ct) { const int col = h * HD + 16 * ct + r;
            const size_t o = meta ? ((size_t)BATCH * NCH * DM + col) : ((size_t)(b * NCH + c) * DM + col);
            ((f32x2*)W_RGSUM)[o] = (f32x2){pt[ct], hc[ct]}; }
    }
}
template <int MODE, bool DUMMY = false, int VAR = 0>
__device__ __forceinline__ void rg_phase(Frame& F, const Args& args) {
    const int lane_ = lane_now(), tid_ = F.wave * 64 + lane_; (void)tid_;
    LAS unsigned char* WAl = F.lds;
    LAS unsigned char* WXl = F.lds + 34816;
    LAS unsigned char* YL = F.lds + 69632 + F.wave * 8704;
    LAS float* CST = (LAS float*)(F.lds + 139264);
    const int nit = BATCH * NCH * NH, per = (nit + F.G - 1) / F.G;
    const int it0 = F.vcu * per, it1 = (it0 + per < nit) ? it0 + per : nit;
    for (int seg0 = it0; seg0 < it1;) {
        const int h = seg0 >> 8, hend = (h + 1) << 8, seg1 = hend < it1 ? hend : it1;
        __syncthreads();
        { const v4u* ga = (const v4u*)(W_WAT + (size_t)h * HD * HD); const v4u* gx = (const v4u*)(W_WXT + (size_t)h * HD * HD);
#pragma unroll
          for (int i = 0; i < 4; ++i) { const int p = tid_ + 512 * i, row = p >> 4, c16 = p & 15;
              *(LAS v4u*)(WAl + row * 272 + c16 * 16) = ga[p]; *(LAS v4u*)(WXl + row * 272 + c16 * 16) = gx[p]; } }
        if (tid_ < HD) { const int col = h * HD + tid_; CST[tid_] = A_rg_ba[col]; CST[128 + tid_] = A_rg_bx[col]; CST[256 + tid_] = -8.0f * 1.44269504f * log1pf(__expf(-A_rg_lambda[col]));
#pragma unroll
            for (int k = 0; k < 4; ++k) CST[384 + k * 128 + tid_] = A_conv_w[(size_t)k * DM + col];
            CST[896 + tid_] = A_conv_b[col]; }
        __syncthreads();
        for (int it = seg0 + F.wave; it < seg1; it += NWAVES) {
            const int bc = it & 255, b = bc >> 6, c = bc & 63;
            if (MODE == 0 && bc == 0) rg_wave_item<MODE, DUMMY, VAR>(args, WAl, WXl, YL, CST, h, 0, 0, true, lane_);
            rg_wave_item<MODE, DUMMY, VAR>(args, WAl, WXl, YL, CST, h, b, c, false, lane_);
        }
        seg0 = seg1;
    }
    __syncthreads();
}
__device__ __forceinline__ void rg_carry(Frame& F, const Args& args) {
    const int lane_ = lane_now(), tid_ = F.wave * 64 + lane_; (void)tid_;
    const int gid = F.vcu * NWAVES * 64 + tid_;
    if (gid < BATCH * DM) {
        const int b = gid >> 11, col = gid & (DM - 1);
        float h = ((const f32x2*)W_RGSUM)[(size_t)BATCH * NCH * DM + col].y;
        for (int c0 = 0; c0 < NCH; c0 += 16) { f32x2 sv[16];
#pragma unroll
            for (int i = 0; i < 16; ++i) sv[i] = ((const f32x2*)W_RGSUM)[(size_t)(b * NCH + c0 + i) * DM + col];
#pragma unroll
            for (int i = 0; i < 16; ++i) { W_RGHIN[(size_t)(b * NCH + c0 + i) * DM + col] = h; h = sv[i].x * h + sv[i].y; } }
    }
}

struct HgRaw { unsigned fw[8], vw[8], qw[8]; v4u stw[4]; v2u ogw[4]; };
template <int MODE>
__device__ __forceinline__ void hg_load(HgRaw& R, const Args& args, const bf16* ST, int it, int tid_, int lane_, int w) {
    const bool meta = it >= BATCH * NH * NCH;
    const int bh = meta ? 0 : (it >> 6), c = meta ? 0 : (it & 63), b = bh >> 4, h = meta ? (it - BATCH * NH * NCH) : (bh & 15);
    const int kp = w * 8 + (lane_ & 7), sg = lane_ >> 3, r = lane_ & 15, g = lane_ >> 4, col = h * HD + 2 * kp;
#pragma unroll
    for (int i = 0; i < 8; ++i) { const int s = 8 * sg + i;
        if (meta) { const bool valid = s < NMETA; const size_t ro = (size_t)(valid ? s : 0) * INW + col;
            const unsigned f = *(const unsigned*)(W_METAPROJ + ro + 3 * DM), v = *(const unsigned*)(W_METAPROJ + ro + 4 * DM); R.fw[i] = valid ? f : 0u; R.vw[i] = valid ? v : 0u; if (MODE == 1) R.qw[i] = 0u; }
        else { const size_t ro = (size_t)(b * SEQ + c * CH + s) * DM + col; R.fw[i] = *(const unsigned*)(W_SLAB(SL_F) + ro); R.vw[i] = *(const unsigned*)(W_SLAB(SL_I) + ro);
               if (MODE == 1) R.qw[i] = *(const unsigned*)(W_SLAB(SL_Q) + ro); } }
    if (MODE == 1) { const v4u* gs = (const v4u*)(ST + ((size_t)(bh * NCH + c)) * HD * HD);
#pragma unroll
        for (int i = 0; i < 4; ++i) R.stw[i] = gs[tid_ + 512 * i];
#pragma unroll
        for (int tt = 0; tt < 4; ++tt) R.ogw[tt] = *(const v2u*)(W_SLAB(SL_OG) + (size_t)(b * SEQ + c * CH + 16 * tt + r) * DM + h * HD + 16 * w + 4 * g); }
}
template <int MODE, bool DUMMY = false>
__device__ __forceinline__ void hg_phase(Frame& F, const Args& args, bf16* ST) {
    const int lane_ = lane_now(), tid_ = F.wave * 64 + lane_; (void)tid_;
    LAS unsigned char* VT = F.lds;
    LAS float* TOT = (LAS float*)(F.lds + 18432);
    LAS unsigned char* KDT = F.lds + 22528;
    LAS unsigned char* QDEC = F.lds + 22528;
    LAS unsigned char* QD2 = F.lds + 39936;
    LAS unsigned char* KD2 = F.lds + 57344;
    LAS unsigned char* STl = F.lds + 74752;
    LAS unsigned char* PB = F.lds + 109568;
    LAS float* SSQ = (LAS float*)(F.lds + 118784);
    const int nit = BATCH * NH * NCH + (MODE == 0 ? NH : 0);
    const int w = F.wave, kp = w * 8 + (lane_ & 7), sg = lane_ >> 3, r = lane_ & 15, g = lane_ >> 4;
    HgRaw cur, nxt;
    if (F.vcu < nit) hg_load<MODE>(cur, args, ST, F.vcu, tid_, lane_, w);
    for (int it = F.vcu; it < nit; it += F.G) {
        const bool meta = it >= BATCH * NH * NCH;
        const int bh = meta ? 0 : (it >> 6), c = meta ? 0 : (it & 63), b = bh >> 4, h = meta ? (it - BATCH * NH * NCH) : (bh & 15);
        const int col = h * HD + 2 * kp;
        __syncthreads();
        float lb0, lb1;
        { const f32x2 l0 = *(const f32x2*)(A_hg_lb + col), l1 = *(const f32x2*)(A_hg_lb + DM + col); lb0 = 1.0f / (1.0f + __expf(l1.x - l0.x)); lb1 = 1.0f / (1.0f + __expf(l1.y - l0.y)); }
        float cs0[8], cs1[8], kk0[8], kk1[8];
        float run0 = 0.f, run1 = 0.f;
#pragma unroll
        for (int i = 0; i < 8; ++i) {
            const int s = 8 * sg + i; const unsigned fw = cur.fw[i]; const bool valid = !meta || s < NMETA;
            const float f0 = lb0 + (1.0f - lb0) * sigm(bflo(fw)), f1 = lb1 + (1.0f - lb1) * sigm(bfhi(fw));
            const float l0 = valid ? __logf(f0) : 0.f, l1 = valid ? __logf(f1) : 0.f;
            kk0[i] = valid ? 1.0f - f0 : 0.f; kk1[i] = valid ? 1.0f - f1 : 0.f;
            run0 += l0; run1 += l1; cs0[i] = run0; cs1[i] = run1;
        }
        float inc0 = run0, inc1 = run1;
        { float t0 = __shfl_up(inc0, 8), t1 = __shfl_up(inc1, 8); if (sg >= 1) { inc0 += t0; inc1 += t1; }
          t0 = __shfl_up(inc0, 16); t1 = __shfl_up(inc1, 16); if (sg >= 2) { inc0 += t0; inc1 += t1; }
          t0 = __shfl_up(inc0, 32); t1 = __shfl_up(inc1, 32); if (sg >= 4) { inc0 += t0; inc1 += t1; } }
        const float pre0 = inc0 - run0, pre1 = inc1 - run1;
        const float tot0 = __shfl(inc0, lane_ | 56), tot1 = __shfl(inc1, lane_ | 56), ref0 = __shfl(inc0, (lane_ & 7) | 24), ref1 = __shfl(inc1, (lane_ & 7) | 24);
        { v4u p0, p1;
          p0.x = (cur.vw[0] & 0xffffu) | (cur.vw[1] << 16); p0.y = (cur.vw[2] & 0xffffu) | (cur.vw[3] << 16); p0.z = (cur.vw[4] & 0xffffu) | (cur.vw[5] << 16); p0.w = (cur.vw[6] & 0xffffu) | (cur.vw[7] << 16);
          p1.x = (cur.vw[0] >> 16) | (cur.vw[1] & 0xffff0000u); p1.y = (cur.vw[2] >> 16) | (cur.vw[3] & 0xffff0000u); p1.z = (cur.vw[4] >> 16) | (cur.vw[5] & 0xffff0000u); p1.w = (cur.vw[6] >> 16) | (cur.vw[7] & 0xffff0000u);
          *(LAS v4u*)(VT + (2 * kp) * 144 + sg * 16) = p0; *(LAS v4u*)(VT + (2 * kp + 1) * 144 + sg * 16) = p1; }
        if (MODE == 0) {
            float d0[8], d1[8];
#pragma unroll
            for (int i = 0; i < 8; ++i) { d0[i] = kk0[i] * __expf(tot0 - (pre0 + cs0[i])); d1[i] = kk1[i] * __expf(tot1 - (pre1 + cs1[i])); }
            v4u p0, p1;
            p0.x = pk2(d0[0], d0[1]); p0.y = pk2(d0[2], d0[3]); p0.z = pk2(d0[4], d0[5]); p0.w = pk2(d0[6], d0[7]);
            p1.x = pk2(d1[0], d1[1]); p1.y = pk2(d1[2], d1[3]); p1.z = pk2(d1[4], d1[5]); p1.w = pk2(d1[6], d1[7]);
            *(LAS v4u*)(KDT + (2 * kp) * 144 + sg * 16) = p0; *(LAS v4u*)(KDT + (2 * kp + 1) * 144 + sg * 16) = p1;
            if (!meta && sg == 0) *(f32x2*)(W_HGDEC + (size_t)(bh * NCH + c) * HD + 2 * kp) = (f32x2){__expf(tot0), __expf(tot1)};
            if (it + F.G < nit) hg_load<MODE>(nxt, args, ST, it + F.G, tid_, lane_, w);
            __syncthreads();
#pragma unroll 2
            for (int kt = 0; kt < 8; ++kt) {
                f32x4 acc = (f32x4){0.f, 0.f, 0.f, 0.f};
                acc = mma16(acc, KDT + kt * 16 * 144, 144, VT + w * 16 * 144, 144, CH, lane_);
                const int v = 16 * w + r, k0 = 16 * kt + 4 * g;
                if (meta) *(f32x4*)(W_HGMETA + ((size_t)h * HD + v) * HD + k0) = acc;
                else { v2u o; o.x = pk2(acc[0], acc[1]); o.y = pk2(acc[2], acc[3]); *(v2u*)(ST + (((size_t)(bh * NCH + c)) * HD + v) * HD + k0) = o; }
            }
        } else {
#pragma unroll
            for (int i = 0; i < 8; ++i) { const int s = 8 * sg + i;
                const float q0 = bflo(cur.qw[i]), q1 = bfhi(cur.qw[i]), qs0 = q0 * sigm(q0), qs1 = q1 * sigm(q1);
                const float bc0 = pre0 + cs0[i], bc1 = pre1 + cs1[i];
                *(LAS unsigned*)(QDEC + s * 272 + 4 * kp) = pk2(qs0 * __expf(bc0), qs1 * __expf(bc1));
                *(LAS unsigned*)(QD2 + s * 272 + 4 * kp) = pk2(qs0 * __expf(fminf(bc0 - ref0, 80.f)), qs1 * __expf(fminf(bc1 - ref1, 80.f)));
                *(LAS unsigned*)(KD2 + s * 272 + 4 * kp) = pk2(kk0[i] * __expf(fminf(ref0 - bc0, 80.f)), kk1[i] * __expf(fminf(ref1 - bc1, 80.f))); }
#pragma unroll
            for (int i = 0; i < 4; ++i) { const int p = tid_ + 512 * i, row = p >> 4, c16 = p & 15; *(LAS v4u*)(STl + row * 272 + c16 * 16) = cur.stw[i]; }
            if (it + F.G < nit) hg_load<MODE>(nxt, args, ST, it + F.G, tid_, lane_, w);
            __syncthreads();
            { const int tt = w >> 1;
#pragma unroll
              for (int e = 0; e < 2; ++e) { const int st = 2 * (w & 1) + e; f32x4 acc = (f32x4){0.f, 0.f, 0.f, 0.f};
                  if (st <= tt) acc = mma16(acc, KD2 + st * 16 * 272, 272, QD2 + tt * 16 * 272, 272, HD, lane_);
                  const int t = 16 * tt + r, s0 = 16 * st + 4 * g;
#pragma unroll
                  for (int j = 0; j < 4; ++j) if (s0 + j > t) acc[j] = 0.f;
                  v2u o; o.x = pk2(acc[0], acc[1]); o.y = pk2(acc[2], acc[3]); *(LAS v2u*)(PB + t * 144 + s0 * 2) = o; } }
            __syncthreads();
            f32x4 o4[4];
#pragma unroll
            for (int tt = 0; tt < 4; ++tt) { f32x4 acc = (f32x4){0.f, 0.f, 0.f, 0.f};
                acc = mma16(acc, STl + w * 16 * 272, 272, QDEC + tt * 16 * 272, 272, HD, lane_);
                acc = mma16(acc, VT + w * 16 * 144, 144, PB + tt * 16 * 144, 144, CH, lane_);
                o4[tt] = acc;
                float q = (acc[0] * acc[0] + acc[1] * acc[1]) + (acc[2] * acc[2] + acc[3] * acc[3]);
                q += __shfl_xor(q, 16); q += __shfl_xor(q, 32);
                if (g == 0) SSQ[(16 * tt + r) * 8 + w] = q; }
            __syncthreads();
            const f32x4 ng = *(const f32x4*)(A_hg_norm_g + h * HD + 16 * w + 4 * g);
#pragma unroll
            for (int tt = 0; tt < 4; ++tt) { const int t = 16 * tt + r;
                const f32x4 sa = *(const LAS f32x4*)(SSQ + t * 8), sb = *(const LAS f32x4*)(SSQ + t * 8 + 4);
                const float rs = __builtin_amdgcn_rsqf(((sa[0] + sa[1]) + (sa[2] + sa[3]) + (sb[0] + sb[1]) + (sb[2] + sb[3])) * (1.0f / HD) + EPS);
                v2u* op = (v2u*)(W_SLAB(SL_OG) + (size_t)(b * SEQ + c * CH + t) * DM + h * HD + 16 * w + 4 * g);
                const v2u ow = cur.ogw[tt]; const float g0 = bflo(ow.x), g1 = bfhi(ow.x), g2 = bflo(ow.y), g3 = bfhi(ow.y);
                v2u y; y.x = pk2(o4[tt][0] * rs * ng[0] * (g0 * sigm(g0)), o4[tt][1] * rs * ng[1] * (g1 * sigm(g1)));
                y.y = pk2(o4[tt][2] * rs * ng[2] * (g2 * sigm(g2)), o4[tt][3] * rs * ng[3] * (g3 * sigm(g3)));
                if (DUMMY) *(v2u*)((bf16*)(args.ws + WS_END) + ((((size_t)(b * SEQ + c * CH + t) * DM + h * HD + 16 * w + 4 * g)) & (size_t)(4 * MiB - 1))) = y; else *op = y; }
        }
#pragma unroll
        for (int i = 0; i < 8; ++i) { cur.fw[i] = nxt.fw[i]; cur.vw[i] = nxt.vw[i]; if (MODE == 1) cur.qw[i] = nxt.qw[i]; }
        if (MODE == 1) {
#pragma unroll
            for (int i = 0; i < 4; ++i) { cur.stw[i] = nxt.stw[i]; cur.ogw[i] = nxt.ogw[i]; } }
    }
}
__device__ __forceinline__ void hg_carry(Frame& F, const Args& args, bf16* ST) {
    const int lane_ = lane_now(), tid_ = F.wave * 64 + lane_; (void)tid_;
    for (int gid = F.vcu * NWAVES * 64 + tid_; gid < BATCH * NH * HD * (HD / 8); gid += F.G * NWAVES * 64) {
        const int k8 = gid & 15, v = (gid >> 4) & 127, bh = gid >> 11, h = bh & 15;
        float S[8];
        { const f32x4 a = *(const f32x4*)(W_HGMETA + ((size_t)h * HD + v) * HD + 8 * k8), b2 = *(const f32x4*)(W_HGMETA + ((size_t)h * HD + v) * HD + 8 * k8 + 4);
          S[0] = a[0]; S[1] = a[1]; S[2] = a[2]; S[3] = a[3]; S[4] = b2[0]; S[5] = b2[1]; S[6] = b2[2]; S[7] = b2[3]; }
        v4u* p0 = (v4u*)(ST + (((size_t)(bh * NCH)) * HD + v) * HD + 8 * k8);
        const f32x4* d0 = (const f32x4*)(W_HGDEC + (size_t)(bh * NCH) * HD + 8 * k8);
        for (int c0 = 0; c0 < NCH; c0 += 8) {
            v4u d[8]; f32x4 da[8], db[8];
#pragma unroll
            for (int i = 0; i < 8; ++i) { d[i] = p0[(size_t)(c0 + i) * 2048]; da[i] = d0[(c0 + i) * 32]; db[i] = d0[(c0 + i) * 32 + 1]; }
#pragma unroll
            for (int i = 0; i < 8; ++i) {
                v4u o; o.x = pk2(S[0], S[1]); o.y = pk2(S[2], S[3]); o.z = pk2(S[4], S[5]); o.w = pk2(S[6], S[7]); p0[(size_t)(c0 + i) * 2048] = o;
                S[0] = da[i][0] * S[0] + bflo(d[i].x); S[1] = da[i][1] * S[1] + bfhi(d[i].x); S[2] = da[i][2] * S[2] + bflo(d[i].y); S[3] = da[i][3] * S[3] + bfhi(d[i].y);
                S[4] = db[i][0] * S[4] + bflo(d[i].z); S[5] = db[i][1] * S[5] + bfhi(d[i].z); S[6] = db[i][2] * S[6] + bflo(d[i].w); S[7] = db[i][3] * S[7] + bfhi(d[i].w);
            }
        }
    }
}

__device__ __forceinline__ void p3_convert_uv(Frame& F, const Args& args) {
    const int lane_ = lane_now(), tid_ = F.wave * 64 + lane_; (void)tid_;
    const int gw = F.vcu * NWAVES + F.wave, NGW = F.G * NWAVES, lane = lane_;
    unsigned char* U8 = (unsigned char*)W_SLAB(SL_UB); unsigned char* V8 = (unsigned char*)W_SLAB(SL_VB);
    for (int it = gw; it < 2 * NEXP; it += NGW) {
        const bool isv = it >= NEXP; const int e = isv ? it - NEXP : it;
        const float* src = (isv ? A_peer_v : A_peer_u) + (size_t)e * DM;
        f32x4 a[8];
        { LAS f32x4* T = (LAS f32x4*)(F.lds + F.wave * 8192);
          f32x4 raw[8];
#pragma unroll
          for (int j = 0; j < 8; ++j) raw[j] = *((const f32x4*)src + lane + 64 * j);
#pragma unroll
          for (int j = 0; j < 8; ++j) { const int c = lane + 64 * j; T[c ^ ((c >> 4) & 3)] = raw[j]; }
#pragma unroll
          for (int q = 0; q < 4; ++q) { const int c0 = 4 * lane + q, c1 = 256 + 4 * lane + q; a[q] = T[c0 ^ ((c0 >> 4) & 3)]; a[4 + q] = T[c1 ^ ((c1 >> 4) & 3)]; } }
        if (!isv) {
#pragma unroll
            for (int q = 0; q < 4; ++q) { a[q] = a[q] * *(const f32x4*)(A_ln2_g + 16 * lane + 4 * q); a[4 + q] = a[4 + q] * *(const f32x4*)(A_ln2_g + 1024 + 16 * lane + 4 * q); }
        }
        float mx = 0.f;
#pragma unroll
        for (int q = 0; q < 8; ++q) mx = fmaxf(mx, fmaxf(fmaxf(fabsf(a[q][0]), fabsf(a[q][1])), fmaxf(fabsf(a[q][2]), fabsf(a[q][3]))));
        mx = wave_max(mx);
        const float sc = mx > 0.f ? 256.0f / mx : 0.f;
        v4u o0, o1;
#pragma unroll
        for (int q = 0; q < 4; ++q) {
            int w0 = __builtin_amdgcn_cvt_pk_fp8_f32(a[q][0] * sc, a[q][1] * sc, 0, false); w0 = __builtin_amdgcn_cvt_pk_fp8_f32(a[q][2] * sc, a[q][3] * sc, w0, true);
            int w1 = __builtin_amdgcn_cvt_pk_fp8_f32(a[4 + q][0] * sc, a[4 + q][1] * sc, 0, false); w1 = __builtin_amdgcn_cvt_pk_fp8_f32(a[4 + q][2] * sc, a[4 + q][3] * sc, w1, true);
            o0[q] = (unsigned)w0; o1[q] = (unsigned)w1; }
        unsigned char* dst = (isv ? V8 : U8) + (size_t)e * DM + 16 * lane;
        *(v4u*)dst = o0; *(v4u*)(dst + 1024) = o1;
        if (lane == 0) W_PSC[it] = mx * (1.0f / 256.0f);
    }
}

#define CEU(x, y) do { const unsigned _h = (x) > (y) ? (x) : (y), _l = (x) > (y) ? (y) : (x); (x) = _h; (y) = _l; } while (0)
#define CEP(vx, ix, vy, iy) do { const bool _s = (vy) > (vx); const float _hv = _s ? (vy) : (vx), _lv = _s ? (vx) : (vy); const int _hi = _s ? (iy) : (ix), _li = _s ? (ix) : (iy); (vx) = _hv; (vy) = _lv; (ix) = _hi; (iy) = _li; } while (0)
#define SEL4(g, x0, x1, x2, x3) (((g) & 2) ? (((g) & 1) ? (x3) : (x2)) : (((g) & 1) ? (x1) : (x0)))
__device__ __forceinline__ unsigned sel_key(float f, int idx) { const unsigned u = __float_as_uint(f); const unsigned k = u ^ ((unsigned)((int)u >> 31) | 0x80000000u); return (k & ~127u) | (unsigned)idx; }
__device__ __forceinline__ float sel_val(unsigned k) { const unsigned u = k & ~127u; return __uint_as_float(u ^ (~(unsigned)((int)u >> 31) | 0x80000000u)); }
__device__ __forceinline__ void sel_top16(unsigned (&a)[32], unsigned (&t)[16]) {
    CEU(a[0], a[1]);
    CEU(a[3], a[2]);
    CEU(a[4], a[5]);
    CEU(a[7], a[6]);
    CEU(a[8], a[9]);
    CEU(a[11], a[10]);
    CEU(a[12], a[13]);
    CEU(a[15], a[14]);
    CEU(a[0], a[2]);
    CEU(a[1], a[3]);
    CEU(a[6], a[4]);
    CEU(a[7], a[5]);
    CEU(a[8], a[10]);
    CEU(a[9], a[11]);
    CEU(a[14], a[12]);
    CEU(a[15], a[13]);
    CEU(a[0], a[1]);
    CEU(a[2], a[3]);
    CEU(a[5], a[4]);
    CEU(a[7], a[6]);
    CEU(a[8], a[9]);
    CEU(a[10], a[11]);
    CEU(a[13], a[12]);
    CEU(a[15], a[14]);
    CEU(a[0], a[4]);
    CEU(a[1], a[5]);
    CEU(a[2], a[6]);
    CEU(a[3], a[7]);
    CEU(a[12], a[8]);
    CEU(a[13], a[9]);
    CEU(a[14], a[10]);
    CEU(a[15], a[11]);
    CEU(a[0], a[2]);
    CEU(a[1], a[3]);
    CEU(a[4], a[6]);
    CEU(a[5], a[7]);
    CEU(a[10], a[8]);
    CEU(a[11], a[9]);
    CEU(a[14], a[12]);
    CEU(a[15], a[13]);
    CEU(a[0], a[1]);
    CEU(a[2], a[3]);
    CEU(a[4], a[5]);
    CEU(a[6], a[7]);
    CEU(a[9], a[8]);
    CEU(a[11], a[10]);
    CEU(a[13], a[12]);
    CEU(a[15], a[14]);
    CEU(a[0], a[8]);
    CEU(a[1], a[9]);
    CEU(a[2], a[10]);
    CEU(a[3], a[11]);
    CEU(a[4], a[12]);
    CEU(a[5], a[13]);
    CEU(a[6], a[14]);
    CEU(a[7], a[15]);
    CEU(a[0], a[4]);
    CEU(a[1], a[5]);
    CEU(a[2], a[6]);
    CEU(a[3], a[7]);
    CEU(a[8], a[12]);
    CEU(a[9], a[13]);
    CEU(a[10], a[14]);
    CEU(a[11], a[15]);
    CEU(a[0], a[2]);
    CEU(a[1], a[3]);
    CEU(a[4], a[6]);
    CEU(a[5], a[7]);
    CEU(a[8], a[10]);
    CEU(a[9], a[11]);
    CEU(a[12], a[14]);
    CEU(a[13], a[15]);
    CEU(a[0], a[1]);
    CEU(a[2], a[3]);
    CEU(a[4], a[5]);
    CEU(a[6], a[7]);
    CEU(a[8], a[9]);
    CEU(a[10], a[11]);
    CEU(a[12], a[13]);
    CEU(a[14], a[15]);
    CEU(a[16], a[17]);
    CEU(a[19], a[18]);
    CEU(a[20], a[21]);
    CEU(a[23], a[22]);
    CEU(a[24], a[25]);
    CEU(a[27], a[26]);
    CEU(a[28], a[29]);
    CEU(a[31], a[30]);
    CEU(a[16], a[18]);
    CEU(a[17], a[19]);
    CEU(a[22], a[20]);
    CEU(a[23], a[21]);
    CEU(a[24], a[26]);
    CEU(a[25], a[27]);
    CEU(a[30], a[28]);
    CEU(a[31], a[29]);
    CEU(a[16], a[17]);
    CEU(a[18], a[19]);
    CEU(a[21], a[20]);
    CEU(a[23], a[22]);
    CEU(a[24], a[25]);
    CEU(a[26], a[27]);
    CEU(a[29], a[28]);
    CEU(a[31], a[30]);
    CEU(a[16], a[20]);
    CEU(a[17], a[21]);
    CEU(a[18], a[22]);
    CEU(a[19], a[23]);
    CEU(a[28], a[24]);
    CEU(a[29], a[25]);
    CEU(a[30], a[26]);
    CEU(a[31], a[27]);
    CEU(a[16], a[18]);
    CEU(a[17], a[19]);
    CEU(a[20], a[22]);
    CEU(a[21], a[23]);
    CEU(a[26], a[24]);
    CEU(a[27], a[25]);
    CEU(a[30], a[28]);
    CEU(a[31], a[29]);
    CEU(a[16], a[17]);
    CEU(a[18], a[19]);
    CEU(a[20], a[21]);
    CEU(a[22], a[23]);
    CEU(a[25], a[24]);
    CEU(a[27], a[26]);
    CEU(a[29], a[28]);
    CEU(a[31], a[30]);
    CEU(a[16], a[24]);
    CEU(a[17], a[25]);
    CEU(a[18], a[26]);
    CEU(a[19], a[27]);
    CEU(a[20], a[28]);
    CEU(a[21], a[29]);
    CEU(a[22], a[30]);
    CEU(a[23], a[31]);
    CEU(a[16], a[20]);
    CEU(a[17], a[21]);
    CEU(a[18], a[22]);
    CEU(a[19], a[23]);
    CEU(a[24], a[28]);
    CEU(a[25], a[29]);
    CEU(a[26], a[30]);
    CEU(a[27], a[31]);
    CEU(a[16], a[18]);
    CEU(a[17], a[19]);
    CEU(a[20], a[22]);
    CEU(a[21], a[23]);
    CEU(a[24], a[26]);
    CEU(a[25], a[27]);
    CEU(a[28], a[30]);
    CEU(a[29], a[31]);
    CEU(a[16], a[17]);
    CEU(a[18], a[19]);
    CEU(a[20], a[21]);
    CEU(a[22], a[23]);
    CEU(a[24], a[25]);
    CEU(a[26], a[27]);
    CEU(a[28], a[29]);
    CEU(a[30], a[31]);
    t[0] = a[0] > a[31] ? a[0] : a[31];
    t[1] = a[1] > a[30] ? a[1] : a[30];
    t[2] = a[2] > a[29] ? a[2] : a[29];
    t[3] = a[3] > a[28] ? a[3] : a[28];
    t[4] = a[4] > a[27] ? a[4] : a[27];
    t[5] = a[5] > a[26] ? a[5] : a[26];
    t[6] = a[6] > a[25] ? a[6] : a[25];
    t[7] = a[7] > a[24] ? a[7] : a[24];
    t[8] = a[8] > a[23] ? a[8] : a[23];
    t[9] = a[9] > a[22] ? a[9] : a[22];
    t[10] = a[10] > a[21] ? a[10] : a[21];
    t[11] = a[11] > a[20] ? a[11] : a[20];
    t[12] = a[12] > a[19] ? a[12] : a[19];
    t[13] = a[13] > a[18] ? a[13] : a[18];
    t[14] = a[14] > a[17] ? a[14] : a[17];
    t[15] = a[15] > a[16] ? a[15] : a[16];
    CEU(t[0], t[8]);
    CEU(t[1], t[9]);
    CEU(t[2], t[10]);
    CEU(t[3], t[11]);
    CEU(t[4], t[12]);
    CEU(t[5], t[13]);
    CEU(t[6], t[14]);
    CEU(t[7], t[15]);
    CEU(t[0], t[4]);
    CEU(t[1], t[5]);
    CEU(t[2], t[6]);
    CEU(t[3], t[7]);
    CEU(t[8], t[12]);
    CEU(t[9], t[13]);
    CEU(t[10], t[14]);
    CEU(t[11], t[15]);
    CEU(t[0], t[2]);
    CEU(t[1], t[3]);
    CEU(t[4], t[6]);
    CEU(t[5], t[7]);
    CEU(t[8], t[10]);
    CEU(t[9], t[11]);
    CEU(t[12], t[14]);
    CEU(t[13], t[15]);
    CEU(t[0], t[1]);
    CEU(t[2], t[3]);
    CEU(t[4], t[5]);
    CEU(t[6], t[7]);
    CEU(t[8], t[9]);
    CEU(t[10], t[11]);
    CEU(t[12], t[13]);
    CEU(t[14], t[15]);
    { unsigned o[16];
      o[0] = (unsigned)__shfl_xor((int)t[15], 16);
      o[1] = (unsigned)__shfl_xor((int)t[14], 16);
      o[2] = (unsigned)__shfl_xor((int)t[13], 16);
      o[3] = (unsigned)__shfl_xor((int)t[12], 16);
      o[4] = (unsigned)__shfl_xor((int)t[11], 16);
      o[5] = (unsigned)__shfl_xor((int)t[10], 16);
      o[6] = (unsigned)__shfl_xor((int)t[9], 16);
      o[7] = (unsigned)__shfl_xor((int)t[8], 16);
      o[8] = (unsigned)__shfl_xor((int)t[7], 16);
      o[9] = (unsigned)__shfl_xor((int)t[6], 16);
      o[10] = (unsigned)__shfl_xor((int)t[5], 16);
      o[11] = (unsigned)__shfl_xor((int)t[4], 16);
      o[12] = (unsigned)__shfl_xor((int)t[3], 16);
      o[13] = (unsigned)__shfl_xor((int)t[2], 16);
      o[14] = (unsigned)__shfl_xor((int)t[1], 16);
      o[15] = (unsigned)__shfl_xor((int)t[0], 16);
      t[0] = t[0] > o[0] ? t[0] : o[0];
      t[1] = t[1] > o[1] ? t[1] : o[1];
      t[2] = t[2] > o[2] ? t[2] : o[2];
      t[3] = t[3] > o[3] ? t[3] : o[3];
      t[4] = t[4] > o[4] ? t[4] : o[4];
      t[5] = t[5] > o[5] ? t[5] : o[5];
      t[6] = t[6] > o[6] ? t[6] : o[6];
      t[7] = t[7] > o[7] ? t[7] : o[7];
      t[8] = t[8] > o[8] ? t[8] : o[8];
      t[9] = t[9] > o[9] ? t[9] : o[9];
      t[10] = t[10] > o[10] ? t[10] : o[10];
      t[11] = t[11] > o[11] ? t[11] : o[11];
      t[12] = t[12] > o[12] ? t[12] : o[12];
      t[13] = t[13] > o[13] ? t[13] : o[13];
      t[14] = t[14] > o[14] ? t[14] : o[14];
      t[15] = t[15] > o[15] ? t[15] : o[15];
    }
    CEU(t[0], t[8]);
    CEU(t[1], t[9]);
    CEU(t[2], t[10]);
    CEU(t[3], t[11]);
    CEU(t[4], t[12]);
    CEU(t[5], t[13]);
    CEU(t[6], t[14]);
    CEU(t[7], t[15]);
    CEU(t[0], t[4]);
    CEU(t[1], t[5]);
    CEU(t[2], t[6]);
    CEU(t[3], t[7]);
    CEU(t[8], t[12]);
    CEU(t[9], t[13]);
    CEU(t[10], t[14]);
    CEU(t[11], t[15]);
    CEU(t[0], t[2]);
    CEU(t[1], t[3]);
    CEU(t[4], t[6]);
    CEU(t[5], t[7]);
    CEU(t[8], t[10]);
    CEU(t[9], t[11]);
    CEU(t[12], t[14]);
    CEU(t[13], t[15]);
    CEU(t[0], t[1]);
    CEU(t[2], t[3]);
    CEU(t[4], t[5]);
    CEU(t[6], t[7]);
    CEU(t[8], t[9]);
    CEU(t[10], t[11]);
    CEU(t[12], t[13]);
    CEU(t[14], t[15]);
    { unsigned o[16];
      o[0] = (unsigned)__shfl_xor((int)t[15], 32);
      o[1] = (unsigned)__shfl_xor((int)t[14], 32);
      o[2] = (unsigned)__shfl_xor((int)t[13], 32);
      o[3] = (unsigned)__shfl_xor((int)t[12], 32);
      o[4] = (unsigned)__shfl_xor((int)t[11], 32);
      o[5] = (unsigned)__shfl_xor((int)t[10], 32);
      o[6] = (unsigned)__shfl_xor((int)t[9], 32);
      o[7] = (unsigned)__shfl_xor((int)t[8], 32);
      o[8] = (unsigned)__shfl_xor((int)t[7], 32);
      o[9] = (unsigned)__shfl_xor((int)t[6], 32);
      o[10] = (unsigned)__shfl_xor((int)t[5], 32);
      o[11] = (unsigned)__shfl_xor((int)t[4], 32);
      o[12] = (unsigned)__shfl_xor((int)t[3], 32);
      o[13] = (unsigned)__shfl_xor((int)t[2], 32);
      o[14] = (unsigned)__shfl_xor((int)t[1], 32);
      o[15] = (unsigned)__shfl_xor((int)t[0], 32);
      t[0] = t[0] > o[0] ? t[0] : o[0];
      t[1] = t[1] > o[1] ? t[1] : o[1];
      t[2] = t[2] > o[2] ? t[2] : o[2];
      t[3] = t[3] > o[3] ? t[3] : o[3];
      t[4] = t[4] > o[4] ? t[4] : o[4];
      t[5] = t[5] > o[5] ? t[5] : o[5];
      t[6] = t[6] > o[6] ? t[6] : o[6];
      t[7] = t[7] > o[7] ? t[7] : o[7];
      t[8] = t[8] > o[8] ? t[8] : o[8];
      t[9] = t[9] > o[9] ? t[9] : o[9];
      t[10] = t[10] > o[10] ? t[10] : o[10];
      t[11] = t[11] > o[11] ? t[11] : o[11];
      t[12] = t[12] > o[12] ? t[12] : o[12];
      t[13] = t[13] > o[13] ? t[13] : o[13];
      t[14] = t[14] > o[14] ? t[14] : o[14];
      t[15] = t[15] > o[15] ? t[15] : o[15];
    }
    CEU(t[0], t[8]);
    CEU(t[1], t[9]);
    CEU(t[2], t[10]);
    CEU(t[3], t[11]);
    CEU(t[4], t[12]);
    CEU(t[5], t[13]);
    CEU(t[6], t[14]);
    CEU(t[7], t[15]);
    CEU(t[0], t[4]);
    CEU(t[1], t[5]);
    CEU(t[2], t[6]);
    CEU(t[3], t[7]);
    CEU(t[8], t[12]);
    CEU(t[9], t[13]);
    CEU(t[10], t[14]);
    CEU(t[11], t[15]);
    CEU(t[0], t[2]);
    CEU(t[1], t[3]);
    CEU(t[4], t[6]);
    CEU(t[5], t[7]);
    CEU(t[8], t[10]);
    CEU(t[9], t[11]);
    CEU(t[12], t[14]);
    CEU(t[13], t[15]);
    CEU(t[0], t[1]);
    CEU(t[2], t[3]);
    CEU(t[4], t[5]);
    CEU(t[6], t[7]);
    CEU(t[8], t[9]);
    CEU(t[10], t[11]);
    CEU(t[12], t[13]);
    CEU(t[14], t[15]);
}
__device__ __forceinline__ void sel_phase(Frame& F, const Args& args) {
    const int lane_ = lane_now(), tid_ = F.wave * 64 + lane_; (void)tid_;
    LAS unsigned char* KL = F.lds;
    const int h = F.vcu & 7, r = lane_ & 15, g = lane_ >> 4;
    unsigned short* SELI = (unsigned short*)W_SLAB(SL_SEL); float* SELG = (float*)(W_SLAB(SL_SEL)) + (size_t)M * NSEL;
    { const v4u* gk = (const v4u*)(W_KEYS + (size_t)h * 2 * NKEY * 128);
#pragma unroll
      for (int i = 0; i < 8; ++i) { const int p = tid_ + 512 * i, row = p >> 4, c16 = p & 15; *(LAS v4u*)(KL + row * 272 + c16 * 16) = gk[p]; } }
    __syncthreads();
    const int njob = M / 16, jstride = (F.G >> 3) * NWAVES;
    const int job0 = (F.vcu >> 3) * NWAVES + F.wave;
    bf16x8 bqn[8];
    if (job0 < njob) { const bf16* qp = W_SLAB(SL_QP) + (size_t)(job0 * 16 + r) * DM + h * 256 + 8 * g;
#pragma unroll
        for (int i = 0; i < 8; ++i) bqn[i] = *(const bf16x8*)(qp + 32 * i); }
    for (int job = job0; job < njob; job += jstride) {
        const int tok = job * 16 + r;
        unsigned ta[16], tb[16];
        bf16x8 bqc[8];
#pragma unroll
        for (int i = 0; i < 8; ++i) bqc[i] = bqn[i];
        if (job + jstride < njob) { const bf16* qp = W_SLAB(SL_QP) + (size_t)((job + jstride) * 16 + r) * DM + h * 256 + 8 * g;
#pragma unroll
            for (int i = 0; i < 8; ++i) bqn[i] = *(const bf16x8*)(qp + 32 * i); }
#pragma unroll
        for (int pp = 0; pp < 2; ++pp) {
            bf16x8 bq[4];
#pragma unroll
            for (int ks = 0; ks < 4; ++ks) bq[ks] = bqc[4 * pp + ks];
            unsigned a[32];
#pragma unroll
            for (int kt = 0; kt < 8; ++kt) { f32x4 acc = (f32x4){0.f, 0.f, 0.f, 0.f};
#pragma unroll
                for (int ks = 0; ks < 4; ++ks) { const bf16x8 av = *(const LAS bf16x8*)(KL + (pp * 128 + kt * 16 + r) * 272 + ks * 64 + g * 16); acc = __builtin_amdgcn_mfma_f32_16x16x32_bf16(av, bq[ks], acc, 0, 0, 0); }
#pragma unroll
                for (int j = 0; j < 4; ++j) a[kt * 4 + j] = sel_key(acc[j], kt * 16 + 4 * g + j);
                __builtin_amdgcn_sched_barrier(0); }
            if (pp == 0) sel_top16(a, ta); else sel_top16(a, tb);
        }
        float va[16], vb[16]; int ia[16], ib[16];
#pragma unroll
        for (int i = 0; i < 16; ++i) { va[i] = sel_val(ta[i]); vb[i] = sel_val(tb[i]); ia[i] = (int)(ta[i] & 127u); ib[i] = (int)(tb[i] & 127u); }
        float cv[16]; int ci[16];
        cv[0] = va[0] + SEL4(g, vb[0], vb[1], vb[2], vb[3]); ci[0] = ia[0] * NKEY + SEL4(g, ib[0], ib[1], ib[2], ib[3]);
        cv[1] = va[0] + SEL4(g, vb[4], vb[5], vb[6], vb[7]); ci[1] = ia[0] * NKEY + SEL4(g, ib[4], ib[5], ib[6], ib[7]);
        cv[2] = va[0] + SEL4(g, vb[8], vb[9], vb[10], vb[11]); ci[2] = ia[0] * NKEY + SEL4(g, ib[8], ib[9], ib[10], ib[11]);
        cv[3] = va[0] + SEL4(g, vb[12], vb[13], vb[14], vb[15]); ci[3] = ia[0] * NKEY + SEL4(g, ib[12], ib[13], ib[14], ib[15]);
        cv[4] = va[1] + SEL4(g, vb[0], vb[1], vb[2], vb[3]); ci[4] = ia[1] * NKEY + SEL4(g, ib[0], ib[1], ib[2], ib[3]);
        cv[5] = va[1] + SEL4(g, vb[4], vb[5], vb[6], vb[7]); ci[5] = ia[1] * NKEY + SEL4(g, ib[4], ib[5], ib[6], ib[7]);
        cv[6] = va[2] + SEL4(g, vb[0], vb[1], vb[2], vb[3]); ci[6] = ia[2] * NKEY + SEL4(g, ib[0], ib[1], ib[2], ib[3]);
        cv[7] = SEL4(g, va[2], va[3], va[3], va[3]) + SEL4(g, vb[4], vb[0], vb[1], vb[2]); ci[7] = SEL4(g, ia[2], ia[3], ia[3], ia[3]) * NKEY + SEL4(g, ib[4], ib[0], ib[1], ib[2]);
        cv[8] = SEL4(g, va[3], va[4], va[4], va[4]) + SEL4(g, vb[3], vb[0], vb[1], vb[2]); ci[8] = SEL4(g, ia[3], ia[4], ia[4], ia[4]) * NKEY + SEL4(g, ib[3], ib[0], ib[1], ib[2]);
        cv[9] = SEL4(g, va[5], va[5], va[6], va[6]) + SEL4(g, vb[0], vb[1], vb[0], vb[1]); ci[9] = SEL4(g, ia[5], ia[5], ia[6], ia[6]) * NKEY + SEL4(g, ib[0], ib[1], ib[0], ib[1]);
        cv[10] = SEL4(g, va[7], va[7], va[8], va[9]) + SEL4(g, vb[0], vb[1], vb[0], vb[0]); ci[10] = SEL4(g, ia[7], ia[7], ia[8], ia[9]) * NKEY + SEL4(g, ib[0], ib[1], ib[0], ib[0]);
        cv[11] = SEL4(g, va[10], va[11], va[12], va[13]) + vb[0]; ci[11] = SEL4(g, ia[10], ia[11], ia[12], ia[13]) * NKEY + ib[0];
        { const float sa = SEL4(g, va[14], va[15], 0.f, 0.f), sb = SEL4(g, vb[0], vb[0], 0.f, 0.f); const bool pad = g == 2 || g == 3;
          cv[12] = pad ? -3.0e38f : sa + sb; ci[12] = SEL4(g, ia[14], ia[15], 0, 0) * NKEY + SEL4(g, ib[0], ib[0], 0, 0); }
        cv[13] = -3.0e38f; ci[13] = 0;
        cv[14] = -3.0e38f; ci[14] = 0;
        cv[15] = -3.0e38f; ci[15] = 0;
        CEP(cv[0], ci[0], cv[1], ci[1]);
        CEP(cv[3], ci[3], cv[2], ci[2]);
        CEP(cv[4], ci[4], cv[5], ci[5]);
        CEP(cv[7], ci[7], cv[6], ci[6]);
        CEP(cv[8], ci[8], cv[9], ci[9]);
        CEP(cv[11], ci[11], cv[10], ci[10]);
        CEP(cv[12], ci[12], cv[13], ci[13]);
        CEP(cv[15], ci[15], cv[14], ci[14]);
        CEP(cv[0], ci[0], cv[2], ci[2]);
        CEP(cv[1], ci[1], cv[3], ci[3]);
        CEP(cv[6], ci[6], cv[4], ci[4]);
        CEP(cv[7], ci[7], cv[5], ci[5]);
        CEP(cv[8], ci[8], cv[10], ci[10]);
        CEP(cv[9], ci[9], cv[11], ci[11]);
        CEP(cv[14], ci[14], cv[12], ci[12]);
        CEP(cv[15], ci[15], cv[13], ci[13]);
        CEP(cv[0], ci[0], cv[1], ci[1]);
        CEP(cv[2], ci[2], cv[3], ci[3]);
        CEP(cv[5], ci[5], cv[4], ci[4]);
        CEP(cv[7], ci[7], cv[6], ci[6]);
        CEP(cv[8], ci[8], cv[9], ci[9]);
        CEP(cv[10], ci[10], cv[11], ci[11]);
        CEP(cv[13], ci[13], cv[12], ci[12]);
        CEP(cv[15], ci[15], cv[14], ci[14]);
        CEP(cv[0], ci[0], cv[4], ci[4]);
        CEP(cv[1], ci[1], cv[5], ci[5]);
        CEP(cv[2], ci[2], cv[6], ci[6]);
        CEP(cv[3], ci[3], cv[7], ci[7]);
        CEP(cv[12], ci[12], cv[8], ci[8]);
        CEP(cv[13], ci[13], cv[9], ci[9]);
        CEP(cv[14], ci[14], cv[10], ci[10]);
        CEP(cv[15], ci[15], cv[11], ci[11]);
        CEP(cv[0], ci[0], cv[2], ci[2]);
        CEP(cv[1], ci[1], cv[3], ci[3]);
        CEP(cv[4], ci[4], cv[6], ci[6]);
        CEP(cv[5], ci[5], cv[7], ci[7]);
        CEP(cv[10], ci[10], cv[8], ci[8]);
        CEP(cv[11], ci[11], cv[9], ci[9]);
        CEP(cv[14], ci[14], cv[12], ci[12]);
        CEP(cv[15], ci[15], cv[13], ci[13]);
        CEP(cv[0], ci[0], cv[1], ci[1]);
        CEP(cv[2], ci[2], cv[3], ci[3]);
        CEP(cv[4], ci[4], cv[5], ci[5]);
        CEP(cv[6], ci[6], cv[7], ci[7]);
        CEP(cv[9], ci[9], cv[8], ci[8]);
        CEP(cv[11], ci[11], cv[10], ci[10]);
        CEP(cv[13], ci[13], cv[12], ci[12]);
        CEP(cv[15], ci[15], cv[14], ci[14]);
        CEP(cv[0], ci[0], cv[8], ci[8]);
        CEP(cv[1], ci[1], cv[9], ci[9]);
        CEP(cv[2], ci[2], cv[10], ci[10]);
        CEP(cv[3], ci[3], cv[11], ci[11]);
        CEP(cv[4], ci[4], cv[12], ci[12]);
        CEP(cv[5], ci[5], cv[13], ci[13]);
        CEP(cv[6], ci[6], cv[14], ci[14]);
        CEP(cv[7], ci[7], cv[15], ci[15]);
        CEP(cv[0], ci[0], cv[4], ci[4]);
        CEP(cv[1], ci[1], cv[5], ci[5]);
        CEP(cv[2], ci[2], cv[6], ci[6]);
        CEP(cv[3], ci[3], cv[7], ci[7]);
        CEP(cv[8], ci[8], cv[12], ci[12]);
        CEP(cv[9], ci[9], cv[13], ci[13]);
        CEP(cv[10], ci[10], cv[14], ci[14]);
        CEP(cv[11], ci[11], cv[15], ci[15]);
        CEP(cv[0], ci[0], cv[2], ci[2]);
        CEP(cv[1], ci[1], cv[3], ci[3]);
        CEP(cv[4], ci[4], cv[6], ci[6]);
        CEP(cv[5], ci[5], cv[7], ci[7]);
        CEP(cv[8], ci[8], cv[10], ci[10]);
        CEP(cv[9], ci[9], cv[11], ci[11]);
        CEP(cv[12], ci[12], cv[14], ci[14]);
        CEP(cv[13], ci[13], cv[15], ci[15]);
        CEP(cv[0], ci[0], cv[1], ci[1]);
        CEP(cv[2], ci[2], cv[3], ci[3]);
        CEP(cv[4], ci[4], cv[5], ci[5]);
        CEP(cv[6], ci[6], cv[7], ci[7]);
        CEP(cv[8], ci[8], cv[9], ci[9]);
        CEP(cv[10], ci[10], cv[11], ci[11]);
        CEP(cv[12], ci[12], cv[13], ci[13]);
        CEP(cv[14], ci[14], cv[15], ci[15]);
        { float ov[16]; int oi[16];
          ov[0] = __shfl_xor(cv[15], 16); oi[0] = __shfl_xor(ci[15], 16);
          ov[1] = __shfl_xor(cv[14], 16); oi[1] = __shfl_xor(ci[14], 16);
          ov[2] = __shfl_xor(cv[13], 16); oi[2] = __shfl_xor(ci[13], 16);
          ov[3] = __shfl_xor(cv[12], 16); oi[3] = __shfl_xor(ci[12], 16);
          ov[4] = __shfl_xor(cv[11], 16); oi[4] = __shfl_xor(ci[11], 16);
          ov[5] = __shfl_xor(cv[10], 16); oi[5] = __shfl_xor(ci[10], 16);
          ov[6] = __shfl_xor(cv[9], 16); oi[6] = __shfl_xor(ci[9], 16);
          ov[7] = __shfl_xor(cv[8], 16); oi[7] = __shfl_xor(ci[8], 16);
          ov[8] = __shfl_xor(cv[7], 16); oi[8] = __shfl_xor(ci[7], 16);
          ov[9] = __shfl_xor(cv[6], 16); oi[9] = __shfl_xor(ci[6], 16);
          ov[10] = __shfl_xor(cv[5], 16); oi[10] = __shfl_xor(ci[5], 16);
          ov[11] = __shfl_xor(cv[4], 16); oi[11] = __shfl_xor(ci[4], 16);
          ov[12] = __shfl_xor(cv[3], 16); oi[12] = __shfl_xor(ci[3], 16);
          ov[13] = __shfl_xor(cv[2], 16); oi[13] = __shfl_xor(ci[2], 16);
          ov[14] = __shfl_xor(cv[1], 16); oi[14] = __shfl_xor(ci[1], 16);
          ov[15] = __shfl_xor(cv[0], 16); oi[15] = __shfl_xor(ci[0], 16);
          { const bool s_ = ov[0] > cv[0]; cv[0] = s_ ? ov[0] : cv[0]; ci[0] = s_ ? oi[0] : ci[0]; }
          { const bool s_ = ov[1] > cv[1]; cv[1] = s_ ? ov[1] : cv[1]; ci[1] = s_ ? oi[1] : ci[1]; }
          { const bool s_ = ov[2] > cv[2]; cv[2] = s_ ? ov[2] : cv[2]; ci[2] = s_ ? oi[2] : ci[2]; }
          { const bool s_ = ov[3] > cv[3]; cv[3] = s_ ? ov[3] : cv[3]; ci[3] = s_ ? oi[3] : ci[3]; }
          { const bool s_ = ov[4] > cv[4]; cv[4] = s_ ? ov[4] : cv[4]; ci[4] = s_ ? oi[4] : ci[4]; }
          { const bool s_ = ov[5] > cv[5]; cv[5] = s_ ? ov[5] : cv[5]; ci[5] = s_ ? oi[5] : ci[5]; }
          { const bool s_ = ov[6] > cv[6]; cv[6] = s_ ? ov[6] : cv[6]; ci[6] = s_ ? oi[6] : ci[6]; }
          { const bool s_ = ov[7] > cv[7]; cv[7] = s_ ? ov[7] : cv[7]; ci[7] = s_ ? oi[7] : ci[7]; }
          { const bool s_ = ov[8] > cv[8]; cv[8] = s_ ? ov[8] : cv[8]; ci[8] = s_ ? oi[8] : ci[8]; }
          { const bool s_ = ov[9] > cv[9]; cv[9] = s_ ? ov[9] : cv[9]; ci[9] = s_ ? oi[9] : ci[9]; }
          { const bool s_ = ov[10] > cv[10]; cv[10] = s_ ? ov[10] : cv[10]; ci[10] = s_ ? oi[10] : ci[10]; }
          { const bool s_ = ov[11] > cv[11]; cv[11] = s_ ? ov[11] : cv[11]; ci[11] = s_ ? oi[11] : ci[11]; }
          { const bool s_ = ov[12] > cv[12]; cv[12] = s_ ? ov[12] : cv[12]; ci[12] = s_ ? oi[12] : ci[12]; }
          { const bool s_ = ov[13] > cv[13]; cv[13] = s_ ? ov[13] : cv[13]; ci[13] = s_ ? oi[13] : ci[13]; }
          { const bool s_ = ov[14] > cv[14]; cv[14] = s_ ? ov[14] : cv[14]; ci[14] = s_ ? oi[14] : ci[14]; }
          { const bool s_ = ov[15] > cv[15]; cv[15] = s_ ? ov[15] : cv[15]; ci[15] = s_ ? oi[15] : ci[15]; }
        }
        CEP(cv[0], ci[0], cv[8], ci[8]);
        CEP(cv[1], ci[1], cv[9], ci[9]);
        CEP(cv[2], ci[2], cv[10], ci[10]);
        CEP(cv[3], ci[3], cv[11], ci[11]);
        CEP(cv[4], ci[4], cv[12], ci[12]);
        CEP(cv[5], ci[5], cv[13], ci[13]);
        CEP(cv[6], ci[6], cv[14], ci[14]);
        CEP(cv[7], ci[7], cv[15], ci[15]);
        CEP(cv[0], ci[0], cv[4], ci[4]);
        CEP(cv[1], ci[1], cv[5], ci[5]);
        CEP(cv[2], ci[2], cv[6], ci[6]);
        CEP(cv[3], ci[3], cv[7], ci[7]);
        CEP(cv[8], ci[8], cv[12], ci[12]);
        CEP(cv[9], ci[9], cv[13], ci[13]);
        CEP(cv[10], ci[10], cv[14], ci[14]);
        CEP(cv[11], ci[11], cv[15], ci[15]);
        CEP(cv[0], ci[0], cv[2], ci[2]);
        CEP(cv[1], ci[1], cv[3], ci[3]);
        CEP(cv[4], ci[4], cv[6], ci[6]);
        CEP(cv[5], ci[5], cv[7], ci[7]);
        CEP(cv[8], ci[8], cv[10], ci[10]);
        CEP(cv[9], ci[9], cv[11], ci[11]);
        CEP(cv[12], ci[12], cv[14], ci[14]);
        CEP(cv[13], ci[13], cv[15], ci[15]);
        CEP(cv[0], ci[0], cv[1], ci[1]);
        CEP(cv[2], ci[2], cv[3], ci[3]);
        CEP(cv[4], ci[4], cv[5], ci[5]);
        CEP(cv[6], ci[6], cv[7], ci[7]);
        CEP(cv[8], ci[8], cv[9], ci[9]);
        CEP(cv[10], ci[10], cv[11], ci[11]);
        CEP(cv[12], ci[12], cv[13], ci[13]);
        CEP(cv[14], ci[14], cv[15], ci[15]);
        { float ov[16]; int oi[16];
          ov[0] = __shfl_xor(cv[15], 32); oi[0] = __shfl_xor(ci[15], 32);
          ov[1] = __shfl_xor(cv[14], 32); oi[1] = __shfl_xor(ci[14], 32);
          ov[2] = __shfl_xor(cv[13], 32); oi[2] = __shfl_xor(ci[13], 32);
          ov[3] = __shfl_xor(cv[12], 32); oi[3] = __shfl_xor(ci[12], 32);
          ov[4] = __shfl_xor(cv[11], 32); oi[4] = __shfl_xor(ci[11], 32);
          ov[5] = __shfl_xor(cv[10], 32); oi[5] = __shfl_xor(ci[10], 32);
          ov[6] = __shfl_xor(cv[9], 32); oi[6] = __shfl_xor(ci[9], 32);
          ov[7] = __shfl_xor(cv[8], 32); oi[7] = __shfl_xor(ci[8], 32);
          ov[8] = __shfl_xor(cv[7], 32); oi[8] = __shfl_xor(ci[7], 32);
          ov[9] = __shfl_xor(cv[6], 32); oi[9] = __shfl_xor(ci[6], 32);
          ov[10] = __shfl_xor(cv[5], 32); oi[10] = __shfl_xor(ci[5], 32);
          ov[11] = __shfl_xor(cv[4], 32); oi[11] = __shfl_xor(ci[4], 32);
          ov[12] = __shfl_xor(cv[3], 32); oi[12] = __shfl_xor(ci[3], 32);
          ov[13] = __shfl_xor(cv[2], 32); oi[13] = __shfl_xor(ci[2], 32);
          ov[14] = __shfl_xor(cv[1], 32); oi[14] = __shfl_xor(ci[1], 32);
          ov[15] = __shfl_xor(cv[0], 32); oi[15] = __shfl_xor(ci[0], 32);
          { const bool s_ = ov[0] > cv[0]; cv[0] = s_ ? ov[0] : cv[0]; ci[0] = s_ ? oi[0] : ci[0]; }
          { const bool s_ = ov[1] > cv[1]; cv[1] = s_ ? ov[1] : cv[1]; ci[1] = s_ ? oi[1] : ci[1]; }
          { const bool s_ = ov[2] > cv[2]; cv[2] = s_ ? ov[2] : cv[2]; ci[2] = s_ ? oi[2] : ci[2]; }
          { const bool s_ = ov[3] > cv[3]; cv[3] = s_ ? ov[3] : cv[3]; ci[3] = s_ ? oi[3] : ci[3]; }
          { const bool s_ = ov[4] > cv[4]; cv[4] = s_ ? ov[4] : cv[4]; ci[4] = s_ ? oi[4] : ci[4]; }
          { const bool s_ = ov[5] > cv[5]; cv[5] = s_ ? ov[5] : cv[5]; ci[5] = s_ ? oi[5] : ci[5]; }
          { const bool s_ = ov[6] > cv[6]; cv[6] = s_ ? ov[6] : cv[6]; ci[6] = s_ ? oi[6] : ci[6]; }
          { const bool s_ = ov[7] > cv[7]; cv[7] = s_ ? ov[7] : cv[7]; ci[7] = s_ ? oi[7] : ci[7]; }
          { const bool s_ = ov[8] > cv[8]; cv[8] = s_ ? ov[8] : cv[8]; ci[8] = s_ ? oi[8] : ci[8]; }
          { const bool s_ = ov[9] > cv[9]; cv[9] = s_ ? ov[9] : cv[9]; ci[9] = s_ ? oi[9] : ci[9]; }
          { const bool s_ = ov[10] > cv[10]; cv[10] = s_ ? ov[10] : cv[10]; ci[10] = s_ ? oi[10] : ci[10]; }
          { const bool s_ = ov[11] > cv[11]; cv[11] = s_ ? ov[11] : cv[11]; ci[11] = s_ ? oi[11] : ci[11]; }
          { const bool s_ = ov[12] > cv[12]; cv[12] = s_ ? ov[12] : cv[12]; ci[12] = s_ ? oi[12] : ci[12]; }
          { const bool s_ = ov[13] > cv[13]; cv[13] = s_ ? ov[13] : cv[13]; ci[13] = s_ ? oi[13] : ci[13]; }
          { const bool s_ = ov[14] > cv[14]; cv[14] = s_ ? ov[14] : cv[14]; ci[14] = s_ ? oi[14] : ci[14]; }
          { const bool s_ = ov[15] > cv[15]; cv[15] = s_ ? ov[15] : cv[15]; ci[15] = s_ ? oi[15] : ci[15]; }
        }
        CEP(cv[0], ci[0], cv[8], ci[8]);
        CEP(cv[1], ci[1], cv[9], ci[9]);
        CEP(cv[2], ci[2], cv[10], ci[10]);
        CEP(cv[3], ci[3], cv[11], ci[11]);
        CEP(cv[4], ci[4], cv[12], ci[12]);
        CEP(cv[5], ci[5], cv[13], ci[13]);
        CEP(cv[6], ci[6], cv[14], ci[14]);
        CEP(cv[7], ci[7], cv[15], ci[15]);
        CEP(cv[0], ci[0], cv[4], ci[4]);
        CEP(cv[1], ci[1], cv[5], ci[5]);
        CEP(cv[2], ci[2], cv[6], ci[6]);
        CEP(cv[3], ci[3], cv[7], ci[7]);
        CEP(cv[8], ci[8], cv[12], ci[12]);
        CEP(cv[9], ci[9], cv[13], ci[13]);
        CEP(cv[10], ci[10], cv[14], ci[14]);
        CEP(cv[11], ci[11], cv[15], ci[15]);
        CEP(cv[0], ci[0], cv[2], ci[2]);
        CEP(cv[1], ci[1], cv[3], ci[3]);
        CEP(cv[4], ci[4], cv[6], ci[6]);
        CEP(cv[5], ci[5], cv[7], ci[7]);
        CEP(cv[8], ci[8], cv[10], ci[10]);
        CEP(cv[9], ci[9], cv[11], ci[11]);
        CEP(cv[12], ci[12], cv[14], ci[14]);
        CEP(cv[13], ci[13], cv[15], ci[15]);
        CEP(cv[0], ci[0], cv[1], ci[1]);
        CEP(cv[2], ci[2], cv[3], ci[3]);
        CEP(cv[4], ci[4], cv[5], ci[5]);
        CEP(cv[6], ci[6], cv[7], ci[7]);
        CEP(cv[8], ci[8], cv[9], ci[9]);
        CEP(cv[10], ci[10], cv[11], ci[11]);
        CEP(cv[12], ci[12], cv[13], ci[13]);
        CEP(cv[14], ci[14], cv[15], ci[15]);
        float ex[16], sum = 0.f;
#pragma unroll
        for (int i = 0; i < 16; ++i) { ex[i] = __expf(cv[i] - cv[0]); sum += ex[i]; }
        const float inv = 1.0f / sum;
        v4u oi4; f32x4 og4;
        oi4[0] = (unsigned)SEL4(g, ci[0], ci[4], ci[8], ci[12]); og4[0] = SEL4(g, ex[0], ex[4], ex[8], ex[12]) * inv;
        oi4[1] = (unsigned)SEL4(g, ci[1], ci[5], ci[9], ci[13]); og4[1] = SEL4(g, ex[1], ex[5], ex[9], ex[13]) * inv;
        oi4[2] = (unsigned)SEL4(g, ci[2], ci[6], ci[10], ci[14]); og4[2] = SEL4(g, ex[2], ex[6], ex[10], ex[14]) * inv;
        oi4[3] = (unsigned)SEL4(g, ci[3], ci[7], ci[11], ci[15]); og4[3] = SEL4(g, ex[3], ex[7], ex[11], ex[15]) * inv;
        { v2u o2; o2.x = oi4[0] | (oi4[1] << 16); o2.y = oi4[2] | (oi4[3] << 16); *(v2u*)(SELI + (size_t)tok * NSEL + h * TOPK + 4 * g) = o2; } *(f32x4*)(SELG + (size_t)tok * NSEL + h * TOPK + 4 * g) = og4;
    }
}

constexpr int NSLICE = 16;
struct DotsPre { v4u idv[2]; v4u xw[2]; float rstd; };
struct AxpyPre { v4u idv[2]; f32x2 hv; };
#define SLICE_EID(idv, i) (((idv)[(i) >> 3][((i) >> 1) & 3] >> (16 * ((i) & 1))) & 0xffffu)
__device__ __forceinline__ void dots_pre(DotsPre& P, const Args& args, int tok, int sl, int lane) {
    const int m = lane & 7, sg = lane >> 3;
    const unsigned short* SELI = (const unsigned short*)W_SLAB(SL_SEL);
    P.idv[0] = *(const v4u*)(SELI + (size_t)tok * NSEL + 16 * sg); P.idv[1] = *(const v4u*)(SELI + (size_t)tok * NSEL + 16 * sg + 8);
    const bf16* xp = W_SLAB(SL_H2B) + (size_t)tok * DM + 128 * sl + 16 * m;
    P.xw[0] = *(const v4u*)xp; P.xw[1] = *(const v4u*)(xp + 8);
    P.rstd = W_RSTD2[tok];
}
__device__ __forceinline__ void axpy_pre(AxpyPre& P, const Args& args, int tok, int sl, int lane) {
    const int m = lane & 7, sg = lane >> 3;
    const unsigned short* SELI = (const unsigned short*)W_SLAB(SL_SEL);
    P.idv[0] = *(const v4u*)(SELI + (size_t)tok * NSEL + 16 * sg); P.idv[1] = *(const v4u*)(SELI + (size_t)tok * NSEL + 16 * sg + 8);
    { const unsigned hw = *(const unsigned*)(W_SLAB(SL_H2B) + (size_t)tok * DM + 128 * sl + 16 * m + 2 * sg); P.hv = (f32x2){bflo(hw), bfhi(hw)}; }
}
__device__ __forceinline__ void slice_rows(v4u (&R)[16], const v4u (&idv)[2], const unsigned char* tb) {
#pragma unroll
    for (int i = 0; i < 16; ++i) R[i] = *(const v4u*)(tb + (size_t)SLICE_EID(idv, i) * DM);
}
__device__ __forceinline__ void dots_comp(const v4u (&R)[16], const DotsPre& P, LAS float* acc_row, bool first, int lane) {
    const bool m4 = lane & 4, m2 = lane & 2, m1 = lane & 1;
    const float rstd = P.rstd;
    f32x2 xs[8];
#pragma unroll
    for (int q = 0; q < 2; ++q)
#pragma unroll
        for (int w = 0; w < 4; ++w) xs[4 * q + w] = (f32x2){bflo(P.xw[q][w]) * rstd, bfhi(P.xw[q][w]) * rstd};
    float p[16];
#pragma unroll
    for (int i = 0; i < 16; ++i) { f32x2 d2 = (f32x2){0.f, 0.f};
#pragma unroll
        for (int w = 0; w < 4; ++w) { d2 += xs[2 * w] * __builtin_amdgcn_cvt_pk_f32_fp8((int)R[i][w], false); d2 += xs[2 * w + 1] * __builtin_amdgcn_cvt_pk_f32_fp8((int)R[i][w], true); }
        p[i] = d2.x + d2.y; }
    float qd4[8];
    { const float kp = m4 ? p[8] : p[0], sd = m4 ? p[0] : p[8]; qd4[0] = kp + __shfl_xor(sd, 4); }
    { const float kp = m4 ? p[9] : p[1], sd = m4 ? p[1] : p[9]; qd4[1] = kp + __shfl_xor(sd, 4); }
    { const float kp = m4 ? p[10] : p[2], sd = m4 ? p[2] : p[10]; qd4[2] = kp + __shfl_xor(sd, 4); }
    { const float kp = m4 ? p[11] : p[3], sd = m4 ? p[3] : p[11]; qd4[3] = kp + __shfl_xor(sd, 4); }
    { const float kp = m4 ? p[12] : p[4], sd = m4 ? p[4] : p[12]; qd4[4] = kp + __shfl_xor(sd, 4); }
    { const float kp = m4 ? p[13] : p[5], sd = m4 ? p[5] : p[13]; qd4[5] = kp + __shfl_xor(sd, 4); }
    { const float kp = m4 ? p[14] : p[6], sd = m4 ? p[6] : p[14]; qd4[6] = kp + __shfl_xor(sd, 4); }
    { const float kp = m4 ? p[15] : p[7], sd = m4 ? p[7] : p[15]; qd4[7] = kp + __shfl_xor(sd, 4); }
    float qd2[4];
    { const float kp = m2 ? qd4[4] : qd4[0], sd = m2 ? qd4[0] : qd4[4]; qd2[0] = kp + __shfl_xor(sd, 2); }
    { const float kp = m2 ? qd4[5] : qd4[1], sd = m2 ? qd4[1] : qd4[5]; qd2[1] = kp + __shfl_xor(sd, 2); }
    { const float kp = m2 ? qd4[6] : qd4[2], sd = m2 ? qd4[2] : qd4[6]; qd2[2] = kp + __shfl_xor(sd, 2); }
    { const float kp = m2 ? qd4[7] : qd4[3], sd = m2 ? qd4[3] : qd4[7]; qd2[3] = kp + __shfl_xor(sd, 2); }
    float qd1[2];
    { const float kp = m1 ? qd2[2] : qd2[0], sd = m1 ? qd2[0] : qd2[2]; qd1[0] = kp + __shfl_xor(sd, 1); }
    { const float kp = m1 ? qd2[3] : qd2[1], sd = m1 ? qd2[1] : qd2[3]; qd1[1] = kp + __shfl_xor(sd, 1); }
    LAS f32x2* ap = (LAS f32x2*)(acc_row + 2 * lane);
    f32x2 o = (f32x2){qd1[0], qd1[1]};
    if (!first) o += *ap;
    *ap = o;
}
__device__ __forceinline__ float axpy_comp(const v4u (&R)[16], const AxpyPre& P, const Args& args, const LAS float* coef_row, int tok, int sl, int lane) {
    const int m = lane & 7, sg = lane >> 3;
    const bool s4 = lane & 32, s2 = lane & 16, s1 = lane & 8;
    f32x4 cf[4];
#pragma unroll
    for (int q = 0; q < 4; ++q) cf[q] = *(const LAS f32x4*)(coef_row + 16 * sg + 4 * q);
    f32x2 a2[8];
#pragma unroll
    for (int w = 0; w < 8; ++w) a2[w] = (f32x2){0.f, 0.f};
#pragma unroll
    for (int i = 0; i < 16; ++i) { const float c = cf[i >> 2][i & 3]; const f32x2 c2 = (f32x2){c, c};
#pragma unroll
        for (int w = 0; w < 4; ++w) { a2[2 * w] += c2 * __builtin_amdgcn_cvt_pk_f32_fp8((int)R[i][w], false); a2[2 * w + 1] += c2 * __builtin_amdgcn_cvt_pk_f32_fp8((int)R[i][w], true); } }
    float acc[16];
#pragma unroll
    for (int w = 0; w < 8; ++w) { acc[2 * w] = a2[w].x; acc[2 * w + 1] = a2[w].y; }
    float qv32[8];
    { const float kp = s4 ? acc[8] : acc[0], sd = s4 ? acc[0] : acc[8]; qv32[0] = kp + __shfl_xor(sd, 32); }
    { const float kp = s4 ? acc[9] : acc[1], sd = s4 ? acc[1] : acc[9]; qv32[1] = kp + __shfl_xor(sd, 32); }
    { const float kp = s4 ? acc[10] : acc[2], sd = s4 ? acc[2] : acc[10]; qv32[2] = kp + __shfl_xor(sd, 32); }
    { const float kp = s4 ? acc[11] : acc[3], sd = s4 ? acc[3] : acc[11]; qv32[3] = kp + __shfl_xor(sd, 32); }
    { const float kp = s4 ? acc[12] : acc[4], sd = s4 ? acc[4] : acc[12]; qv32[4] = kp + __shfl_xor(sd, 32); }
    { const float kp = s4 ? acc[13] : acc[5], sd = s4 ? acc[5] : acc[13]; qv32[5] = kp + __shfl_xor(sd, 32); }
    { const float kp = s4 ? acc[14] : acc[6], sd = s4 ? acc[6] : acc[14]; qv32[6] = kp + __shfl_xor(sd, 32); }
    { const float kp = s4 ? acc[15] : acc[7], sd = s4 ? acc[7] : acc[15]; qv32[7] = kp + __shfl_xor(sd, 32); }
    float qv16[4];
    { const float kp = s2 ? qv32[4] : qv32[0], sd = s2 ? qv32[0] : qv32[4]; qv16[0] = kp + __shfl_xor(sd, 16); }
    { const float kp = s2 ? qv32[5] : qv32[1], sd = s2 ? qv32[1] : qv32[5]; qv16[1] = kp + __shfl_xor(sd, 16); }
    { const float kp = s2 ? qv32[6] : qv32[2], sd = s2 ? qv32[2] : qv32[6]; qv16[2] = kp + __shfl_xor(sd, 16); }
    { const float kp = s2 ? qv32[7] : qv32[3], sd = s2 ? qv32[3] : qv32[7]; qv16[3] = kp + __shfl_xor(sd, 16); }
    float qv8[2];
    { const float kp = s1 ? qv16[2] : qv16[0], sd = s1 ? qv16[0] : qv16[2]; qv8[0] = kp + __shfl_xor(sd, 8); }
    { const float kp = s1 ? qv16[3] : qv16[1], sd = s1 ? qv16[1] : qv16[3]; qv8[1] = kp + __shfl_xor(sd, 8); }
    const f32x2 o = (f32x2){P.hv.x + qv8[0], P.hv.y + qv8[1]};
    *(unsigned*)(W_SLAB(SL_ZA) + (size_t)tok * DM + 128 * sl + 16 * m + 2 * sg) = pk2(o.x, o.y);
    return wave_sum(o.x * o.x + o.y * o.y);
}
constexpr int PEER_TPW = 8;
#define PEER_TOK(n) (tokbase + ((n) & (PEER_TPW - 1)))
#define PEER_SL(n) ((n) / PEER_TPW)
#define DOTS_STEP(RX, RY, PX, PY, n) do { if ((n) < NU) { \
        slice_rows(RY, PY.idv, U8 + 128 * PEER_SL(((n) + 1 < NU) ? (n) + 1 : 0) + 16 * m); __builtin_amdgcn_sched_barrier(0); \
        dots_comp(RX, PX, ACC + ((n) & (PEER_TPW - 1)) * NSEL, PEER_SL(n) == 0, lane); __builtin_amdgcn_sched_barrier(0); \
        { const int n3 = ((n) + 3 < NU) ? (n) + 3 : 0; dots_pre(PX, args, PEER_TOK(n3), PEER_SL(n3), lane); } __builtin_amdgcn_sched_barrier(0); } } while (0)
#define AXPY_STEP(RX, RY, PX, PY, n) do { if ((n) < NU) { \
        slice_rows(RY, PY.idv, V8 + 128 * PEER_SL(((n) + 1 < NU) ? (n) + 1 : 0) + 16 * m); __builtin_amdgcn_sched_barrier(0); \
        { const float q_ = axpy_comp(RX, PX, args, ACC + ((n) & (PEER_TPW - 1)) * NSEL, PEER_TOK(n), PEER_SL(n), lane); \
          if (lane == 0) { LAS float* sp_ = SSQl + ((n) & (PEER_TPW - 1)); *sp_ = (PEER_SL(n) == 0) ? q_ : *sp_ + q_; } } __builtin_amdgcn_sched_barrier(0); \
        { const int n3 = ((n) + 3 < NU) ? (n) + 3 : 0; axpy_pre(PX, args, PEER_TOK(n3), PEER_SL(n3), lane); } __builtin_amdgcn_sched_barrier(0); } } while (0)
__device__ __forceinline__ void peer_phase(Frame& F, const Args& args, unsigned long long* prof = nullptr, int prof_k = 0) {
    const int lane = lane_now(), m = lane & 7;
    LAS float* ACC = (LAS float*)(F.lds + F.wave * 8192);
    LAS float* SSQl = (LAS float*)(F.lds + F.wave * 8192 + 4096);
    const unsigned char* U8 = (const unsigned char*)W_SLAB(SL_UB); const unsigned char* V8 = (const unsigned char*)W_SLAB(SL_VB);
    const int tpw = M / (F.G * NWAVES);
    const int tokbase = (F.vcu * NWAVES + F.wave) * tpw;
    constexpr int NU = NSLICE * PEER_TPW;
    v4u RA[16], RB[16];
    { DotsPre PA, PB, PC;
      dots_pre(PA, args, PEER_TOK(0), PEER_SL(0), lane); dots_pre(PB, args, PEER_TOK(1), PEER_SL(1), lane); dots_pre(PC, args, PEER_TOK(2), PEER_SL(2), lane);
      slice_rows(RA, PA.idv, U8 + 128 * PEER_SL(0) + 16 * m);
      for (int nb = 0; nb < NU; nb += 6) {
          DOTS_STEP(RA, RB, PA, PB, nb); DOTS_STEP(RB, RA, PB, PC, nb + 1); DOTS_STEP(RA, RB, PC, PA, nb + 2);
          DOTS_STEP(RB, RA, PA, PB, nb + 3); DOTS_STEP(RA, RB, PB, PC, nb + 4); DOTS_STEP(RB, RA, PC, PA, nb + 5); } }
    { const unsigned short* SELI = (const unsigned short*)W_SLAB(SL_SEL); const float* SELG = (const float*)(W_SLAB(SL_SEL)) + (size_t)M * NSEL;
#pragma unroll 2
      for (int i = 0; i < PEER_TPW; ++i) { const int tok = tokbase + i;
          const unsigned idw = *(const unsigned*)(SELI + (size_t)tok * NSEL + 2 * lane); const int e0 = (int)(idw & 0xffffu), e1 = (int)(idw >> 16);
          const f32x2 gt = *(const f32x2*)(SELG + (size_t)tok * NSEL + 2 * lane);
          LAS f32x2* ap = (LAS f32x2*)(ACC + i * NSEL + 2 * lane); const f32x2 d = *ap;
          const pg8::f32x2 ge = pg8::gelu_pk((pg8::f32x2){d.x * W_PSC[e0], d.y * W_PSC[e1]});
          *ap = (f32x2){ge.x * gt.x * W_PSC[NEXP + e0], ge.y * gt.y * W_PSC[NEXP + e1]}; } }
    if (prof && F.wave == 0 && lane == 0) { const unsigned long long t_ = __builtin_amdgcn_s_memrealtime(); __hip_atomic_fetch_max(prof + prof_k, t_, __ATOMIC_RELAXED, __HIP_MEMORY_SCOPE_AGENT); __hip_atomic_fetch_max(prof + 32 + prof_k, ~t_, __ATOMIC_RELAXED, __HIP_MEMORY_SCOPE_AGENT); }
    { AxpyPre PA, PB, PC;
      axpy_pre(PA, args, PEER_TOK(0), PEER_SL(0), lane); axpy_pre(PB, args, PEER_TOK(1), PEER_SL(1), lane); axpy_pre(PC, args, PEER_TOK(2), PEER_SL(2), lane);
      slice_rows(RA, PA.idv, V8 + 128 * PEER_SL(0) + 16 * m);
      for (int nb = 0; nb < NU; nb += 6) {
          AXPY_STEP(RA, RB, PA, PB, nb); AXPY_STEP(RB, RA, PB, PC, nb + 1); AXPY_STEP(RA, RB, PC, PA, nb + 2);
          AXPY_STEP(RB, RA, PA, PB, nb + 3); AXPY_STEP(RA, RB, PB, PC, nb + 4); AXPY_STEP(RB, RA, PC, PA, nb + 5); } }
    asm volatile("s_waitcnt vmcnt(0) lgkmcnt(0)" ::: "memory");
    for (int i = 0; i < PEER_TPW; ++i) { const int tok = tokbase + i;
        const float r3 = __builtin_amdgcn_rsqf(SSQl[i] * (1.0f / DM) + EPS);
        const v4u* ur = (const v4u*)(W_SLAB(SL_ZA) + (size_t)tok * DM) + lane;
        f32x4* xr = (f32x4*)(A_out + (size_t)tok * DM); const f32x4* gr = (const f32x4*)A_final_g;
        v4u v[4];
#pragma unroll
        for (int j = 0; j < 4; ++j) v[j] = __builtin_nontemporal_load(ur + 64 * j);
#pragma unroll
        for (int j = 0; j < 4; ++j) { const int e4 = 2 * lane + 128 * j;
            xr[e4] = (f32x4){bflo(v[j].x), bfhi(v[j].x), bflo(v[j].y), bfhi(v[j].y)} * r3 * gr[e4];
            xr[e4 + 1] = (f32x4){bflo(v[j].z), bfhi(v[j].z), bflo(v[j].w), bfhi(v[j].w)} * r3 * gr[e4 + 1]; } }
}

__global__ void __launch_bounds__(NWAVES * 64, 2) fwd_kernel(Args args) {
    extern __shared__ __attribute__((aligned(16))) unsigned char lds[];
    Frame F;
    F.lds = (LAS unsigned char*)lds;
    F.MISC = (volatile LAS unsigned*)(F.lds + MISC_OFF);
    F.wave = __builtin_amdgcn_readfirstlane((int)threadIdx.x >> 6);
    F.G = gridDim.x; { const int bx = blockIdx.x; F.vcu = (F.G % 8 == 0) ? (bx % 8) * (F.G / 8) + bx / 8 : bx; }
    for (int u = F.wave * 64 + lane_now(); u < (LDS_BYTES - LDSCTL_OFF) / 4; u += NWAVES * 64) ((LAS unsigned*)(F.lds + LDSCTL_OFF))[u] = 0u;
    __syncthreads();
    XcdBarrier bar = xcd_barrier_post((unsigned*)(args.ws + WS_CTL) + CW_BAR, F.MISC + 8);
#define ST_ ((bf16*)args.out)
#if PROF_SEL
    unsigned long long* PROFW = (unsigned long long*)(args.ws + WS_CTL + 256 * 1024);
    int prof_k = 0;
#define PROF_ARRIVE() do { if (F.wave == 0 && lane_now() == 0) { const unsigned long long t_ = __builtin_amdgcn_s_memrealtime(); \
        __hip_atomic_fetch_max(PROFW + prof_k, t_, __ATOMIC_RELAXED, __HIP_MEMORY_SCOPE_AGENT); __hip_atomic_fetch_max(PROFW + 32 + prof_k, ~t_, __ATOMIC_RELAXED, __HIP_MEMORY_SCOPE_AGENT); } } while (0)
#define GRID_BAR() do { PROF_ARRIVE(); xcd_barrier(bar); if (blockIdx.x == 0 && F.wave == 0 && lane_now() == 0) PROFW[64 + prof_k] = __builtin_amdgcn_s_memrealtime(); ++prof_k; } while (0)
#define PROF_MARK() do { PROF_ARRIVE(); if (blockIdx.x == 0 && F.wave == 0 && lane_now() == 0) PROFW[64 + prof_k] = (prof_k == 0) ? PROFW[95] : PROFW[64 + prof_k - 1]; ++prof_k; } while (0)
#else
#define GRID_BAR() xcd_barrier(bar)
#define PROF_MARK() do { } while (0)
#endif

#define PH_P0() do { p0_prologue(F, args); GRID_BAR(); } while (0)
#define PH_G1() do { { pg8::Gemm gm{W_XN, W_WinT, M, INW, DM, nullptr, nullptr}; pg8::StaticOrder S; S.init(M, INW, F.G, (int)blockIdx.x); \
      pg8::EpiSplit E{W_SLAB(0), DM, DM, (size_t)M * DM}; \
      pg8::gemm_phase<pg8::EpiSplit, pg8::StaticOrder, true, true>(F.lds, gm, S, E, F.wave); } \
    p1_meta(F, args); GRID_BAR(); } while (0)
#define PH_P2A() do { rg_phase<0>(F, args); PROF_MARK(); hg_phase<0>(F, args, ST_); GRID_BAR(); } while (0)
#define PH_G345(QPSLAB) do { \
    p3_convert_uv(F, args); __syncthreads(); \
    { pg8::Gemm gm{W_SLAB(SL_YA), W_WpaT, M, DM, DM, W_SLAB(SL_OG), W_WpbT}; pg8::PairOrder S; S.init(M, DM, F.G, (int)blockIdx.x); \
      pg8::EpiPairGate E{W_SLAB(SL_ZA), W_SLAB(SL_ZB), W_SLAB(SL_MIX), DM}; \
      pg8::gemm_phase<pg8::EpiPairGate, pg8::PairOrder, true, true>(F.lds, gm, S, E, F.wave); } \
    GRID_BAR(); \
    { pg8::Gemm gm{W_SLAB(SL_MIX), W_WoutT, M, DM, DM, nullptr, nullptr}; pg8::StaticOrder S; S.init(M, DM, F.G, (int)blockIdx.x); \
      pg8::EpiResid E{A_x, A_out, W_SLAB(SL_H2B), W_RSP, DM}; \
      pg8::gemm_phase<pg8::EpiResid, pg8::StaticOrder, true, true>(F.lds, gm, S, E, F.wave); } \
    GRID_BAR(); \
    { pg8::Gemm gm{W_SLAB(SL_H2B), W_WqT, M, DM, DM, nullptr, nullptr}; pg8::StaticOrder S; S.init(M, DM, F.G, (int)blockIdx.x); \
      pg8::EpiRowScale E{W_SLAB(QPSLAB), DM, W_RSP, 1.0f / DM, EPS, W_RSTD2}; \
      pg8::gemm_phase<pg8::EpiRowScale, pg8::StaticOrder, true, true>(F.lds, gm, S, E, F.wave); } \
    GRID_BAR(); } while (0)
#define PH_SEL() do { sel_phase(F, args); GRID_BAR(); } while (0)

#if defined(TEST_ONLY)
#if TEST_ONLY == 1
    rg_phase<0>(F, args);
#elif TEST_ONLY == 2
    rg_phase<1>(F, args);
#elif TEST_ONLY == 3
    hg_phase<0>(F, args, ST_);
#elif TEST_ONLY == 4
    hg_phase<1>(F, args, ST_);
#elif TEST_ONLY == 5
    sel_phase(F, args);
#elif TEST_ONLY == 6
    peer_phase(F, args);
#elif TEST_ONLY == 7
    p0_prologue(F, args);
#endif
    return;
#endif
#if PROF_SEL
    if (blockIdx.x == 0 && F.wave == 0 && lane_now() == 0) PROFW[95] = __builtin_amdgcn_s_memrealtime();
#endif
    PH_P0();
#if REPMASK & 1
    PH_P0();
#endif
    PH_G1();
#if REPMASK & 2
    PH_G1();
#endif
#if REPMASK & 64
    rg_phase<0, false, RGVAR>(F, args); GRID_BAR();
#endif
    PH_P2A();
#if REPMASK & 4
    PH_P2A();
#endif
#if REPMASK & 128
    hg_phase<0>(F, args, ST_); GRID_BAR();
#endif
    rg_carry(F, args);
    hg_carry(F, args, ST_);
    GRID_BAR();
#if REPMASK & 256
    rg_phase<1, true>(F, args); GRID_BAR();
#endif
#if REPMASK & 512
    hg_phase<1, true>(F, args, ST_); GRID_BAR();
#endif
    rg_phase<1>(F, args);
    PROF_MARK();
    hg_phase<1>(F, args, ST_);
    GRID_BAR();
#if REPMASK & 8
    PH_G345(SL_MIX);
#endif
    PH_G345(SL_QP);
    PH_SEL();
#if REPMASK & 16
    PH_SEL();
#endif
#if PROF_SEL
    peer_phase(F, args, PROFW, prof_k); if (blockIdx.x == 0 && F.wave == 0 && lane_now() == 0) PROFW[64 + prof_k] = PROFW[64 + prof_k - 1]; ++prof_k;
#else
    peer_phase(F, args);
#endif
#if PROF_SEL
    PROF_ARRIVE();
    asm volatile("s_waitcnt vmcnt(0)" ::: "memory");
    if (blockIdx.x == 0) {
        if (F.wave == 0 && lane_now() == 0) {
            const unsigned long long t0 = __builtin_amdgcn_s_memrealtime();
            while (__builtin_amdgcn_s_memrealtime() - t0 < 30000ull) __builtin_amdgcn_s_sleep(8);
            const int k = PROF_SEL % 100;
            const unsigned long long last = __hip_atomic_load(PROFW + k, __ATOMIC_RELAXED, __HIP_MEMORY_SCOPE_AGENT), first = ~__hip_atomic_load(PROFW + 32 + k, __ATOMIC_RELAXED, __HIP_MEMORY_SCOPE_AGENT);
            const unsigned long long rel = (k == 0) ? PROFW[95] : PROFW[64 + k - 1];
            unsigned long long q = (PROF_SEL >= 200) ? (last - first) : (last - rel);
            if (PROF_SEL == 300) q = 0ull; if (PROF_SEL == 301) q = 10000ull;
            if (q > 200000ull) q = 200000ull;
            const unsigned long long t1 = __builtin_amdgcn_s_memrealtime();
            while (__builtin_amdgcn_s_memrealtime() - t1 < q * PROF_AMP) __builtin_amdgcn_s_sleep(8);
        }
    }
#endif
}

extern "C" void kernel_launch(void* const* d_in, const int* in_sizes, int n_in, void* d_out, int out_size, void* d_ws, size_t ws_size, hipStream_t stream) {
    static int grid = 0;
    if (grid == 0) {
        if (n_in != 22 || in_sizes[0] != M * DM || out_size != M * DM || ws_size < WS_END) { fprintf(stderr, "kernel_launch: unexpected shapes (n_in %d in0 %d out %d ws %zu)\n", n_in, n_in > 0 ? in_sizes[0] : -1, out_size, ws_size); grid = -1; return; }
        int dev = 0, cus = 0, per_cu = 0;
        if (hipGetDevice(&dev) != hipSuccess || hipDeviceGetAttribute(&cus, hipDeviceAttributeMultiprocessorCount, dev) != hipSuccess) { grid = -1; return; }
        if (hipFuncSetAttribute((const void*)fwd_kernel, hipFuncAttributeMaxDynamicSharedMemorySize, LDS_BYTES) != hipSuccess) { fprintf(stderr, "kernel_launch: hipFuncSetAttribute failed\n"); grid = -1; return; }
        if (hipOccupancyMaxActiveBlocksPerMultiprocessor(&per_cu, (const void*)fwd_kernel, NWAVES * 64, LDS_BYTES) != hipSuccess || per_cu < 1) { fprintf(stderr, "kernel_launch: occupancy query says %d\n", per_cu); per_cu = 1; }
        (void)hipGetLastError();
        grid = cus;
        if (grid % 8 != 0 || grid > 256) grid = (grid > 256) ? 256 : (grid / 8) * 8;
        if (M / (grid * NWAVES) != PEER_TPW || M % (grid * NWAVES) != 0) { fprintf(stderr, "kernel_launch: built for a 256-CU device (got %d)\n", grid); grid = -1; return; }
    }
    if (grid <= 0) return;
    (void)hipMemsetAsync((char*)d_ws + WS_CTL, 0, CTL_ZERO_BYTES, stream);
    Args a{};
    for (int i = 0; i < 22; ++i) a.in[i] = (const float*)d_in[i];
    a.out = (float*)d_out; a.ws = (unsigned char*)d_ws;
    hipLaunchKernelGGL(fwd_kernel, dim3(grid), dim3(NWAVES * 64), LDS_BYTES, stream, a);
}
```

```cpp
#include <hip/hip_runtime.h>
#include <cstdio>
#include <cstdint>
#define RGVAR 0
#define PROF_SEL 0
#define PROF_AMP 8
#ifndef REPMASK
#define REPMASK 0
#endif
namespace pg8 {
#define PG8_LAS __attribute__((address_space(3)))
typedef unsigned short bf16_t;
typedef short bf16x8 __attribute__((ext_vector_type(8)));
typedef float f32x4 __attribute__((ext_vector_type(4)));
typedef unsigned u32x4 __attribute__((ext_vector_type(4)));
constexpr int BM = 256, BK = 64, HALF = 128, HTB = HALF * BK * 2  , STAGE_BYTES = 8 * HTB, NXCD = 8, WGM = 8;

__host__ __device__ __forceinline__ int lds_byte(int r, int c) { const int st = (r >> 4) * 2 + (c >> 5), rr = r & 15, cc = c & 31, ob = rr * 64 + cc * 2; return st * 1024 + (ob ^ (((ob >> 9) & 1) << 5)); }
__host__ __device__ __forceinline__ void stage_rc(int b, int& R, int& C) { const int st = b / 1024, sb = b % 1024, swz = sb ^ (((sb >> 9) & 1) << 5); R = (st >> 1) * 16 + swz / 64; C = (st & 1) * 32 + (swz % 64) / 2; }
__host__ __device__ __forceinline__ int perm32(int rho) { const int n = rho >> 4, i = rho & 15; return 8 * (i >> 2) + 4 * n + (i & 3); }

__device__ __forceinline__ int lane_now_pg8() { int l; asm volatile("v_mbcnt_lo_u32_b32 %0, -1, 0\n\tv_mbcnt_hi_u32_b32 %0, -1, %0" : "=v"(l)); return l; }
struct Unit { int pm, pn, seg; };
typedef int i32x4_ __attribute__((ext_vector_type(4))); typedef int i32x8_ __attribute__((ext_vector_type(8)));
__device__ __forceinline__ i32x8_ cat8(const bf16x8 a, const bf16x8 b) { const i32x4_ x = __builtin_bit_cast(i32x4_, a), y = __builtin_bit_cast(i32x4_, b); return __builtin_shufflevector(x, y, 0, 1, 2, 3, 4, 5, 6, 7); }
struct Gemm { const bf16_t* A; const bf16_t* Bt; int M, N, K; const bf16_t* A2; const bf16_t* Bt2; };

struct StaticOrder {
    int nM, nN, nwg, G, c;
    __host__ __device__ void init(int M, int N, int G_, int c_) { nM = M / BM; nN = N / BM; nwg = nM * nN; G = G_; c = c_; }
    __host__ __device__ bool next(int i, Unit& u) const {
        const long L = (long)i * G + c; if (L >= nwg) return false;
        int wgid = (int)L; { const int q = nwg / NXCD, r = nwg % NXCD, xcd = wgid % NXCD, off = wgid / NXCD; wgid = (xcd < r ? xcd * (q + 1) : r * (q + 1) + (xcd - r) * q) + off; }
        const int nig = WGM * nN, gid = wgid / nig, fm = gid * WGM, gsz = (nM - fm) < WGM ? (nM - fm) : WGM;
        u.pm = fm + ((wgid % nig) % gsz); u.pn = (wgid % nig) / gsz; u.seg = 0; return true;
    }
    __device__ __forceinline__ void a_ready(const Unit&) const {}
    __device__ __forceinline__ void done(const Unit&) const {}
};
struct PairOrder : StaticOrder {
    __host__ __device__ bool next(int i, Unit& u) const { if (!StaticOrder::next(i >> 1, u)) return false; u.seg = i & 1; return true; }
};

__device__ __forceinline__ unsigned cvt_pk_bf16(float lo, float hi) { unsigned r; asm volatile("v_cvt_pk_bf16_f32 %0, %1, %2" : "=v"(r) : "v"(lo), "v"(hi)); return r; }
typedef float f32x2 __attribute__((ext_vector_type(2)));
__device__ __forceinline__ f32x2 gelu_pk(f32x2 v) {
    const f32x2 av = __builtin_elementwise_abs(v), d = av * 0.2316418882f + 1.0f;
    f32x2 t; t.x = __builtin_amdgcn_rcpf(d.x); t.y = __builtin_amdgcn_rcpf(d.y);
    f32x2 q = t * 0.5307027145f + (-0.7265760135f); q = q * t + 0.7107068705f; q = q * t + (-0.142248368f); q = q * t + 0.127414796f; q = q * t;
    const f32x2 s = (v * v) * (-0.72134752044f);
    f32x2 e; e.x = __builtin_amdgcn_exp2f(s.x); e.y = __builtin_amdgcn_exp2f(s.y);
    const f32x2 m = v * (q * e), r = v - m;
    f32x2 o; o.x = v.x < 0.f ? m.x : r.x; o.y = v.y < 0.f ? m.y : r.y; return o;
}

__device__ __forceinline__ float bf_lo(unsigned w) { return __uint_as_float(w << 16); }
__device__ __forceinline__ float bf_hi(unsigned w) { return __uint_as_float(w & 0xffff0000u); }
__device__ __forceinline__ float sigmoidf_(float x) { return __builtin_amdgcn_rcpf(1.0f + __expf(-x)); }
typedef unsigned u32x2 __attribute__((ext_vector_type(2)));

struct EpiSplit {
    static constexpr bool PERM = true, AFTER_DRAIN = false, PAIRED = false;
    bf16_t* O; int ldc; int split_cols; size_t split_stride; float osc;
    __device__ __forceinline__ void operator()(const f32x4 (&acc)[2][2][4][2], const Unit& u, int wr, int wc, int fr, int fq) const {
        const int row0 = u.pm * BM + wr * 64 + fr; int colt = u.pn * BM; bf16_t* base = O;
        if (split_cols) { const int t = colt / split_cols; base += (size_t)t * split_stride; colt -= t * split_cols; }
        const int col0 = colt + wc * 32 + 8 * fq;
#pragma unroll
        for (int ai = 0; ai < 2; ++ai)
#pragma unroll
            for (int m = 0; m < 4; ++m) { bf16_t* rowp = base + (size_t)(row0 + ai * HALF + m * 16) * ldc + col0;
#pragma unroll
                for (int bj = 0; bj < 2; ++bj) { const f32x4 v0 = acc[ai][bj][m][0] * osc, v1 = acc[ai][bj][m][1] * osc;
                    u32x4 w; w.x = cvt_pk_bf16(v0[0], v0[1]); w.y = cvt_pk_bf16(v0[2], v0[3]); w.z = cvt_pk_bf16(v1[0], v1[1]); w.w = cvt_pk_bf16(v1[2], v1[3]);
                    __builtin_nontemporal_store(w, (u32x4*)(rowp + bj * HALF)); } }
    }
};
struct EpiRowScale {
    static constexpr bool PERM = true, AFTER_DRAIN = false, PAIRED = false;
    bf16_t* O; int ldc; const float* rsp; float inv_n, eps; float* rstd_out;
    __device__ __forceinline__ void operator()(const f32x4 (&acc)[2][2][4][2], const Unit& u, int wr, int wc, int fr, int fq) const {
        const int row0 = u.pm * BM + wr * 64 + fr; const int col0 = u.pn * BM + wc * 32 + 8 * fq;
#pragma unroll
        for (int ai = 0; ai < 2; ++ai) {
            f32x4 t[4][2];
#pragma unroll
            for (int m = 0; m < 4; ++m) { const f32x4* rp = (const f32x4*)(rsp + (size_t)(row0 + ai * HALF + m * 16) * 32) + 2 * fq; t[m][0] = rp[0]; t[m][1] = rp[1]; }
            __builtin_amdgcn_sched_barrier(0);
#pragma unroll
            for (int m = 0; m < 4; ++m) { const int row = row0 + ai * HALF + m * 16; bf16_t* rowp = O + (size_t)row * ldc + col0;
                float ss = ((t[m][0][0] + t[m][0][1]) + (t[m][0][2] + t[m][0][3])) + ((t[m][1][0] + t[m][1][1]) + (t[m][1][2] + t[m][1][3]));
                { const auto r_ = __builtin_amdgcn_permlane16_swap(__float_as_uint(ss), __float_as_uint(ss), false, false); ss = __uint_as_float(r_[0]) + __uint_as_float(r_[1]); }
                { const auto r_ = __builtin_amdgcn_permlane32_swap(__float_as_uint(ss), __float_as_uint(ss), false, false); ss = __uint_as_float(r_[0]) + __uint_as_float(r_[1]); }
                const float sc = __builtin_amdgcn_rsqf(ss * inv_n + eps);
                if (u.pn == 0 && wc == 0 && fq == 0) rstd_out[row] = sc;
#pragma unroll
                for (int bj = 0; bj < 2; ++bj) { const f32x4 v0 = acc[ai][bj][m][0] * sc, v1 = acc[ai][bj][m][1] * sc;
                    u32x4 w; w.x = cvt_pk_bf16(v0[0], v0[1]); w.y = cvt_pk_bf16(v0[2], v0[3]); w.z = cvt_pk_bf16(v1[0], v1[1]); w.w = cvt_pk_bf16(v1[2], v1[3]);
                    *(u32x4*)(rowp + bj * HALF) = w; } }
        }
    }
};
struct EpiGateF32 {
    static constexpr bool PERM = false, AFTER_DRAIN = false, PAIRED = false;
    bf16_t* C; const bf16_t* Z; int ldc;
    __device__ __forceinline__ void operator()(const f32x4 (&acc)[2][2][4][2], const Unit& u, int wr, int wc, int fr, int fq) const {
        const int row0 = u.pm * BM + wr * 64 + fr, col0 = u.pn * BM + wc * 32 + 4 * fq;
#pragma unroll
        for (int ai = 0; ai < 2; ++ai)
#pragma unroll
            for (int m = 0; m < 4; ++m) { const size_t off = (size_t)(row0 + ai * HALF + m * 16) * ldc + col0;
#pragma unroll
                for (int bj = 0; bj < 2; ++bj)
#pragma unroll
                    for (int n = 0; n < 2; ++n) { const u32x2 z = *(const u32x2*)(Z + off + bj * HALF + n * 16);
                        const f32x4 g = (f32x4){sigmoidf_(bf_lo(z.x)), sigmoidf_(bf_hi(z.x)), sigmoidf_(bf_lo(z.y)), sigmoidf_(bf_hi(z.y))};
                        const f32x4 t = acc[ai][bj][m][n] * g; u32x2 w; w.x = cvt_pk_bf16(t[0], t[1]); w.y = cvt_pk_bf16(t[2], t[3]); *(u32x2*)(C + off + bj * HALF + n * 16) = w; } }
    }
};
struct EpiMerge {
    static constexpr bool PERM = false, AFTER_DRAIN = false, PAIRED = false;
    const bf16_t* T1; const bf16_t* Z; bf16_t* O; int ldc;
    __device__ __forceinline__ void operator()(const f32x4 (&acc)[2][2][4][2], const Unit& u, int wr, int wc, int fr, int fq) const {
        const int row0 = u.pm * BM + wr * 64 + fr, col0 = u.pn * BM + wc * 32 + 4 * fq;
#pragma unroll
        for (int ai = 0; ai < 2; ++ai)
#pragma unroll
            for (int m = 0; m < 4; ++m) { const size_t off = (size_t)(row0 + ai * HALF + m * 16) * ldc + col0;
#pragma unroll
                for (int bj = 0; bj < 2; ++bj)
#pragma unroll
                    for (int n = 0; n < 2; ++n) { const u32x2 z = *(const u32x2*)(Z + off + bj * HALF + n * 16); const u32x2 tw = *(const u32x2*)(T1 + off + bj * HALF + n * 16); const f32x4 t1 = (f32x4){bf_lo(tw.x), bf_hi(tw.x), bf_lo(tw.y), bf_hi(tw.y)};
                        const f32x4 g = (f32x4){sigmoidf_(bf_lo(z.x)), sigmoidf_(bf_hi(z.x)), sigmoidf_(bf_lo(z.y)), sigmoidf_(bf_hi(z.y))};
                        const f32x4 o = t1 + acc[ai][bj][m][n] * g; u32x2 w; w.x = cvt_pk_bf16(o[0], o[1]); w.y = cvt_pk_bf16(o[2], o[3]);
                        *(u32x2*)(O + off + bj * HALF + n * 16) = w; } }
    }
};
struct EpiPairGate {
    static constexpr bool PERM = false, AFTER_DRAIN = false, PAIRED = true;
    const bf16_t* ZA; const bf16_t* ZB; bf16_t* O; int ldc;
    __device__ __forceinline__ void mid(f32x4 (&acc)[2][2][4][2], const Unit& u, int wr, int wc, int fr, int fq) const {
        const int row0 = u.pm * BM + wr * 64 + fr, col0 = u.pn * BM + wc * 32 + 4 * fq;
#pragma unroll
        for (int ai = 0; ai < 2; ++ai)
#pragma unroll
            for (int mp = 0; mp < 2; ++mp) {
                u32x2 za[2][2][2], zb[2][2][2];
#pragma unroll
                for (int mm = 0; mm < 2; ++mm) { const size_t off = (size_t)(row0 + ai * HALF + (2 * mp + mm) * 16) * ldc + col0;
#pragma unroll
                    for (int bj = 0; bj < 2; ++bj)
#pragma unroll
                        for (int n = 0; n < 2; ++n) { za[mm][bj][n] = *(const u32x2*)(ZA + off + bj * HALF + n * 16); zb[mm][bj][n] = *(const u32x2*)(ZB + off + bj * HALF + n * 16); } }
                __builtin_amdgcn_sched_barrier(0);
#pragma unroll
                for (int mm = 0; mm < 2; ++mm)
#pragma unroll
                    for (int bj = 0; bj < 2; ++bj)
#pragma unroll
                        for (int n = 0; n < 2; ++n) { const u32x2 a = za[mm][bj][n], b = zb[mm][bj][n];
                            const f32x4 ra = (f32x4){sigmoidf_(bf_lo(a.x)), sigmoidf_(bf_hi(a.x)), sigmoidf_(bf_lo(a.y)), sigmoidf_(bf_hi(a.y))};
                            const f32x4 ib = (f32x4){1.0f + __expf(-fmaxf(bf_lo(b.x), -30.f)), 1.0f + __expf(-fmaxf(bf_hi(b.x), -30.f)), 1.0f + __expf(-fmaxf(bf_lo(b.y), -30.f)), 1.0f + __expf(-fmaxf(bf_hi(b.y), -30.f))};
                            acc[ai][bj][2 * mp + mm][n] = acc[ai][bj][2 * mp + mm][n] * ra * ib; }
            }
    }
    __device__ __forceinline__ void operator()(const f32x4 (&acc)[2][2][4][2], const Unit& u, int wr, int wc, int fr, int fq) const {
        const int row0 = u.pm * BM + wr * 64 + fr, col0 = u.pn * BM + wc * 32 + 4 * fq;
#pragma unroll
        for (int ai = 0; ai < 2; ++ai) {
            u32x2 zb[4][2][2];
#pragma unroll
            for (int m = 0; m < 4; ++m) { const size_t off = (size_t)(row0 + ai * HALF + m * 16) * ldc + col0;
#pragma unroll
                for (int bj = 0; bj < 2; ++bj)
#pragma unroll
                    for (int n = 0; n < 2; ++n) zb[m][bj][n] = *(const u32x2*)(ZB + off + bj * HALF + n * 16); }
            __builtin_amdgcn_sched_barrier(0);
#pragma unroll
            for (int m = 0; m < 4; ++m) { const size_t off = (size_t)(row0 + ai * HALF + m * 16) * ldc + col0;
#pragma unroll
                for (int bj = 0; bj < 2; ++bj)
#pragma unroll
                    for (int n = 0; n < 2; ++n) { const u32x2 b = zb[m][bj][n];
                        const f32x4 g = (f32x4){sigmoidf_(fmaxf(bf_lo(b.x), -30.f)), sigmoidf_(fmaxf(bf_hi(b.x), -30.f)), sigmoidf_(fmaxf(bf_lo(b.y), -30.f)), sigmoidf_(fmaxf(bf_hi(b.y), -30.f))};
                        const f32x4 o = acc[ai][bj][m][n] * g; u32x2 w; w.x = cvt_pk_bf16(o[0], o[1]); w.y = cvt_pk_bf16(o[2], o[3]);
                        *(u32x2*)(O + off + bj * HALF + n * 16) = w; } }
        }
    }
};
struct EpiResid {
    static constexpr bool PERM = false, AFTER_DRAIN = false, PAIRED = false;
    const float* X; float* H2; bf16_t* H2B; float* rsp; int ldc;
    __device__ __forceinline__ void operator()(const f32x4 (&acc)[2][2][4][2], const Unit& u, int wr, int wc, int fr, int fq) const {
        const int row0 = u.pm * BM + wr * 64 + fr, col0 = u.pn * BM + wc * 32 + 4 * fq;
#pragma unroll
        for (int ai = 0; ai < 2; ++ai)
#pragma unroll
            for (int mp = 0; mp < 2; ++mp) {
                f32x4 xv[2][2][2];
#pragma unroll
                for (int mm = 0; mm < 2; ++mm) { const size_t off = (size_t)(row0 + ai * HALF + (2 * mp + mm) * 16) * ldc + col0;
#pragma unroll
                    for (int bj = 0; bj < 2; ++bj)
#pragma unroll
                        for (int n = 0; n < 2; ++n) xv[mm][bj][n] = __builtin_nontemporal_load((const f32x4*)(X + off + bj * HALF + n * 16)); }
                __builtin_amdgcn_sched_barrier(0);
#pragma unroll
                for (int mm = 0; mm < 2; ++mm) { const int m = 2 * mp + mm; const int row = row0 + ai * HALF + m * 16; const size_t off = (size_t)row * ldc + col0; float ss = 0.f;
#pragma unroll
                    for (int bj = 0; bj < 2; ++bj)
#pragma unroll
                        for (int n = 0; n < 2; ++n) { const f32x4 o = xv[mm][bj][n] + acc[ai][bj][m][n];
                            ss += (o[0] * o[0] + o[1] * o[1]) + (o[2] * o[2] + o[3] * o[3]);
                            u32x2 w; w.x = cvt_pk_bf16(o[0], o[1]); w.y = cvt_pk_bf16(o[2], o[3]); *(u32x2*)(H2B + off + bj * HALF + n * 16) = w; }
                    ss += __shfl_xor(ss, 16); ss += __shfl_xor(ss, 32);
                    if (fq == 0) rsp[(size_t)row * 32 + 4 * u.pn + wc] = ss; }
            }
    }
};

template <class Epi, class Sched, bool ALIGN_EPI = false, bool SP2 = false, bool FP8 = false>
__device__ __forceinline__ void gemm_phase(PG8_LAS unsigned char* lds, const Gemm g, const Sched& S, const Epi& E, const int wid) {
    const int lane = lane_now_pg8(), tid = wid * 64 + lane, wr = wid >> 2, wc = wid & 3, fr = lane & 15, fq = lane >> 4;
    const int K = g.K, nt = K / BK;
    unsigned voffA[2], voffB[2];
#pragma unroll
    for (int i = 0; i < 2; ++i) { int R, C; stage_rc(tid * 16 + i * 8192, R, C); const int Rb = Epi::PERM ? ((R & ~31) + perm32(R & 31)) : R;
        voffA[i] = (unsigned)(R * K + C) * 2u; voffB[i] = (unsigned)(Rb * K + C) * 2u; }
    const size_t kstep = (size_t)(BK * 2);
    const size_t hstep = (size_t)HALF * K * 2;
    const size_t tstep = 2 * hstep;
    const unsigned ldsw = (unsigned)wid * 1024u;
    const int aoff = lds_byte(wr * 64 + fr, fq * 8), boff = lds_byte(wc * 32 + fr, fq * 8);
#define PG8_SA(b, h) (((b) * 2 + (h)) * HTB)
#define PG8_SB(b, h) ((4 + (b) * 2 + (h)) * HTB)
#define PG8_STAGE(bufoff, gbase, voff) do { _Pragma("unroll") for (int _i = 0; _i < 2; ++_i) \
        __builtin_amdgcn_global_load_lds((const unsigned*)((const char*)(gbase) + (voff)[_i]), (PG8_LAS unsigned*)(lds + (bufoff) + ldsw + _i * 8192), 16, 0, 0); } while (0)
#define PG8_LDA(dst, b, h) do { _Pragma("unroll") for (int m = 0; m < 4; ++m) _Pragma("unroll") for (int k = 0; k < 2; ++k) dst[m][k] = *(const PG8_LAS bf16x8*)(lds + PG8_SA(b, h) + aoff + m * 2048 + k * 1024); } while (0)
#define PG8_LDB(dst, b, h) do { _Pragma("unroll") for (int n = 0; n < 2; ++n) _Pragma("unroll") for (int k = 0; k < 2; ++k) dst[n][k] = *(const PG8_LAS bf16x8*)(lds + PG8_SB(b, h) + boff + n * 2048 + k * 1024); } while (0)
#define PG8_MMA(ai, bj, At, Bt) do { __builtin_amdgcn_s_setprio(1); _Pragma("unroll") for (int m = 0; m < 4; ++m) _Pragma("unroll") for (int n = 0; n < 2; ++n) { \
        if constexpr (FP8) { const i32x8_ a8_ = cat8(Bt[n][0], Bt[n][1]), b8_ = cat8(At[m][0], At[m][1]); asm volatile("v_mfma_f32_16x16x128_f8f6f4 %0, %1, %2, %0" : "+v"(acc[ai][bj][m][n]) : "v"(a8_), "v"(b8_)); } \
        else { _Pragma("unroll") for (int k = 0; k < 2; ++k) acc[ai][bj][m][n] = __builtin_amdgcn_mfma_f32_16x16x32_bf16(Bt[n][k], At[m][k], acc[ai][bj][m][n], 0, 0, 0); } } __builtin_amdgcn_s_setprio(0); } while (0)
#define PG8_WAIT_V(n) asm volatile("s_waitcnt vmcnt(" #n ")" ::: "memory")
#define PG8_WAIT_L(n) asm volatile("s_waitcnt lgkmcnt(" #n ")" ::: "memory")
#define PG8_BAR __builtin_amdgcn_s_barrier()
#define PG8_SCHED __builtin_amdgcn_sched_barrier(0)
    Unit cur, nxt; int ui = 0;
    if (!S.next(0, cur)) return;
    f32x4 acc[2][2][4][2];
#pragma unroll
    for (int a = 0; a < 2; ++a)
#pragma unroll
        for (int b = 0; b < 2; ++b)
#pragma unroll
            for (int m = 0; m < 4; ++m)
#pragma unroll
                for (int n = 0; n < 2; ++n) acc[a][b][m][n] = (f32x4){0.f, 0.f, 0.f, 0.f};
    bf16x8 At[4][2], B0[2][2], B1[2][2];
    const char* cA = (const char*)(cur.seg ? g.A2 : g.A) + (size_t)cur.pm * tstep; const char* cB = (const char*)(cur.seg ? g.Bt2 : g.Bt) + (size_t)cur.pn * tstep;
    S.a_ready(cur);
    if constexpr (SP2) {
        PG8_STAGE(PG8_SB(0, 0), cB, voffB); PG8_STAGE(PG8_SB(0, 1), cB + hstep, voffB); PG8_STAGE(PG8_SA(0, 0), cA, voffA); PG8_STAGE(PG8_SA(0, 1), cA + hstep, voffA);
        if (wr == 1) PG8_BAR;
        PG8_WAIT_V(2); PG8_BAR;
        PG8_STAGE(PG8_SB(1, 0), cB + kstep, voffB); PG8_STAGE(PG8_SA(1, 0), cA + kstep, voffA); PG8_STAGE(PG8_SB(1, 1), cB + hstep + kstep, voffB);
        PG8_WAIT_V(6); PG8_BAR;
    } else {
        PG8_STAGE(PG8_SB(0, 0), cB, voffB); PG8_STAGE(PG8_SA(0, 0), cA, voffA); PG8_STAGE(PG8_SB(0, 1), cB + hstep, voffB); PG8_STAGE(PG8_SA(0, 1), cA + hstep, voffA);
        if (wr == 1) PG8_BAR;
        PG8_WAIT_V(4); PG8_BAR;
        PG8_STAGE(PG8_SB(1, 0), cB + kstep, voffB); PG8_STAGE(PG8_SA(1, 0), cA + kstep, voffA); PG8_STAGE(PG8_SB(1, 1), cB + hstep + kstep, voffB);
        PG8_WAIT_V(6); PG8_BAR;
    }
    for (;;) {
        const bool has_next = S.next(ui + 1, nxt);
        const char* nA = has_next ? (const char*)(nxt.seg ? g.A2 : g.A) + (size_t)nxt.pm * tstep : cA; const char* nB = has_next ? (const char*)(nxt.seg ? g.Bt2 : g.Bt) + (size_t)nxt.pn * tstep : cB;
        for (int t = 0; t < nt; t += 2) {
            const bool last = (t == nt - 2);
            const char* a1 = cA + (size_t)(t + 1) * kstep;
            const char* a2 = last ? nA : cA + (size_t)(t + 2) * kstep; const char* b2 = last ? nB : cB + (size_t)(t + 2) * kstep;
            const char* a3 = a2 + kstep; const char* b3 = b2 + kstep;
            if (last && has_next) S.a_ready(nxt);
            if constexpr (SP2) {
            PG8_LDB(B0, 0, 0); PG8_LDB(B1, 0, 1); PG8_SCHED; PG8_LDA(At, 0, 0); PG8_STAGE(PG8_SA(1, 1), a1 + hstep, voffA);
            PG8_WAIT_V(8); PG8_WAIT_L(0); PG8_BAR; PG8_MMA(0, 0, At, B0); PG8_MMA(0, 1, At, B1); PG8_BAR; PG8_SCHED;
            PG8_LDA(At, 0, 1); PG8_STAGE(PG8_SB(0, 0), b2, voffB); PG8_STAGE(PG8_SB(0, 1), b2 + hstep, voffB); PG8_STAGE(PG8_SA(0, 0), a2, voffA);
            PG8_WAIT_V(8); PG8_WAIT_L(0); PG8_BAR; PG8_MMA(1, 0, At, B0); PG8_MMA(1, 1, At, B1); PG8_BAR; PG8_SCHED;
            PG8_LDB(B0, 1, 0); PG8_LDB(B1, 1, 1); PG8_SCHED; PG8_LDA(At, 1, 0); PG8_STAGE(PG8_SA(0, 1), a2 + hstep, voffA);
            PG8_WAIT_V(8); PG8_WAIT_L(0); PG8_BAR; PG8_MMA(0, 0, At, B0); PG8_MMA(0, 1, At, B1); PG8_BAR; PG8_SCHED;
            PG8_LDA(At, 1, 1); PG8_STAGE(PG8_SB(1, 0), b3, voffB); PG8_STAGE(PG8_SB(1, 1), b3 + hstep, voffB); PG8_STAGE(PG8_SA(1, 0), a3, voffA);
            PG8_WAIT_V(8); PG8_WAIT_L(0); PG8_BAR; PG8_MMA(1, 0, At, B0); PG8_MMA(1, 1, At, B1); PG8_BAR; PG8_SCHED;
            } else {
            PG8_LDB(B0, 0, 0); PG8_SCHED; PG8_LDA(At, 0, 0); PG8_STAGE(PG8_SA(1, 1), a1 + hstep, voffA);
            PG8_WAIT_L(8); PG8_BAR; PG8_WAIT_L(0); PG8_MMA(0, 0, At, B0); PG8_BAR; PG8_SCHED;
            PG8_LDB(B1, 0, 1); PG8_STAGE(PG8_SB(0, 0), b2, voffB);
            PG8_BAR; PG8_WAIT_L(0); PG8_MMA(0, 1, At, B1); PG8_BAR;
            PG8_LDA(At, 0, 1); PG8_STAGE(PG8_SA(0, 0), a2, voffA);
            PG8_BAR; PG8_WAIT_L(0); PG8_MMA(1, 0, At, B0); PG8_BAR; PG8_SCHED;
            PG8_STAGE(PG8_SB(0, 1), b2 + hstep, voffB);
            PG8_WAIT_V(6); PG8_BAR; PG8_MMA(1, 1, At, B1); PG8_BAR;
            PG8_LDB(B0, 1, 0); PG8_SCHED; PG8_LDA(At, 1, 0); PG8_STAGE(PG8_SA(0, 1), a2 + hstep, voffA);
            PG8_WAIT_L(8); PG8_BAR; PG8_WAIT_L(0); PG8_MMA(0, 0, At, B0); PG8_BAR; PG8_SCHED;
            PG8_LDB(B1, 1, 1); PG8_STAGE(PG8_SB(1, 0), b3, voffB);
            PG8_BAR; PG8_WAIT_L(0); PG8_MMA(0, 1, At, B1); PG8_BAR;
            PG8_LDA(At, 1, 1); PG8_STAGE(PG8_SA(1, 0), a3, voffA);
            PG8_BAR; PG8_WAIT_L(0); PG8_MMA(1, 0, At, B0); PG8_BAR; PG8_SCHED;
            PG8_STAGE(PG8_SB(1, 1), b3 + hstep, voffB);
            PG8_WAIT_V(6); PG8_BAR; PG8_MMA(1, 1, At, B1); PG8_BAR;
            }
        }
        if constexpr (FP8) asm volatile("s_nop 15\n\ts_nop 7" ::: "memory");
        if constexpr (ALIGN_EPI) { if (wr == 0) PG8_BAR; }
        bool keep = false;
        if constexpr (Epi::PAIRED) { if (cur.seg == 0) { E.mid(acc, cur, wr, wc, fr, fq); keep = true; } else E(acc, cur, wr, wc, fr, fq); S.done(cur); }
        else if constexpr (!Epi::AFTER_DRAIN) { E(acc, cur, wr, wc, fr, fq); S.done(cur); }
        if (!has_next) break;
        if (!keep)
#pragma unroll
        for (int a = 0; a < 2; ++a)
#pragma unroll
            for (int b = 0; b < 2; ++b)
#pragma unroll
                for (int m = 0; m < 4; ++m)
#pragma unroll
                    for (int n = 0; n < 2; ++n) acc[a][b][m][n] = (f32x4){0.f, 0.f, 0.f, 0.f};
        cur = nxt; cA = nA; cB = nB; ++ui;
        if constexpr (ALIGN_EPI) { if (wr == 1) PG8_BAR; }
    }
    PG8_WAIT_V(0);
    if constexpr (!ALIGN_EPI) { if (wr == 0) PG8_BAR; }
    PG8_BAR;
    if constexpr (Epi::AFTER_DRAIN) { E.fused(acc, cur, wr, wc, fr, fq, lds, wid, lane); S.done(cur); }
#undef PG8_SA
#undef PG8_SB
#undef PG8_STAGE
#undef PG8_LDA
#undef PG8_LDB
#undef PG8_MMA
#undef PG8_WAIT_V
#undef PG8_WAIT_L
#undef PG8_BAR
#undef PG8_SCHED
}
}


constexpr int NWAVES = 8;
constexpr int DM = 2048, BATCH = 4, SEQ = 4096, M = BATCH * SEQ, NMETA = 16, INW = 16384;
constexpr int NH = 16, HD = 128, CH = 64, NCH = SEQ / CH;
constexpr int PH = 8, NKEY = 128, TOPK = 16, NEXP = NKEY * NKEY, NSEL = PH * TOPK;
constexpr float EPS = 1e-6f;

constexpr size_t MiB = 1u << 20;
constexpr size_t WS_CTL = 0, CTL_ZERO_BYTES = 1 * MiB;
constexpr size_t SLAB_BYTES = (size_t)M * DM * 2;
constexpr size_t WS_SLAB = 1 * MiB;
constexpr size_t WS_WPA = 513 * MiB, WS_WPB = 521 * MiB, WS_WOUT = 529 * MiB, WS_WQ = 537 * MiB;
constexpr size_t WS_KEYS = 545 * MiB, WS_WA = WS_KEYS + 512 * 1024, WS_WX = WS_WA + 512 * 1024;
constexpr size_t WS_METAPROJ = 547 * MiB, WS_XNMETA = WS_METAPROJ + 512 * 1024;
constexpr size_t WS_RGSUM = 548 * MiB;
constexpr size_t WS_RGHIN = 553 * MiB;
constexpr size_t WS_HGDEC = 556 * MiB;
constexpr size_t WS_HGMETA = 559 * MiB;
constexpr size_t WS_RSP = 561 * MiB;
constexpr size_t WS_PSC = 563 * MiB;
constexpr size_t WS_END = 564 * MiB;
constexpr int SL_XA = 0, SL_YA = 1, SL_Q = 2, SL_F = 3, SL_I = 4, SL_OG = 5, SL_ZA = 6, SL_ZB = 7;
constexpr int SL_UB = 0, SL_VB = 2, SL_MIX = 3, SL_H2B = 4, SL_QP = 1, SL_SEL = 5;
constexpr int CW_BAR = 4096;

constexpr int RING_BYTES = 131072;
constexpr int LDS_BYTES = 147456;
constexpr int LDSCTL_OFF = LDS_BYTES - 1024, MISC_OFF = LDSCTL_OFF + 320;

#define LAS __attribute__((address_space(3)))
typedef unsigned short bf16;
typedef unsigned v4u __attribute__((ext_vector_type(4)));
typedef unsigned v2u __attribute__((ext_vector_type(2)));
typedef float f32x4 __attribute__((ext_vector_type(4)));
typedef float f32x2 __attribute__((ext_vector_type(2)));
typedef short bf16x8 __attribute__((ext_vector_type(8)));
#define LDS_WAIT() asm volatile("s_waitcnt lgkmcnt(0)" ::: "memory")
__device__ __forceinline__ int lane_now() { int l; asm volatile("v_mbcnt_lo_u32_b32 %0, -1, 0\n\tv_mbcnt_hi_u32_b32 %0, -1, %0" : "=v"(l)); return l; }
#define VM_WAIT() asm volatile("s_waitcnt vmcnt(0)" ::: "memory")
__device__ __forceinline__ unsigned f2bf(float f) { unsigned u = __builtin_bit_cast(unsigned, f); return (u + 0x7fffu + ((u >> 16) & 1u)) >> 16; }
__device__ __forceinline__ unsigned pk2(float lo, float hi) { unsigned r; asm("v_cvt_pk_bf16_f32 %0, %1, %2" : "=v"(r) : "v"(lo), "v"(hi)); return r; }
__device__ __forceinline__ float bflo(unsigned w) { return __uint_as_float(w << 16); }
__device__ __forceinline__ float bfhi(unsigned w) { return __uint_as_float(w & 0xffff0000u); }
__device__ __forceinline__ float bf1(bf16 h) { return __uint_as_float(((unsigned)h) << 16); }
__device__ __forceinline__ float sigm(float x) { return __builtin_amdgcn_rcpf(1.0f + __builtin_amdgcn_exp2f(-1.44269504f * x)); }
__device__ __forceinline__ float gelu1(float v) { pg8::f32x2 t; t.x = v; t.y = 0.f; t = pg8::gelu_pk(t); return t.x; }

#define XB_TMO      128
#define XB_XCNT(j)  (256  + 64 * (j))
#define XB_XSUB(j)  (1280 + 64 * (j))
#define XB_XGEN(j)  (2304 + 64 * (j))
#define XB_TOP      3328
#define XB_TOPGEN   3392
#define XCD_BAR_WORDS 3456
#define XB_SPIN_CAP (1u << 18)
__device__ __forceinline__ unsigned xb_ld(unsigned* p)              { return __hip_atomic_load(p, __ATOMIC_RELAXED, __HIP_MEMORY_SCOPE_AGENT); }
__device__ __forceinline__ unsigned xb_add(unsigned* p, unsigned v) { return __hip_atomic_fetch_add(p, v, __ATOMIC_RELAXED, __HIP_MEMORY_SCOPE_AGENT); }
__device__ __forceinline__ unsigned xb_xcc_id() { return (unsigned)__builtin_amdgcn_s_getreg((3 << 11) | 20) & 0xFu; }
#define XB_SPIN(cond, bar) do { unsigned _sp = 0; while (cond) { __builtin_amdgcn_s_sleep(1); \
    if ((++_sp & 255u) == 0u) { if (xb_ld(&(bar)[XB_TMO])) break; if (_sp > XB_SPIN_CAP) { atomicAdd(&(bar)[XB_TMO], 1u); break; } } } } while (0)
struct XcdBarrier { unsigned* bar; unsigned x; volatile LAS unsigned* st; int wave; };
__device__ __forceinline__ XcdBarrier xcd_barrier_post(unsigned* bar, volatile LAS unsigned* st) {
    XcdBarrier b; b.bar = bar; b.x = xb_xcc_id(); b.st = st; b.wave = __builtin_amdgcn_readfirstlane((int)threadIdx.x >> 6);
    if (threadIdx.x == 0) (void)xb_add(&bar[XB_XCNT(b.x)], 1u);
    return b;
}
__device__ __forceinline__ void xcd_barrier_complete(unsigned* bar, unsigned x, unsigned& nloc, unsigned& nx) {
    const unsigned G = gridDim.x * gridDim.y * gridDim.z;
    unsigned sum, cnt, mine, sp = 0u;
    for (;;) {
        sum = 0u; cnt = 0u; mine = 0u;
#pragma unroll
        for (unsigned j = 0; j < 16; ++j) { const unsigned c = xb_ld(&bar[XB_XCNT(j)]); sum += c; cnt += (c > 0u) ? 1u : 0u; mine = (j == x) ? c : mine; }
        if (sum == G) break;
        __builtin_amdgcn_s_sleep(1);
        if ((++sp & 255u) == 0u) { if (xb_ld(&bar[XB_TMO])) break; if (sp > XB_SPIN_CAP) { atomicAdd(&bar[XB_TMO], 1u); break; } }
    }
    nloc = mine > 0u ? mine : 1u; nx = cnt > 0u ? cnt : 1u;
}
__device__ __forceinline__ void xcd_barrier(const XcdBarrier& b) {
    asm volatile("s_waitcnt vmcnt(0)" ::: "memory");
    __syncthreads();
    if (b.wave == 0 && lane_now() == 0) {
        unsigned* bar = b.bar;
        __builtin_amdgcn_s_waitcnt(0);
        unsigned nloc = b.st[0], nx = b.st[1];
        if (nloc == 0u) { xcd_barrier_complete(bar, b.x, nloc, nx); b.st[0] = nloc; b.st[1] = nx; }
        const unsigned old = xb_add(&bar[XB_XSUB(b.x)], 1u);
        const unsigned gen = old / nloc;
        if (old + 1u == (gen + 1u) * nloc) {
            __builtin_amdgcn_fence(__ATOMIC_RELEASE, "agent");
            asm volatile("s_waitcnt vmcnt(0)" ::: "memory");
            const unsigned og = xb_add(&bar[XB_TOP], 1u);
            const unsigned tg = og / nx;
            if (og + 1u == (tg + 1u) * nx) xb_add(&bar[XB_TOPGEN], 1u);
            else XB_SPIN(xb_ld(&bar[XB_TOPGEN]) == tg, bar);
            __builtin_amdgcn_fence(__ATOMIC_ACQUIRE, "agent");
            xb_add(&bar[XB_XGEN(b.x)], 1u);
            asm volatile("s_waitcnt vmcnt(0)" ::: "memory");
        } else {
            XB_SPIN(xb_ld(&bar[XB_XGEN(b.x)]) == gen, bar);
            __builtin_amdgcn_fence(__ATOMIC_ACQUIRE, "agent");
            asm volatile("s_waitcnt vmcnt(0)" ::: "memory");
        }
    }
    __syncthreads();
}

struct Args { const float* in[22]; float* out; unsigned char* ws; };
struct Frame {
    LAS unsigned char* lds;
    volatile LAS unsigned* MISC;
    int wave, vcu, G;
};
#define IN_(k) (args.in[k])
#define A_x IN_(0)
#define A_meta IN_(1)
#define A_ln1_g IN_(2)
#define A_w_in IN_(3)
#define A_conv_w IN_(4)
#define A_conv_b IN_(5)
#define A_rg_wa IN_(6)
#define A_rg_ba IN_(7)
#define A_rg_wx IN_(8)
#define A_rg_bx IN_(9)
#define A_rg_lambda IN_(10)
#define A_hg_lb IN_(11)
#define A_hg_norm_g IN_(12)
#define A_w_pa IN_(13)
#define A_w_pb IN_(14)
#define A_w_out IN_(15)
#define A_ln2_g IN_(16)
#define A_peer_wq IN_(17)
#define A_peer_keys IN_(18)
#define A_peer_u IN_(19)
#define A_peer_v IN_(20)
#define A_final_g IN_(21)
#define A_out (args.out)
#define W_SLAB(i) ((bf16*)(args.ws + WS_SLAB + (size_t)(i) * SLAB_BYTES))
#define W_WinT ((bf16*)args.out)
#define W_XN ((bf16*)args.out + (size_t)INW * DM)
#define W_WpaT ((bf16*)(args.ws + WS_WPA))
#define W_WpbT ((bf16*)(args.ws + WS_WPB))
#define W_WoutT ((bf16*)(args.ws + WS_WOUT))
#define W_WqT ((bf16*)(args.ws + WS_WQ))
#define W_KEYS ((bf16*)(args.ws + WS_KEYS))
#define W_WAT ((bf16*)(args.ws + WS_WA))
#define W_WXT ((bf16*)(args.ws + WS_WX))
#define W_METAPROJ ((bf16*)(args.ws + WS_METAPROJ))
#define W_XNMETA ((bf16*)(args.ws + WS_XNMETA))
#define W_RGSUM ((float*)(args.ws + WS_RGSUM))
#define W_RGHIN ((float*)(args.ws + WS_RGHIN))
#define W_HGDEC ((float*)(args.ws + WS_HGDEC))
#define W_HGMETA ((float*)(args.ws + WS_HGMETA))
#define W_RSP ((float*)(args.ws + WS_RSP))
#define W_PSC ((float*)(args.ws + WS_PSC))
#define W_RSTD2 ((float*)(args.ws + WS_PSC + 256 * 1024))
__device__ __forceinline__ float wave_sum(float v) {
#pragma unroll
    for (int o = 1; o < 64; o <<= 1) v += __shfl_xor(v, o);
    return v;
}
__device__ __forceinline__ float wave_max(float v) {
#pragma unroll
    for (int o = 1; o < 64; o <<= 1) v = fmaxf(v, __shfl_xor(v, o));
    return v;
}
__device__ __forceinline__ f32x4 mma16(f32x4 acc, const LAS unsigned char* a, int lda, const LAS unsigned char* b, int ldb, int K, int lane) {
    const int r = lane & 15, g = lane >> 4;
    const LAS unsigned char* ap = a + r * lda + g * 16; const LAS unsigned char* bp = b + r * ldb + g * 16;
    for (int k0 = 0; k0 < K; k0 += 32) {
        const bf16x8 av = *(const LAS bf16x8*)(ap + k0 * 2); const bf16x8 bv = *(const LAS bf16x8*)(bp + k0 * 2);
        acc = __builtin_amdgcn_mfma_f32_16x16x32_bf16(av, bv, acc, 0, 0, 0);
    }
    return acc;
}
constexpr float W8S = 128.f, X8S = 8.f;
template <bool F8 = false>
__device__ __forceinline__ void p0_transpose_item(const float* W, int K, int N, bf16* WT, LAS float* scr, int item, int lane, const float* rs) {
    const int nblk = N / 64, kb = item / nblk, nb = item % nblk, k0 = 64 * kb, n0 = 64 * nb;
    f32x4 v[16];
#pragma unroll
    for (int i = 0; i < 16; ++i) v[i] = __builtin_nontemporal_load((const f32x4*)(W + (size_t)(k0 + 4 * i + (lane >> 4)) * N + n0 + 4 * (lane & 15)));
#pragma unroll
    for (int i = 0; i < 16; ++i) { const int kk = 4 * i + (lane >> 4); f32x4 w = v[i]; if (rs) w = w * rs[k0 + kk]; *(LAS f32x4*)(scr + kk * 68 + 4 * (lane & 15)) = w; }
    LDS_WAIT(); asm volatile("" ::: "memory");
    const int c = lane & 7;
#pragma unroll
    for (int j = 0; j < 8; ++j) { const int n = (lane >> 3) + 8 * j; const LAS float* sp = scr + (8 * c) * 68 + n;
        if constexpr (F8) {
            int w0 = __builtin_amdgcn_cvt_pk_fp8_f32(sp[0 * 68] * W8S, sp[1 * 68] * W8S, 0, false); w0 = __builtin_amdgcn_cvt_pk_fp8_f32(sp[2 * 68] * W8S, sp[3 * 68] * W8S, w0, true);
            int w1 = __builtin_amdgcn_cvt_pk_fp8_f32(sp[4 * 68] * W8S, sp[5 * 68] * W8S, 0, false); w1 = __builtin_amdgcn_cvt_pk_fp8_f32(sp[6 * 68] * W8S, sp[7 * 68] * W8S, w1, true);
            *(v2u*)((unsigned char*)WT + (size_t)(n0 + n) * K + k0 + 8 * c) = (v2u){(unsigned)w0, (unsigned)w1};
        } else {
        v4u o; o.x = pk2(sp[0 * 68], sp[1 * 68]); o.y = pk2(sp[2 * 68], sp[3 * 68]); o.z = pk2(sp[4 * 68], sp[5 * 68]); o.w = pk2(sp[6 * 68], sp[7 * 68]);
        *(v4u*)(WT + (size_t)(n0 + n) * K + k0 + 8 * c) = o; } }
    LDS_WAIT(); asm volatile("" ::: "memory");
}
__device__ __forceinline__ void rms_row_to_bf16(const float* xrow, const float* g, bf16* orow, int lane) {
    const f32x4* xr = (const f32x4*)xrow + lane; const f32x4* gr = (const f32x4*)g + lane;
    f32x4 v[8]; float s = 0.f;
#pragma unroll
    for (int j = 0; j < 8; ++j) { v[j] = __builtin_nontemporal_load(xr + 64 * j); s += (v[j].x * v[j].x + v[j].y * v[j].y) + (v[j].z * v[j].z + v[j].w * v[j].w); }
    const float rstd = 1.0f / sqrtf(wave_sum(s) * (1.f / DM) + EPS);
    unsigned long long* o8 = (unsigned long long*)orow + lane;
#pragma unroll
    for (int j = 0; j < 8; ++j) { const f32x4 gg = gr[64 * j];
        o8[64 * j] = (unsigned long long)pk2(v[j].x * rstd * gg.x, v[j].y * rstd * gg.y) | ((unsigned long long)pk2(v[j].z * rstd * gg.z, v[j].w * rstd * gg.w) << 32); }
}
__device__ __forceinline__ void rms_row_to_fp8(const float* xrow, const float* g, unsigned char* orow, int lane) {
    const f32x4* xr = (const f32x4*)xrow + lane; const f32x4* gr = (const f32x4*)g + lane;
    f32x4 v[8]; float s = 0.f;
#pragma unroll
    for (int j = 0; j < 8; ++j) { v[j] = __builtin_nontemporal_load(xr + 64 * j); s += (v[j].x * v[j].x + v[j].y * v[j].y) + (v[j].z * v[j].z + v[j].w * v[j].w); }
    const float rstd = X8S / sqrtf(wave_sum(s) * (1.f / DM) + EPS);
    unsigned* o4 = (unsigned*)orow + lane;
#pragma unroll
    for (int j = 0; j < 8; ++j) { const f32x4 gg = gr[64 * j];
        int w = __builtin_amdgcn_cvt_pk_fp8_f32(v[j].x * rstd * gg.x, v[j].y * rstd * gg.y, 0, false); w = __builtin_amdgcn_cvt_pk_fp8_f32(v[j].z * rstd * gg.z, v[j].w * rstd * gg.w, w, true);
        o4[64 * j] = (unsigned)w; }
}
__device__ __forceinline__ void p0_prologue(Frame& F, const Args& args) {
    const int lane_ = lane_now(), tid_ = F.wave * 64 + lane_; (void)tid_;
    LAS float* scr = (LAS float*)(F.lds + F.wave * 17408);
    const int gw = F.vcu * NWAVES + F.wave, NGW = F.G * NWAVES;
    constexpr int I_IN = (DM / 64) * (INW / 64), I_SQ = (DM / 64) * (DM / 64), I_G = 16 * (HD / 64) * (HD / 64);
    constexpr int NITEMS = I_IN + 4 * I_SQ + 2 * I_G;
    for (int it = gw; it < NITEMS; it += NGW) {
        int r = it;
        if (r < I_IN) { p0_transpose_item<true>(A_w_in, DM, INW, W_WinT, scr, r, lane_, nullptr); continue; } r -= I_IN;
        if (r < I_SQ) { p0_transpose_item(A_w_pa, DM, DM, W_WpaT, scr, r, lane_, nullptr); continue; } r -= I_SQ;
        if (r < I_SQ) { p0_transpose_item(A_w_pb, DM, DM, W_WpbT, scr, r, lane_, nullptr); continue; } r -= I_SQ;
        if (r < I_SQ) { p0_transpose_item(A_w_out, DM, DM, W_WoutT, scr, r, lane_, nullptr); continue; } r -= I_SQ;
        if (r < I_SQ) { p0_transpose_item(A_peer_wq, DM, DM, W_WqT, scr, r, lane_, A_ln2_g); continue; } r -= I_SQ;
        if (r < I_G) { const int h = r / 4; p0_transpose_item(A_rg_wa + (size_t)h * HD * HD, HD, HD, W_WAT + (size_t)h * HD * HD, scr, r % 4, lane_, nullptr); continue; } r -= I_G;
        { const int h = r / 4; p0_transpose_item(A_rg_wx + (size_t)h * HD * HD, HD, HD, W_WXT + (size_t)h * HD * HD, scr, r % 4, lane_, nullptr); }
    }
    for (int m = gw; m < M + NMETA; m += NGW) {
        if (m < M) rms_row_to_fp8(A_x + (size_t)m * DM, A_ln1_g, (unsigned char*)W_XN + (size_t)m * DM, lane_);
        else rms_row_to_bf16(A_meta + (size_t)(m - M) * DM, A_ln1_g, W_XNMETA + (size_t)(m - M) * DM, lane_);
    }
    for (int i = (F.vcu * NWAVES * 64 + tid_); i < PH * 2 * NKEY * 128 / 2; i += F.G * NWAVES * 64) {
        const f32x2 k2 = ((const f32x2*)A_peer_keys)[i]; ((unsigned*)W_KEYS)[i] = pk2(k2.x, k2.y); }
}

__device__ __forceinline__ void p1_meta(Frame& F, const Args& args) {
    const int lane_ = lane_now(), tid_ = F.wave * 64 + lane_; (void)tid_;
    const int gw = F.vcu * NWAVES + F.wave, NGW = F.G * NWAVES, r = lane_ & 15, g = lane_ >> 4;
    for (int it = (gw & 1) ? INW : (gw >> 1); it < INW / 16; it += (NGW >> 1)) {
        const int n0 = it * 16;
        const bf16* ap = W_XNMETA + (size_t)r * DM + 8 * g; const unsigned char* bp = (const unsigned char*)W_WinT + (size_t)(n0 + r) * DM + 8 * g;
        f32x4 acc = (f32x4){0.f, 0.f, 0.f, 0.f};
#pragma unroll 16
        for (int k0 = 0; k0 < DM; k0 += 32) { const bf16x8 a = *(const bf16x8*)(ap + k0); const v2u b8 = *(const v2u*)(bp + k0);
            const f32x2 b0 = __builtin_amdgcn_cvt_pk_f32_fp8((int)b8.x, false), b1 = __builtin_amdgcn_cvt_pk_f32_fp8((int)b8.x, true), b2 = __builtin_amdgcn_cvt_pk_f32_fp8((int)b8.y, false), b3 = __builtin_amdgcn_cvt_pk_f32_fp8((int)b8.y, true);
            v4u bw; bw.x = pk2(b0[0], b0[1]); bw.y = pk2(b1[0], b1[1]); bw.z = pk2(b2[0], b2[1]); bw.w = pk2(b3[0], b3[1]);
            acc = __builtin_amdgcn_mfma_f32_16x16x32_bf16(a, __builtin_bit_cast(bf16x8, bw), acc, 0, 0, 0); }
#pragma unroll
        for (int j = 0; j < 4; ++j) W_METAPROJ[(size_t)(4 * g + j) * INW + n0 + r] = (bf16)f2bf(acc[j] * (1.0f / W8S));
    }
}

template <int MODE, bool DUMMY, int VAR = 0>
__device__ __forceinline__ void rg_wave_item(const Args& args, const LAS unsigned char* WAl, const LAS unsigned char* WXl, LAS unsigned char* YL, const LAS float* CST, int h, int b, int c, bool meta, int lane) {
    const int r = lane & 15, g = lane >> 4;
    const int nhalf = meta ? 1 : 2, ntile = meta ? 1 : 2;
    bf16x8 SEL0, SEL1;
#pragma unroll
    for (int j = 0; j < 8; ++j) { SEL0[j] = (8 * g + j == r) ? (short)0x3F80 : (short)0; SEL1[j] = (8 * g + j == 16 + r) ? (short)0x3F80 : (short)0; }
    float hc[8], pt[8];
#pragma unroll
    for (int ct = 0; ct < 8; ++ct) { hc[ct] = (MODE == 1) ? W_RGHIN[(size_t)(b * NCH + c) * DM + h * HD + 16 * ct + r] : 0.f; pt[ct] = 1.f; }
#pragma unroll 1
    for (int hf = 0; hf < nhalf; ++hf) {
        v4u yr[8];
        if (MODE == 1) {
#pragma unroll
            for (int i = 0; i < 8; ++i) yr[i] = *(const v4u*)(W_SLAB(SL_YA) + (size_t)(b * SEQ + c * CH + 32 * hf + 4 * i + (lane >> 4)) * DM + h * HD + 8 * (lane & 15));
        }
        bf16x8 A[2][4];
        v4u xrb[2][4][4];
#pragma unroll
        for (int rt = 0; rt < 2; ++rt) {
            if (MODE == 0 && rt < ntile) {
                const int t = 32 * hf + 16 * rt + r;
#pragma unroll
                for (int k = 0; k < 4; ++k) {
                    const bf16* rowp; bool valid = true;
                    if (meta) { const int s = t + k - 3; valid = s >= 0; rowp = W_METAPROJ + (size_t)(valid ? s : 0) * INW; }
                    else { const int s = c * CH + t + k - 3; rowp = (s >= 0) ? W_SLAB(SL_XA) + (size_t)(b * SEQ + s) * DM : W_METAPROJ + (size_t)(NMETA + s) * INW; }
#pragma unroll
                    for (int ks = 0; ks < 4; ++ks) { v4u xw = *(const v4u*)(rowp + h * HD + 32 * ks + 8 * g); if (!valid) xw = (v4u){0u, 0u, 0u, 0u}; xrb[rt][ks][k] = xw; }
                }
            }
        }
        __builtin_amdgcn_sched_barrier(0);
#pragma unroll
        for (int rt = 0; rt < 2; ++rt) {
            if (rt < ntile) {
                if (MODE == 1) {
                const int t = 32 * hf + 16 * rt + r;
#pragma unroll
                for (int k = 0; k < 4; ++k) {
                    const bf16* rowp; bool valid = true;
                    if (meta) { const int s = t + k - 3; valid = s >= 0; rowp = W_METAPROJ + (size_t)(valid ? s : 0) * INW; }
                    else { const int s = c * CH + t + k - 3; rowp = (s >= 0) ? W_SLAB(SL_XA) + (size_t)(b * SEQ + s) * DM : W_METAPROJ + (size_t)(NMETA + s) * INW; }
#pragma unroll
                    for (int ks = 0; ks < 4; ++ks) { v4u xw = *(const v4u*)(rowp + h * HD + 32 * ks + 8 * g); if (!valid) xw = (v4u){0u, 0u, 0u, 0u}; xrb[rt][ks][k] = xw; }
                }
                __builtin_amdgcn_sched_barrier(0); }
#pragma unroll
                for (int ks = 0; ks < 4; ++ks) {
                    f32x4 a0 = *(const LAS f32x4*)(CST + 896 + 32 * ks + 8 * g), a1 = *(const LAS f32x4*)(CST + 896 + 32 * ks + 8 * g + 4);
#pragma unroll
                    for (int k = 0; k < 4; ++k) { const v4u xw = xrb[rt][ks][k];
                        const f32x4 w0 = *(const LAS f32x4*)(CST + 384 + k * 128 + 32 * ks + 8 * g), w1 = *(const LAS f32x4*)(CST + 384 + k * 128 + 32 * ks + 8 * g + 4);
                        a0 += w0 * (f32x4){bflo(xw.x), bfhi(xw.x), bflo(xw.y), bfhi(xw.y)};
                        a1 += w1 * (f32x4){bflo(xw.z), bfhi(xw.z), bflo(xw.w), bfhi(xw.w)}; }
                    v4u pk; pk.x = pk2(a0[0], a0[1]); pk.y = pk2(a0[2], a0[3]); pk.z = pk2(a1[0], a1[1]); pk.w = pk2(a1[2], a1[3]);
                    A[rt][ks] = __builtin_bit_cast(bf16x8, pk);
                }
                __builtin_amdgcn_sched_barrier(0);
            } else {
#pragma unroll
                for (int ks = 0; ks < 4; ++ks) A[rt][ks] = (bf16x8){0, 0, 0, 0, 0, 0, 0, 0};
            }
        }
        if (MODE == 1) {
#pragma unroll
            for (int i = 0; i < 8; ++i) { v4u gw;
#pragma unroll
                for (int w = 0; w < 4; ++w) { const pg8::f32x2 gl = pg8::gelu_pk((pg8::f32x2){bflo(yr[i][w]), bfhi(yr[i][w])}); gw[w] = pk2(gl.x, gl.y); }
                *(LAS v4u*)(YL + (4 * i + (lane >> 4)) * 272 + 16 * (lane & 15)) = gw; }
        }
#pragma unroll
        for (int ct = 0; ct < 8; ++ct) {
            const int col = h * HD + 16 * ct + r;
            const float ba = CST[16 * ct + r], bx = CST[128 + 16 * ct + r], sp2 = CST[256 + 16 * ct + r];
            bf16x8 wa[4], wx[4];
#pragma unroll
            for (int ks = 0; ks < 4; ++ks) { wa[ks] = *(const LAS bf16x8*)(WAl + (16 * ct + r) * 272 + ks * 64 + g * 16); wx[ks] = *(const LAS bf16x8*)(WXl + (16 * ct + r) * 272 + ks * 64 + g * 16); }
#pragma unroll
            for (int rt = 0; rt < 2; ++rt) {
                if (rt < ntile) {
                    f32x4 R = (f32x4){0.f, 0.f, 0.f, 0.f}, I = R, XC = R;
#pragma unroll
                    for (int ks = 0; ks < 4; ++ks) { if (VAR == 4 && ks > 0) continue; R = __builtin_amdgcn_mfma_f32_16x16x32_bf16(A[rt][ks], wa[ks], R, 0, 0, 0); I = __builtin_amdgcn_mfma_f32_16x16x32_bf16(A[rt][ks], wx[ks], I, 0, 0, 0); }
                    XC = __builtin_amdgcn_mfma_f32_16x16x32_bf16(A[rt][ct >> 1], (ct & 1) ? SEL1 : SEL0, XC, 0, 0, 0);
                    float av[4], uv[4];
#pragma unroll
                    for (int j = 0; j < 4; ++j) {
                        const float rr = sigm(R[j] + ba), ii = sigm(I[j] + bx);
                        av[j] = __builtin_amdgcn_exp2f(sp2 * rr); uv[j] = __builtin_amdgcn_sqrtf((1.0f - av[j]) * (1.0f + av[j])) * ii * XC[j]; }
                    const float P = (av[0] * av[1]) * (av[2] * av[3]);
                    const float U = ((uv[0] * av[1] + uv[1]) * av[2] + uv[2]) * av[3] + uv[3];
                    const float P0 = (VAR == 2) ? P : __shfl(P, r), P1 = (VAR == 2) ? P : __shfl(P, r + 16), P2 = (VAR == 2) ? P : __shfl(P, r + 32), P3 = (VAR == 2) ? P : __shfl(P, r + 48);
                    const float U0 = (VAR == 2) ? U : __shfl(U, r), U1 = (VAR == 2) ? U : __shfl(U, r + 16), U2 = (VAR == 2) ? U : __shfl(U, r + 32), U3 = (VAR == 2) ? U : __shfl(U, r + 48);
                    const float h0 = hc[ct], h1 = P0 * h0 + U0, h2 = P1 * h1 + U1, h3 = P2 * h2 + U2, he = P3 * h3 + U3;
                    if (MODE == 1) {
                        float hh = (g == 0) ? h0 : (g == 1) ? h1 : (g == 2) ? h2 : h3;
#pragma unroll
                        for (int j = 0; j < 4; j += 2) { const int tl = 16 * rt + 4 * g + j;
                            const float hA = av[j] * hh + uv[j], hB = av[j + 1] * hA + uv[j + 1]; hh = hB;
                            LAS bf16* yp = (LAS bf16*)(YL + tl * 272 + (16 * ct + r) * 2);
                            const unsigned pw = pk2(bf1(yp[0]) * hA, bf1(yp[136]) * hB);
                            yp[0] = (bf16)(pw & 0xffffu); yp[136] = (bf16)(pw >> 16); }
                    }
                    hc[ct] = he; pt[ct] *= (P0 * P1) * (P2 * P3);
                }
            }
            if (ct & 1) __builtin_amdgcn_sched_barrier(0);
        }
        if (MODE == 1) {
#pragma unroll
            for (int i = 0; i < 8; ++i) { const v4u yv = *(const LAS v4u*)(YL + (4 * i + (lane >> 4)) * 272 + 16 * (lane & 15));
                const size_t eo = (size_t)(b * SEQ + c * CH + 32 * hf + 4 * i + (lane >> 4)) * DM + h * HD + 8 * (lane & 15);
                bf16* yo = DUMMY ? (bf16*)(args.ws + WS_END) + (eo & (size_t)(4 * MiB - 1)) : W_SLAB(SL_YA) + eo;
                *(v4u*)yo = yv; }
        }
    }
    if (MODE == 0 && g == 0) {
#pragma unroll
        for (int ct = 0; ct < 8; ++ct) { const int col = h * HD + 16 * ct + r;
            const size_t o = meta ? ((size_t)BATCH * NCH * DM + col) : ((size_t)(b * NCH + c) * DM + col);
            ((f32x2*)W_RGSUM)[o] = (f32x2){pt[ct], hc[ct]}; }
    }
}
template <int MODE, bool DUMMY = false, int VAR = 0>
__device__ __forceinline__ void rg_phase(Frame& F, const Args& args) {
    const int lane_ = lane_now(), tid_ = F.wave * 64 + lane_; (void)tid_;
    LAS unsigned char* WAl = F.lds;
    LAS unsigned char* WXl = F.lds + 34816;
    LAS unsigned char* YL = F.lds + 69632 + F.wave * 8704;
    LAS float* CST = (LAS float*)(F.lds + 139264);
    const int nit = BATCH * NCH * NH, per = (nit + F.G - 1) / F.G;
    const int it0 = F.vcu * per, it1 = (it0 + per < nit) ? it0 + per : nit;
    for (int seg0 = it0; seg0 < it1;) {
        const int h = seg0 >> 8, hend = (h + 1) << 8, seg1 = hend < it1 ? hend : it1;
        __syncthreads();
        { const v4u* ga = (const v4u*)(W_WAT + (size_t)h * HD * HD); const v4u* gx = (const v4u*)(W_WXT + (size_t)h * HD * HD);
#pragma unroll
          for (int i = 0; i < 4; ++i) { const int p = tid_ + 512 * i, row = p >> 4, c16 = p & 15;
              *(LAS v4u*)(WAl + row * 272 + c16 * 16) = ga[p]; *(LAS v4u*)(WXl + row * 272 + c16 * 16) = gx[p]; } }
        if (tid_ < HD) { const int col = h * HD + tid_; CST[tid_] = A_rg_ba[col]; CST[128 + tid_] = A_rg_bx[col]; CST[256 + tid_] = -8.0f * 1.44269504f * log1pf(__expf(-A_rg_lambda[col]));
#pragma unroll
            for (int k = 0; k < 4; ++k) CST[384 + k * 128 + tid_] = A_conv_w[(size_t)k * DM + col];
            CST[896 + tid_] = A_conv_b[col]; }
        __syncthreads();
        for (int it = seg0 + F.wave; it < seg1; it += NWAVES) {
            const int bc = it & 255, b = bc >> 6, c = bc & 63;
            if (MODE == 0 && bc == 0) rg_wave_item<MODE, DUMMY, VAR>(args, WAl, WXl, YL, CST, h, 0, 0, true, lane_);
            rg_wave_item<MODE, DUMMY, VAR>(args, WAl, WXl, YL, CST, h, b, c, false, lane_);
        }
        seg0 = seg1;
    }
    __syncthreads();
}
constexpr int NSC = NCH / 2;
struct HgRaw { unsigned fw[8], vw[8], qw[8]; v4u stw[4]; v2u ogw[4]; };
struct HgU { bool meta; int b, h, c, sub; };
template <int MODE>
__device__ __forceinline__ void hg_load(HgRaw& R, const Args& args, const bf16* ST, const HgU& u, int tid_, int lane_, int w) {
    const bool meta = u.meta; const int b = u.b, h = u.h, c = u.c, bh = b * NH + h;
    const int kp = w * 8 + (lane_ & 7), sg = lane_ >> 3, r = lane_ & 15, g = lane_ >> 4, col = h * HD + 2 * kp;
#pragma unroll
    for (int i = 0; i < 8; ++i) { const int s = 8 * sg + i;
        if (meta) { const bool valid = s < NMETA; const size_t ro = (size_t)(valid ? s : 0) * INW + col;
            const unsigned f = *(const unsigned*)(W_METAPROJ + ro + 3 * DM), v = *(const unsigned*)(W_METAPROJ + ro + 4 * DM); R.fw[i] = valid ? f : 0u; R.vw[i] = valid ? v : 0u; if (MODE == 1) R.qw[i] = 0u; }
        else { const size_t ro = (size_t)(b * SEQ + c * CH + s) * DM + col; R.fw[i] = *(const unsigned*)(W_SLAB(SL_F) + ro); R.vw[i] = *(const unsigned*)(W_SLAB(SL_I) + ro);
               if (MODE == 1) R.qw[i] = *(const unsigned*)(W_SLAB(SL_Q) + ro); } }
    if (MODE == 1) {
        if (u.sub == 0) { const v4u* gs = (const v4u*)(ST + ((size_t)(bh * NSC + (c >> 1))) * HD * HD);
#pragma unroll
            for (int i = 0; i < 4; ++i) R.stw[i] = gs[tid_ + 512 * i]; }
#pragma unroll
        for (int tt = 0; tt < 4; ++tt) R.ogw[tt] = *(const v2u*)(W_SLAB(SL_OG) + (size_t)(b * SEQ + c * CH + 16 * tt + r) * DM + h * HD + 16 * w + 4 * g); }
}
__device__ __forceinline__ float hg_sum_rows4(float v) {
    { const auto r_ = __builtin_amdgcn_permlane16_swap(__float_as_uint(v), __float_as_uint(v), false, false); v = __uint_as_float(r_[0]) + __uint_as_float(r_[1]); }
    { const auto r_ = __builtin_amdgcn_permlane32_swap(__float_as_uint(v), __float_as_uint(v), false, false); v = __uint_as_float(r_[0]) + __uint_as_float(r_[1]); }
    return v;
}
template <int MODE, bool DUMMY = false>
__device__ __forceinline__ void hg_phase(Frame& F, const Args& args, bf16* ST) {
    const int lane_ = lane_now(), tid_ = F.wave * 64 + lane_; (void)tid_;
    LAS unsigned char* VT = F.lds;
    LAS unsigned char* KDT = F.lds + (MODE == 0 ? 22528 : 120832);
    LAS unsigned char* QDEC = F.lds + 22528;
    LAS unsigned char* QD2 = F.lds + 39936;
    LAS unsigned char* KD2 = F.lds + 57344;
    LAS unsigned char* STl = F.lds + 74752;
    LAS unsigned char* PB = F.lds + 109568;
    LAS float* SSQ = (LAS float*)(F.lds + 118784);
    LAS float* DECl = (LAS float*)(F.lds + 139264);
    const int w = F.wave, kp = w * 8 + (lane_ & 7), sg = lane_ >> 3, r = lane_ & 15, g = lane_ >> 4;
    const int nsi = BATCH * NH * NSC;
    const int nmine = (F.vcu < nsi) ? (nsi - 1 - F.vcu) / F.G + 1 : 0;
    const bool hasmeta = (MODE == 0) && (F.vcu < NH);
    const int nunits = (hasmeta ? 1 : 0) + 2 * nmine;
    auto unit_of = [&](int q) -> HgU { HgU u; if (hasmeta) { if (q == 0) { u.meta = true; u.b = 0; u.h = F.vcu; u.c = 0; u.sub = 0; return u; } q -= 1; }
        const int sit = F.vcu + (q >> 1) * F.G; u.meta = false; u.h = sit & 15; u.b = sit >> 9; u.sub = q & 1; u.c = 2 * ((sit >> 4) & 31) + u.sub; return u; };
    HgRaw cur, nxt;
    f32x4 Sacc[8]; float tA0 = 0.f, tA1 = 0.f;
    if (nunits > 0) hg_load<MODE>(cur, args, ST, unit_of(0), tid_, lane_, w);
    const int hfix = F.vcu & (NH - 1);
    float lbf0, lbf1;
    { const int colf = hfix * HD + 2 * kp; const f32x2 l0 = *(const f32x2*)(A_hg_lb + colf), l1 = *(const f32x2*)(A_hg_lb + DM + colf); lbf0 = 1.0f / (1.0f + __expf(l1.x - l0.x)); lbf1 = 1.0f / (1.0f + __expf(l1.y - l0.y)); }
    f32x4 ngf = (f32x4){0.f, 0.f, 0.f, 0.f};
    if (MODE == 1) ngf = *(const f32x4*)(A_hg_norm_g + hfix * HD + 16 * w + 4 * g);
    for (int q = 0; q < nunits; ++q) {
        const HgU u = unit_of(q);
        const bool meta = u.meta; const int b = u.b, h = u.h, c = u.c, sub = u.sub, bh = b * NH + h, sc = c >> 1;
        const int col = h * HD + 2 * kp;
        __syncthreads();
        float lb0 = lbf0, lb1 = lbf1;
        if (h != hfix) { const f32x2 l0 = *(const f32x2*)(A_hg_lb + col), l1 = *(const f32x2*)(A_hg_lb + DM + col); lb0 = 1.0f / (1.0f + __expf(l1.x - l0.x)); lb1 = 1.0f / (1.0f + __expf(l1.y - l0.y)); }
        float cs0[8], cs1[8], kk0[8], kk1[8];
        float run0 = 0.f, run1 = 0.f;
#pragma unroll
        for (int i = 0; i < 8; ++i) {
            const int s = 8 * sg + i; const unsigned fw = cur.fw[i]; const bool valid = !meta || s < NMETA;
            const float f0 = lb0 + (1.0f - lb0) * sigm(bflo(fw)), f1 = lb1 + (1.0f - lb1) * sigm(bfhi(fw));
            const float l0 = valid ? __logf(f0) : 0.f, l1 = valid ? __logf(f1) : 0.f;
            kk0[i] = valid ? 1.0f - f0 : 0.f; kk1[i] = valid ? 1.0f - f1 : 0.f;
            run0 += l0; run1 += l1; cs0[i] = run0; cs1[i] = run1;
        }
        float inc0 = run0, inc1 = run1;
        { float t0 = __shfl_up(inc0, 8), t1 = __shfl_up(inc1, 8); if (sg >= 1) { inc0 += t0; inc1 += t1; }
          t0 = __shfl_up(inc0, 16); t1 = __shfl_up(inc1, 16); if (sg >= 2) { inc0 += t0; inc1 += t1; }
          t0 = __shfl_up(inc0, 32); t1 = __shfl_up(inc1, 32); if (sg >= 4) { inc0 += t0; inc1 += t1; } }
        const float pre0 = inc0 - run0, pre1 = inc1 - run1;
        const float tot0 = __shfl(inc0, lane_ | 56), tot1 = __shfl(inc1, lane_ | 56), ref0 = __shfl(inc0, (lane_ & 7) | 24), ref1 = __shfl(inc1, (lane_ & 7) | 24);
        { v4u p0, p1;
          p0.x = (cur.vw[0] & 0xffffu) | (cur.vw[1] << 16); p0.y = (cur.vw[2] & 0xffffu) | (cur.vw[3] << 16); p0.z = (cur.vw[4] & 0xffffu) | (cur.vw[5] << 16); p0.w = (cur.vw[6] & 0xffffu) | (cur.vw[7] << 16);
          p1.x = (cur.vw[0] >> 16) | (cur.vw[1] & 0xffff0000u); p1.y = (cur.vw[2] >> 16) | (cur.vw[3] & 0xffff0000u); p1.z = (cur.vw[4] >> 16) | (cur.vw[5] & 0xffff0000u); p1.w = (cur.vw[6] >> 16) | (cur.vw[7] & 0xffff0000u);
          *(LAS v4u*)(VT + (2 * kp) * 144 + sg * 16) = p0; *(LAS v4u*)(VT + (2 * kp + 1) * 144 + sg * 16) = p1; }
        if (MODE == 0 || sub == 0) {
            float d0[8], d1[8];
#pragma unroll
            for (int i = 0; i < 8; ++i) { d0[i] = kk0[i] * __expf(tot0 - (pre0 + cs0[i])); d1[i] = kk1[i] * __expf(tot1 - (pre1 + cs1[i])); }
            v4u p0, p1;
            p0.x = pk2(d0[0], d0[1]); p0.y = pk2(d0[2], d0[3]); p0.z = pk2(d0[4], d0[5]); p0.w = pk2(d0[6], d0[7]);
            p1.x = pk2(d1[0], d1[1]); p1.y = pk2(d1[2], d1[3]); p1.z = pk2(d1[4], d1[5]); p1.w = pk2(d1[6], d1[7]);
            *(LAS v4u*)(KDT + (2 * kp) * 144 + sg * 16) = p0; *(LAS v4u*)(KDT + (2 * kp + 1) * 144 + sg * 16) = p1;
        }
        if (sg == 0) *(LAS f32x2*)(DECl + 2 * kp) = (f32x2){__expf(tot0), __expf(tot1)};
        if (MODE == 0) {
            if (q + 1 < nunits) hg_load<MODE>(nxt, args, ST, unit_of(q + 1), tid_, lane_, w);
            __syncthreads();
#pragma unroll
            for (int kt = 0; kt < 8; ++kt) {
                f32x4 acc = (f32x4){0.f, 0.f, 0.f, 0.f};
                acc = mma16(acc, KDT + kt * 16 * 144, 144, VT + w * 16 * 144, 144, CH, lane_);
                const int v = 16 * w + r, k0 = 16 * kt + 4 * g;
                if (meta) *(f32x4*)(W_HGMETA + ((size_t)h * HD + v) * HD + k0) = acc;
                else if (sub == 0) Sacc[kt] = acc;
                else { const f32x4 dc = *(const LAS f32x4*)(DECl + k0); const f32x4 sv = dc * Sacc[kt] + acc;
                    v2u o; o.x = pk2(sv[0], sv[1]); o.y = pk2(sv[2], sv[3]); *(v2u*)(ST + (((size_t)(bh * NSC + sc)) * HD + v) * HD + k0) = o; }
            }
            if (!meta) { if (sub == 0) { tA0 = tot0; tA1 = tot1; } else if (sg == 0) *(f32x2*)(W_HGDEC + (size_t)(bh * NSC + sc) * HD + 2 * kp) = (f32x2){__expf(tA0 + tot0), __expf(tA1 + tot1)}; }
        } else {
#pragma unroll
            for (int i = 0; i < 8; ++i) { const int s = 8 * sg + i;
                const float q0 = bflo(cur.qw[i]), q1 = bfhi(cur.qw[i]), qs0 = q0 * sigm(q0), qs1 = q1 * sigm(q1);
                const float bc0 = pre0 + cs0[i], bc1 = pre1 + cs1[i];
                *(LAS unsigned*)(QDEC + s * 272 + 4 * kp) = pk2(qs0 * __expf(bc0), qs1 * __expf(bc1));
                *(LAS unsigned*)(QD2 + s * 272 + 4 * kp) = pk2(qs0 * __expf(fminf(bc0 - ref0, 80.f)), qs1 * __expf(fminf(bc1 - ref1, 80.f)));
                *(LAS unsigned*)(KD2 + s * 272 + 4 * kp) = pk2(kk0[i] * __expf(fminf(ref0 - bc0, 80.f)), kk1[i] * __expf(fminf(ref1 - bc1, 80.f))); }
            if (sub == 0) {
#pragma unroll
                for (int i = 0; i < 4; ++i) { const int p = tid_ + 512 * i, row = p >> 4, c16 = p & 15; *(LAS v4u*)(STl + row * 272 + c16 * 16) = cur.stw[i]; } }
            if (q + 1 < nunits) hg_load<MODE>(nxt, args, ST, unit_of(q + 1), tid_, lane_, w);
            __syncthreads();
            { const int tt = w >> 1;
#pragma unroll
              for (int e = 0; e < 2; ++e) { const int st = 2 * (w & 1) + e; f32x4 acc = (f32x4){0.f, 0.f, 0.f, 0.f};
                  if (st <= tt) acc = mma16(acc, KD2 + st * 16 * 272, 272, QD2 + tt * 16 * 272, 272, HD, lane_);
                  const int t = 16 * tt + r, s0 = 16 * st + 4 * g;
#pragma unroll
                  for (int j = 0; j < 4; ++j) if (s0 + j > t) acc[j] = 0.f;
                  v2u o; o.x = pk2(acc[0], acc[1]); o.y = pk2(acc[2], acc[3]); *(LAS v2u*)(PB + t * 144 + s0 * 2) = o; } }
            __syncthreads();
            f32x4 o4[4];
#pragma unroll
            for (int tt = 0; tt < 4; ++tt) { f32x4 acc = (f32x4){0.f, 0.f, 0.f, 0.f};
                acc = mma16(acc, STl + w * 16 * 272, 272, QDEC + tt * 16 * 272, 272, HD, lane_);
                acc = mma16(acc, VT + w * 16 * 144, 144, PB + tt * 16 * 144, 144, CH, lane_);
                o4[tt] = acc;
                float qq = (acc[0] * acc[0] + acc[1] * acc[1]) + (acc[2] * acc[2] + acc[3] * acc[3]);
                qq = hg_sum_rows4(qq);
                if (g == 0) SSQ[(16 * tt + r) * 8 + w] = qq; }
            __syncthreads();
            if (sub == 0) {
#pragma unroll
                for (int kt = 0; kt < 8; ++kt) {
                    f32x4 acc = (f32x4){0.f, 0.f, 0.f, 0.f};
                    acc = mma16(acc, KDT + kt * 16 * 144, 144, VT + w * 16 * 144, 144, CH, lane_);
                    LAS v2u* sp = (LAS v2u*)(STl + (16 * w + r) * 272 + (16 * kt + 4 * g) * 2);
                    const v2u sw = *sp; const f32x4 dc = *(const LAS f32x4*)(DECl + 16 * kt + 4 * g);
                    v2u o; o.x = pk2(dc[0] * bflo(sw.x) + acc[0], dc[1] * bfhi(sw.x) + acc[1]); o.y = pk2(dc[2] * bflo(sw.y) + acc[2], dc[3] * bfhi(sw.y) + acc[3]);
                    *sp = o; }
            }
            const f32x4 ng = (h == hfix) ? ngf : *(const f32x4*)(A_hg_norm_g + h * HD + 16 * w + 4 * g);
#pragma unroll
            for (int tt = 0; tt < 4; ++tt) { const int t = 16 * tt + r;
                const f32x4 sa = *(const LAS f32x4*)(SSQ + t * 8), sb = *(const LAS f32x4*)(SSQ + t * 8 + 4);
                const float rs = __builtin_amdgcn_rsqf(((sa[0] + sa[1]) + (sa[2] + sa[3]) + (sb[0] + sb[1]) + (sb[2] + sb[3])) * (1.0f / HD) + EPS);
                v2u* op = (v2u*)(W_SLAB(SL_OG) + (size_t)(b * SEQ + c * CH + t) * DM + h * HD + 16 * w + 4 * g);
                const v2u ow = cur.ogw[tt]; const float g0 = bflo(ow.x), g1 = bfhi(ow.x), g2 = bflo(ow.y), g3 = bfhi(ow.y);
                v2u y; y.x = pk2(o4[tt][0] * rs * ng[0] * (g0 * sigm(g0)), o4[tt][1] * rs * ng[1] * (g1 * sigm(g1)));
                y.y = pk2(o4[tt][2] * rs * ng[2] * (g2 * sigm(g2)), o4[tt][3] * rs * ng[3] * (g3 * sigm(g3)));
                if (DUMMY) *(v2u*)((bf16*)(args.ws + WS_END) + ((((size_t)(b * SEQ + c * CH + t) * DM + h * HD + 16 * w + 4 * g)) & (size_t)(4 * MiB - 1))) = y; else *op = y; }
        }
#pragma unroll
        for (int i = 0; i < 8; ++i) { cur.fw[i] = nxt.fw[i]; cur.vw[i] = nxt.vw[i]; if (MODE == 1) cur.qw[i] = nxt.qw[i]; }
        if (MODE == 1) {
#pragma unroll
            for (int i = 0; i < 4; ++i) { cur.stw[i] = nxt.stw[i]; cur.ogw[i] = nxt.ogw[i]; } }
    }
}
__device__ __forceinline__ void hg_carry(Frame& F, const Args& args, bf16* ST) {
    const int lane_ = lane_now(), tid_ = F.wave * 64 + lane_; (void)tid_;
    const int rgid = F.vcu * 32 + lane_; const bool rgon = (F.wave == 0) && (lane_ < 32) && (rgid < BATCH * DM);
    const int rb = rgid >> 11, rcol = rgid & (DM - 1);
    float rh = rgon ? ((const f32x2*)W_RGSUM)[(size_t)BATCH * NCH * DM + rcol].y : 0.f;
    for (int gid = F.vcu * NWAVES * 64 + tid_; gid < BATCH * NH * HD * (HD / 8); gid += F.G * NWAVES * 64) {
        const int k8 = gid & 15, v = (gid >> 4) & 127, bh = gid >> 11, h = bh & 15;
        float S[8];
        { const f32x4 a = *(const f32x4*)(W_HGMETA + ((size_t)h * HD + v) * HD + 8 * k8), b2 = *(const f32x4*)(W_HGMETA + ((size_t)h * HD + v) * HD + 8 * k8 + 4);
          S[0] = a[0]; S[1] = a[1]; S[2] = a[2]; S[3] = a[3]; S[4] = b2[0]; S[5] = b2[1]; S[6] = b2[2]; S[7] = b2[3]; }
        v4u* p0 = (v4u*)(ST + (((size_t)(bh * NSC)) * HD + v) * HD + 8 * k8);
        const f32x4* d0 = (const f32x4*)(W_HGDEC + (size_t)(bh * NSC) * HD + 8 * k8);
        const bool rgit = rgon && gid < F.G * NWAVES * 64;
        for (int c0 = 0; c0 < NSC; c0 += 8) {
            v4u d[8]; f32x4 da[8], db[8]; f32x2 sv[16];
            const int rc0 = 2 * c0;
            if (rgit) {
#pragma unroll
                for (int i = 0; i < 16; ++i) sv[i] = ((const f32x2*)W_RGSUM)[(size_t)(rb * NCH + rc0 + i) * DM + rcol]; }
#pragma unroll
            for (int i = 0; i < 8; ++i) { d[i] = p0[(size_t)(c0 + i) * 2048]; da[i] = d0[(c0 + i) * 32]; db[i] = d0[(c0 + i) * 32 + 1]; }
            if (rgit) {
#pragma unroll
                for (int i = 0; i < 16; ++i) { W_RGHIN[(size_t)(rb * NCH + rc0 + i) * DM + rcol] = rh; rh = sv[i].x * rh + sv[i].y; } }
#pragma unroll
            for (int i = 0; i < 8; ++i) {
                v4u o; o.x = pk2(S[0], S[1]); o.y = pk2(S[2], S[3]); o.z = pk2(S[4], S[5]); o.w = pk2(S[6], S[7]); p0[(size_t)(c0 + i) * 2048] = o;
                S[0] = da[i][0] * S[0] + bflo(d[i].x); S[1] = da[i][1] * S[1] + bfhi(d[i].x); S[2] = da[i][2] * S[2] + bflo(d[i].y); S[3] = da[i][3] * S[3] + bfhi(d[i].y);
                S[4] = db[i][0] * S[4] + bflo(d[i].z); S[5] = db[i][1] * S[5] + bfhi(d[i].z); S[6] = db[i][2] * S[6] + bflo(d[i].w); S[7] = db[i][3] * S[7] + bfhi(d[i].w);
            }
        }
    }
}

__device__ __forceinline__ void p3_convert_uv(Frame& F, const Args& args) {
    const int lane_ = lane_now(), tid_ = F.wave * 64 + lane_; (void)tid_;
    const int gw = F.vcu * NWAVES + F.wave, NGW = F.G * NWAVES, lane = lane_;
    unsigned char* U8 = (unsigned char*)W_SLAB(SL_UB); unsigned char* V8 = (unsigned char*)W_SLAB(SL_VB);
    for (int it = gw; it < 2 * NEXP; it += NGW) {
        const bool isv = it >= NEXP; const int e = isv ? it - NEXP : it;
        const float* src = (isv ? A_peer_v : A_peer_u) + (size_t)e * DM;
        f32x4 a[8];
        { LAS f32x4* T = (LAS f32x4*)(F.lds + F.wave * 8192);
          f32x4 raw[8];
#pragma unroll
          for (int j = 0; j < 8; ++j) raw[j] = __builtin_nontemporal_load((const f32x4*)src + lane + 64 * j);
#pragma unroll
          for (int j = 0; j < 8; ++j) { const int c = lane + 64 * j; T[c ^ ((c >> 4) & 3)] = raw[j]; }
#pragma unroll
          for (int q = 0; q < 4; ++q) { const int c0 = 4 * lane + q, c1 = 256 + 4 * lane + q; a[q] = T[c0 ^ ((c0 >> 4) & 3)]; a[4 + q] = T[c1 ^ ((c1 >> 4) & 3)]; } }
        if (!isv) {
#pragma unroll
            for (int q = 0; q < 4; ++q) { a[q] = a[q] * *(const f32x4*)(A_ln2_g + 16 * lane + 4 * q); a[4 + q] = a[4 + q] * *(const f32x4*)(A_ln2_g + 1024 + 16 * lane + 4 * q); }
        }
        float mx = 0.f;
#pragma unroll
        for (int q = 0; q < 8; ++q) mx = fmaxf(mx, fmaxf(fmaxf(fabsf(a[q][0]), fabsf(a[q][1])), fmaxf(fabsf(a[q][2]), fabsf(a[q][3]))));
        mx = wave_max(mx);
        if (!isv) {
            float ss = 0.f;
#pragma unroll
            for (int q = 0; q < 8; ++q) ss += (a[q][0] * a[q][0] + a[q][1] * a[q][1]) + (a[q][2] * a[q][2] + a[q][3] * a[q][3]);
            ss = wave_sum(ss);
            const float delta = 0.3352f * sqrtf(ss * (1.0f / DM)), inv = delta > 0.f ? 1.0f / delta : 0.f;
            v2u p0, p1;
#pragma unroll
            for (int d = 0; d < 2; ++d) { unsigned w0 = 0u, w1 = 0u;
#pragma unroll
                for (int t = 0; t < 8; ++t) { const float lo = a[2 * d + (t >> 2)][t & 3], hi = a[4 + 2 * d + (t >> 2)][t & 3];
                    const int n0 = (int)fminf(fmaxf(floorf(lo * inv), -8.f), 7.f), n1 = (int)fminf(fmaxf(floorf(hi * inv), -8.f), 7.f);
                    w0 |= ((unsigned)n0 & 15u) << (4 * t); w1 |= ((unsigned)n1 & 15u) << (4 * t); }
                p0[d] = w0; p1[d] = w1; }
            unsigned char* dst4 = U8 + (size_t)e * (DM / 2) + 8 * lane;
            *(v2u*)dst4 = p0; *(v2u*)(dst4 + 512) = p1;
            if (lane == 0) W_PSC[it] = delta;
            continue;
        }
        {
            const float sc4 = mx > 0.f ? 6.0f / mx : 0.f;
            v2u p0, p1;
#pragma unroll
            for (int d = 0; d < 2; ++d) { unsigned w0 = 0u, w1 = 0u;
#define PK4_(bb) do { const f32x4 lo = a[2 * d + ((bb) >> 1)], hi = a[4 + 2 * d + ((bb) >> 1)]; constexpr int z = 2 * ((bb) & 1); \
                    w0 = __builtin_amdgcn_cvt_scalef32_pk_fp4_f32(w0, lo[z] * sc4, lo[z + 1] * sc4, 1.0f, bb); \
                    w1 = __builtin_amdgcn_cvt_scalef32_pk_fp4_f32(w1, hi[z] * sc4, hi[z + 1] * sc4, 1.0f, bb); } while (0)
                PK4_(0); PK4_(1); PK4_(2); PK4_(3);
#undef PK4_
                p0[d] = w0; p1[d] = w1; }
            unsigned char* dst4 = (isv ? V8 : U8) + (size_t)e * (DM / 2) + 8 * lane;
            *(v2u*)dst4 = p0; *(v2u*)(dst4 + 512) = p1;
            if (lane == 0) W_PSC[it] = mx * (1.0f / 6.0f);
        }
    }
}

__device__ __forceinline__ unsigned lane_id_cse() { return __builtin_amdgcn_mbcnt_hi(~0u, __builtin_amdgcn_mbcnt_lo(~0u, 0u)); }
__device__ __forceinline__ unsigned shx16(unsigned v) { const auto r = __builtin_amdgcn_permlane16_swap(v, v, false, false); return (lane_id_cse() & 16u) ? r[0] : r[1]; }
__device__ __forceinline__ unsigned shx32(unsigned v) { const auto r = __builtin_amdgcn_permlane32_swap(v, v, false, false); return (lane_id_cse() & 32u) ? r[0] : r[1]; }
__device__ __forceinline__ int shx16(int v) { return (int)shx16((unsigned)v); }
__device__ __forceinline__ int shx32(int v) { return (int)shx32((unsigned)v); }
__device__ __forceinline__ float shx16(float v) { return __uint_as_float(shx16(__float_as_uint(v))); }
__device__ __forceinline__ float shx32(float v) { return __uint_as_float(shx32(__float_as_uint(v))); }
#define CEU(x, y) do { const unsigned _h = (x) > (y) ? (x) : (y), _l = (x) > (y) ? (y) : (x); (x) = _h; (y) = _l; } while (0)
#define CEP(vx, ix, vy, iy) do { const bool _s = (vy) > (vx); const float _hv = _s ? (vy) : (vx), _lv = _s ? (vx) : (vy); const int _hi = _s ? (iy) : (ix), _li = _s ? (ix) : (iy); (vx) = _hv; (vy) = _lv; (ix) = _hi; (iy) = _li; } while (0)
#define SEL4(g, x0, x1, x2, x3) (((g) & 2) ? (((g) & 1) ? (x3) : (x2)) : (((g) & 1) ? (x1) : (x0)))
__device__ __forceinline__ unsigned sel_key(float f, int idx) { const unsigned u = __float_as_uint(f); const unsigned k = u ^ ((unsigned)((int)u >> 31) | 0x80000000u); return (k & ~127u) | (unsigned)idx; }
__device__ __forceinline__ float sel_val(unsigned k) { const unsigned u = k & ~127u; return __uint_as_float(u ^ (~(unsigned)((int)u >> 31) | 0x80000000u)); }
__device__ __forceinline__ void sel_top16(unsigned (&a)[32], unsigned (&t)[16]) {
    CEU(a[0], a[1]);
    CEU(a[3], a[2]);
    CEU(a[4], a[5]);
    CEU(a[7], a[6]);
    CEU(a[8], a[9]);
    CEU(a[11], a[10]);
    CEU(a[12], a[13]);
    CEU(a[15], a[14]);
    CEU(a[0], a[2]);
    CEU(a[1], a[3]);
    CEU(a[6], a[4]);
    CEU(a[7], a[5]);
    CEU(a[8], a[10]);
    CEU(a[9], a[11]);
    CEU(a[14], a[12]);
    CEU(a[15], a[13]);
    CEU(a[0], a[1]);
    CEU(a[2], a[3]);
    CEU(a[5], a[4]);
    CEU(a[7], a[6]);
    CEU(a[8], a[9]);
    CEU(a[10], a[11]);
    CEU(a[13], a[12]);
    CEU(a[15], a[14]);
    CEU(a[0], a[4]);
    CEU(a[1], a[5]);
    CEU(a[2], a[6]);
    CEU(a[3], a[7]);
    CEU(a[12], a[8]);
    CEU(a[13], a[9]);
    CEU(a[14], a[10]);
    CEU(a[15], a[11]);
    CEU(a[0], a[2]);
    CEU(a[1], a[3]);
    CEU(a[4], a[6]);
    CEU(a[5], a[7]);
    CEU(a[10], a[8]);
    CEU(a[11], a[9]);
    CEU(a[14], a[12]);
    CEU(a[15], a[13]);
    CEU(a[0], a[1]);
    CEU(a[2], a[3]);
    CEU(a[4], a[5]);
    CEU(a[6], a[7]);
    CEU(a[9], a[8]);
    CEU(a[11], a[10]);
    CEU(a[13], a[12]);
    CEU(a[15], a[14]);
    CEU(a[0], a[8]);
    CEU(a[1], a[9]);
    CEU(a[2], a[10]);
    CEU(a[3], a[11]);
    CEU(a[4], a[12]);
    CEU(a[5], a[13]);
    CEU(a[6], a[14]);
    CEU(a[7], a[15]);
    CEU(a[0], a[4]);
    CEU(a[1], a[5]);
    CEU(a[2], a[6]);
    CEU(a[3], a[7]);
    CEU(a[8], a[12]);
    CEU(a[9], a[13]);
    CEU(a[10], a[14]);
    CEU(a[11], a[15]);
    CEU(a[0], a[2]);
    CEU(a[1], a[3]);
    CEU(a[4], a[6]);
    CEU(a[5], a[7]);
    CEU(a[8], a[10]);
    CEU(a[9], a[11]);
    CEU(a[12], a[14]);
    CEU(a[13], a[15]);
    CEU(a[0], a[1]);
    CEU(a[2], a[3]);
    CEU(a[4], a[5]);
    CEU(a[6], a[7]);
    CEU(a[8], a[9]);
    CEU(a[10], a[11]);
    CEU(a[12], a[13]);
    CEU(a[14], a[15]);
    CEU(a[16], a[17]);
    CEU(a[19], a[18]);
    CEU(a[20], a[21]);
    CEU(a[23], a[22]);
    CEU(a[24], a[25]);
    CEU(a[27], a[26]);
    CEU(a[28], a[29]);
    CEU(a[31], a[30]);
    CEU(a[16], a[18]);
    CEU(a[17], a[19]);
    CEU(a[22], a[20]);
    CEU(a[23], a[21]);
    CEU(a[24], a[26]);
    CEU(a[25], a[27]);
    CEU(a[30], a[28]);
    CEU(a[31], a[29]);
    CEU(a[16], a[17]);
    CEU(a[18], a[19]);
    CEU(a[21], a[20]);
    CEU(a[23], a[22]);
    CEU(a[24], a[25]);
    CEU(a[26], a[27]);
    CEU(a[29], a[28]);
    CEU(a[31], a[30]);
    CEU(a[16], a[20]);
    CEU(a[17], a[21]);
    CEU(a[18], a[22]);
    CEU(a[19], a[23]);
    CEU(a[28], a[24]);
    CEU(a[29], a[25]);
    CEU(a[30], a[26]);
    CEU(a[31], a[27]);
    CEU(a[16], a[18]);
    CEU(a[17], a[19]);
    CEU(a[20], a[22]);
    CEU(a[21], a[23]);
    CEU(a[26], a[24]);
    CEU(a[27], a[25]);
    CEU(a[30], a[28]);
    CEU(a[31], a[29]);
    CEU(a[16], a[17]);
    CEU(a[18], a[19]);
    CEU(a[20], a[21]);
    CEU(a[22], a[23]);
    CEU(a[25], a[24]);
    CEU(a[27], a[26]);
    CEU(a[29], a[28]);
    CEU(a[31], a[30]);
    CEU(a[16], a[24]);
    CEU(a[17], a[25]);
    CEU(a[18], a[26]);
    CEU(a[19], a[27]);
    CEU(a[20], a[28]);
    CEU(a[21], a[29]);
    CEU(a[22], a[30]);
    CEU(a[23], a[31]);
    CEU(a[16], a[20]);
    CEU(a[17], a[21]);
    CEU(a[18], a[22]);
    CEU(a[19], a[23]);
    CEU(a[24], a[28]);
    CEU(a[25], a[29]);
    CEU(a[26], a[30]);
    CEU(a[27], a[31]);
    CEU(a[16], a[18]);
    CEU(a[17], a[19]);
    CEU(a[20], a[22]);
    CEU(a[21], a[23]);
    CEU(a[24], a[26]);
    CEU(a[25], a[27]);
    CEU(a[28], a[30]);
    CEU(a[29], a[31]);
    CEU(a[16], a[17]);
    CEU(a[18], a[19]);
    CEU(a[20], a[21]);
    CEU(a[22], a[23]);
    CEU(a[24], a[25]);
    CEU(a[26], a[27]);
    CEU(a[28], a[29]);
    CEU(a[30], a[31]);
    t[0] = a[0] > a[31] ? a[0] : a[31];
    t[1] = a[1] > a[30] ? a[1] : a[30];
    t[2] = a[2] > a[29] ? a[2] : a[29];
    t[3] = a[3] > a[28] ? a[3] : a[28];
    t[4] = a[4] > a[27] ? a[4] : a[27];
    t[5] = a[5] > a[26] ? a[5] : a[26];
    t[6] = a[6] > a[25] ? a[6] : a[25];
    t[7] = a[7] > a[24] ? a[7] : a[24];
    t[8] = a[8] > a[23] ? a[8] : a[23];
    t[9] = a[9] > a[22] ? a[9] : a[22];
    t[10] = a[10] > a[21] ? a[10] : a[21];
    t[11] = a[11] > a[20] ? a[11] : a[20];
    t[12] = a[12] > a[19] ? a[12] : a[19];
    t[13] = a[13] > a[18] ? a[13] : a[18];
    t[14] = a[14] > a[17] ? a[14] : a[17];
    t[15] = a[15] > a[16] ? a[15] : a[16];
    CEU(t[0], t[8]);
    CEU(t[1], t[9]);
    CEU(t[2], t[10]);
    CEU(t[3], t[11]);
    CEU(t[4], t[12]);
    CEU(t[5], t[13]);
    CEU(t[6], t[14]);
    CEU(t[7], t[15]);
    CEU(t[0], t[4]);
    CEU(t[1], t[5]);
    CEU(t[2], t[6]);
    CEU(t[3], t[7]);
    CEU(t[8], t[12]);
    CEU(t[9], t[13]);
    CEU(t[10], t[14]);
    CEU(t[11], t[15]);
    CEU(t[0], t[2]);
    CEU(t[1], t[3]);
    CEU(t[4], t[6]);
    CEU(t[5], t[7]);
    CEU(t[8], t[10]);
    CEU(t[9], t[11]);
    CEU(t[12], t[14]);
    CEU(t[13], t[15]);
    CEU(t[0], t[1]);
    CEU(t[2], t[3]);
    CEU(t[4], t[5]);
    CEU(t[6], t[7]);
    CEU(t[8], t[9]);
    CEU(t[10], t[11]);
    CEU(t[12], t[13]);
    CEU(t[14], t[15]);
    { unsigned o[16];
      o[0] = (unsigned)shx16((int)t[15]);
      o[1] = (unsigned)shx16((int)t[14]);
      o[2] = (unsigned)shx16((int)t[13]);
      o[3] = (unsigned)shx16((int)t[12]);
      o[4] = (unsigned)shx16((int)t[11]);
      o[5] = (unsigned)shx16((int)t[10]);
      o[6] = (unsigned)shx16((int)t[9]);
      o[7] = (unsigned)shx16((int)t[8]);
      o[8] = (unsigned)shx16((int)t[7]);
      o[9] = (unsigned)shx16((int)t[6]);
      o[10] = (unsigned)shx16((int)t[5]);
      o[11] = (unsigned)shx16((int)t[4]);
      o[12] = (unsigned)shx16((int)t[3]);
      o[13] = (unsigned)shx16((int)t[2]);
      o[14] = (unsigned)shx16((int)t[1]);
      o[15] = (unsigned)shx16((int)t[0]);
      t[0] = t[0] > o[0] ? t[0] : o[0];
      t[1] = t[1] > o[1] ? t[1] : o[1];
      t[2] = t[2] > o[2] ? t[2] : o[2];
      t[3] = t[3] > o[3] ? t[3] : o[3];
      t[4] = t[4] > o[4] ? t[4] : o[4];
      t[5] = t[5] > o[5] ? t[5] : o[5];
      t[6] = t[6] > o[6] ? t[6] : o[6];
      t[7] = t[7] > o[7] ? t[7] : o[7];
      t[8] = t[8] > o[8] ? t[8] : o[8];
      t[9] = t[9] > o[9] ? t[9] : o[9];
      t[10] = t[10] > o[10] ? t[10] : o[10];
      t[11] = t[11] > o[11] ? t[11] : o[11];
      t[12] = t[12] > o[12] ? t[12] : o[12];
      t[13] = t[13] > o[13] ? t[13] : o[13];
      t[14] = t[14] > o[14] ? t[14] : o[14];
      t[15] = t[15] > o[15] ? t[15] : o[15];
    }
    CEU(t[0], t[8]);
    CEU(t[1], t[9]);
    CEU(t[2], t[10]);
    CEU(t[3], t[11]);
    CEU(t[4], t[12]);
    CEU(t[5], t[13]);
    CEU(t[6], t[14]);
    CEU(t[7], t[15]);
    CEU(t[0], t[4]);
    CEU(t[1], t[5]);
    CEU(t[2], t[6]);
    CEU(t[3], t[7]);
    CEU(t[8], t[12]);
    CEU(t[9], t[13]);
    CEU(t[10], t[14]);
    CEU(t[11], t[15]);
    CEU(t[0], t[2]);
    CEU(t[1], t[3]);
    CEU(t[4], t[6]);
    CEU(t[5], t[7]);
    CEU(t[8], t[10]);
    CEU(t[9], t[11]);
    CEU(t[12], t[14]);
    CEU(t[13], t[15]);
    CEU(t[0], t[1]);
    CEU(t[2], t[3]);
    CEU(t[4], t[5]);
    CEU(t[6], t[7]);
    CEU(t[8], t[9]);
    CEU(t[10], t[11]);
    CEU(t[12], t[13]);
    CEU(t[14], t[15]);
    { unsigned o[16];
      o[0] = (unsigned)shx32((int)t[15]);
      o[1] = (unsigned)shx32((int)t[14]);
      o[2] = (unsigned)shx32((int)t[13]);
      o[3] = (unsigned)shx32((int)t[12]);
      o[4] = (unsigned)shx32((int)t[11]);
      o[5] = (unsigned)shx32((int)t[10]);
      o[6] = (unsigned)shx32((int)t[9]);
      o[7] = (unsigned)shx32((int)t[8]);
      o[8] = (unsigned)shx32((int)t[7]);
      o[9] = (unsigned)shx32((int)t[6]);
      o[10] = (unsigned)shx32((int)t[5]);
      o[11] = (unsigned)shx32((int)t[4]);
      o[12] = (unsigned)shx32((int)t[3]);
      o[13] = (unsigned)shx32((int)t[2]);
      o[14] = (unsigned)shx32((int)t[1]);
      o[15] = (unsigned)shx32((int)t[0]);
      t[0] = t[0] > o[0] ? t[0] : o[0];
      t[1] = t[1] > o[1] ? t[1] : o[1];
      t[2] = t[2] > o[2] ? t[2] : o[2];
      t[3] = t[3] > o[3] ? t[3] : o[3];
      t[4] = t[4] > o[4] ? t[4] : o[4];
      t[5] = t[5] > o[5] ? t[5] : o[5];
      t[6] = t[6] > o[6] ? t[6] : o[6];
      t[7] = t[7] > o[7] ? t[7] : o[7];
      t[8] = t[8] > o[8] ? t[8] : o[8];
      t[9] = t[9] > o[9] ? t[9] : o[9];
      t[10] = t[10] > o[10] ? t[10] : o[10];
      t[11] = t[11] > o[11] ? t[11] : o[11];
      t[12] = t[12] > o[12] ? t[12] : o[12];
      t[13] = t[13] > o[13] ? t[13] : o[13];
      t[14] = t[14] > o[14] ? t[14] : o[14];
      t[15] = t[15] > o[15] ? t[15] : o[15];
    }
    CEU(t[0], t[8]);
    CEU(t[1], t[9]);
    CEU(t[2], t[10]);
    CEU(t[3], t[11]);
    CEU(t[4], t[12]);
    CEU(t[5], t[13]);
    CEU(t[6], t[14]);
    CEU(t[7], t[15]);
    CEU(t[0], t[4]);
    CEU(t[1], t[5]);
    CEU(t[2], t[6]);
    CEU(t[3], t[7]);
    CEU(t[8], t[12]);
    CEU(t[9], t[13]);
    CEU(t[10], t[14]);
    CEU(t[11], t[15]);
    CEU(t[0], t[2]);
    CEU(t[1], t[3]);
    CEU(t[4], t[6]);
    CEU(t[5], t[7]);
    CEU(t[8], t[10]);
    CEU(t[9], t[11]);
    CEU(t[12], t[14]);
    CEU(t[13], t[15]);
    CEU(t[0], t[1]);
    CEU(t[2], t[3]);
    CEU(t[4], t[5]);
    CEU(t[6], t[7]);
    CEU(t[8], t[9]);
    CEU(t[10], t[11]);
    CEU(t[12], t[13]);
    CEU(t[14], t[15]);
}
__device__ __forceinline__ void sel_phase(Frame& F, const Args& args) {
    const int lane_ = lane_now(), tid_ = F.wave * 64 + lane_; (void)tid_;
    LAS unsigned char* KL = F.lds;
    const int r = lane_ & 15, g = lane_ >> 4;
    unsigned short* SELI = (unsigned short*)W_SLAB(SL_SEL); float* SELG = (float*)(W_SLAB(SL_SEL)) + (size_t)M * NSEL;
    pg8::StaticOrder TS; TS.init(M, DM, F.G, (int)blockIdx.x);
    pg8::Unit tu;
    for (int ti = 0; TS.next(ti, tu); ++ti) {
    const int h = tu.pn;
    bf16x8 bqn[8];
    { const bf16* qp = W_SLAB(SL_QP) + (size_t)(tu.pm * 256 + 16 * F.wave + r) * DM + h * 256 + 8 * g;
#pragma unroll
        for (int i = 0; i < 8; ++i) bqn[i] = *(const bf16x8*)(qp + 32 * i); }
    v4u kreg[8];
    { const v4u* gk = (const v4u*)(W_KEYS + (size_t)h * 2 * NKEY * 128);
#pragma unroll
      for (int i = 0; i < 8; ++i) kreg[i] = gk[tid_ + 512 * i]; }
    __syncthreads();
#pragma unroll
    for (int i = 0; i < 8; ++i) { const int p = tid_ + 512 * i, row = p >> 4, c16 = p & 15; *(LAS v4u*)(KL + row * 272 + c16 * 16) = kreg[i]; }
    __syncthreads();
    for (int jj = 0; jj < 2; ++jj) {
        const int tok = tu.pm * 256 + 16 * (F.wave + 8 * jj) + r;
        unsigned ta[16], tb[16];
        bf16x8 bqc[8];
#pragma unroll
        for (int i = 0; i < 8; ++i) bqc[i] = bqn[i];
        if (jj == 0) { const bf16* qp = W_SLAB(SL_QP) + (size_t)(tu.pm * 256 + 16 * (F.wave + 8) + r) * DM + h * 256 + 8 * g;
#pragma unroll
            for (int i = 0; i < 8; ++i) bqn[i] = *(const bf16x8*)(qp + 32 * i); }
#pragma unroll
        for (int pp = 0; pp < 2; ++pp) {
            bf16x8 bq[4];
#pragma unroll
            for (int ks = 0; ks < 4; ++ks) bq[ks] = bqc[4 * pp + ks];
            unsigned a[32];
#pragma unroll
            for (int kt = 0; kt < 8; ++kt) { f32x4 acc = (f32x4){0.f, 0.f, 0.f, 0.f};
#pragma unroll
                for (int ks = 0; ks < 4; ++ks) { const bf16x8 av = *(const LAS bf16x8*)(KL + (pp * 128 + kt * 16 + r) * 272 + ks * 64 + g * 16); acc = __builtin_amdgcn_mfma_f32_16x16x32_bf16(av, bq[ks], acc, 0, 0, 0); }
#pragma unroll
                for (int j = 0; j < 4; ++j) a[kt * 4 + j] = sel_key(acc[j], kt * 16 + 4 * g + j);
                __builtin_amdgcn_sched_barrier(0); }
            if (pp == 0) sel_top16(a, ta); else sel_top16(a, tb);
        }
        float va[16], vb[16]; int ia[16], ib[16];
#pragma unroll
        for (int i = 0; i < 16; ++i) { va[i] = sel_val(ta[i]); vb[i] = sel_val(tb[i]); ia[i] = (int)(ta[i] & 127u); ib[i] = (int)(tb[i] & 127u); }
        float cv[16]; int ci[16];
        cv[0] = va[0] + SEL4(g, vb[0], vb[1], vb[2], vb[3]); ci[0] = ia[0] * NKEY + SEL4(g, ib[0], ib[1], ib[2], ib[3]);
        cv[1] = va[0] + SEL4(g, vb[4], vb[5], vb[6], vb[7]); ci[1] = ia[0] * NKEY + SEL4(g, ib[4], ib[5], ib[6], ib[7]);
        cv[2] = va[0] + SEL4(g, vb[8], vb[9], vb[10], vb[11]); ci[2] = ia[0] * NKEY + SEL4(g, ib[8], ib[9], ib[10], ib[11]);
        cv[3] = va[0] + SEL4(g, vb[12], vb[13], vb[14], vb[15]); ci[3] = ia[0] * NKEY + SEL4(g, ib[12], ib[13], ib[14], ib[15]);
        cv[4] = va[1] + SEL4(g, vb[0], vb[1], vb[2], vb[3]); ci[4] = ia[1] * NKEY + SEL4(g, ib[0], ib[1], ib[2], ib[3]);
        cv[5] = va[1] + SEL4(g, vb[4], vb[5], vb[6], vb[7]); ci[5] = ia[1] * NKEY + SEL4(g, ib[4], ib[5], ib[6], ib[7]);
        cv[6] = va[2] + SEL4(g, vb[0], vb[1], vb[2], vb[3]); ci[6] = ia[2] * NKEY + SEL4(g, ib[0], ib[1], ib[2], ib[3]);
        cv[7] = SEL4(g, va[2], va[3], va[3], va[3]) + SEL4(g, vb[4], vb[0], vb[1], vb[2]); ci[7] = SEL4(g, ia[2], ia[3], ia[3], ia[3]) * NKEY + SEL4(g, ib[4], ib[0], ib[1], ib[2]);
        cv[8] = SEL4(g, va[3], va[4], va[4], va[4]) + SEL4(g, vb[3], vb[0], vb[1], vb[2]); ci[8] = SEL4(g, ia[3], ia[4], ia[4], ia[4]) * NKEY + SEL4(g, ib[3], ib[0], ib[1], ib[2]);
        cv[9] = SEL4(g, va[5], va[5], va[6], va[6]) + SEL4(g, vb[0], vb[1], vb[0], vb[1]); ci[9] = SEL4(g, ia[5], ia[5], ia[6], ia[6]) * NKEY + SEL4(g, ib[0], ib[1], ib[0], ib[1]);
        cv[10] = SEL4(g, va[7], va[7], va[8], va[9]) + SEL4(g, vb[0], vb[1], vb[0], vb[0]); ci[10] = SEL4(g, ia[7], ia[7], ia[8], ia[9]) * NKEY + SEL4(g, ib[0], ib[1], ib[0], ib[0]);
        cv[11] = SEL4(g, va[10], va[11], va[12], va[13]) + vb[0]; ci[11] = SEL4(g, ia[10], ia[11], ia[12], ia[13]) * NKEY + ib[0];
        { const float sa = SEL4(g, va[14], va[15], 0.f, 0.f), sb = SEL4(g, vb[0], vb[0], 0.f, 0.f); const bool pad = g == 2 || g == 3;
          cv[12] = pad ? -3.0e38f : sa + sb; ci[12] = SEL4(g, ia[14], ia[15], 0, 0) * NKEY + SEL4(g, ib[0], ib[0], 0, 0); }
        cv[13] = -3.0e38f; ci[13] = 0;
        cv[14] = -3.0e38f; ci[14] = 0;
        cv[15] = -3.0e38f; ci[15] = 0;
        CEP(cv[0], ci[0], cv[1], ci[1]);
        CEP(cv[3], ci[3], cv[2], ci[2]);
        CEP(cv[4], ci[4], cv[5], ci[5]);
        CEP(cv[7], ci[7], cv[6], ci[6]);
        CEP(cv[8], ci[8], cv[9], ci[9]);
        CEP(cv[11], ci[11], cv[10], ci[10]);
        CEP(cv[12], ci[12], cv[13], ci[13]);
        CEP(cv[15], ci[15], cv[14], ci[14]);
        CEP(cv[0], ci[0], cv[2], ci[2]);
        CEP(cv[1], ci[1], cv[3], ci[3]);
        CEP(cv[6], ci[6], cv[4], ci[4]);
        CEP(cv[7], ci[7], cv[5], ci[5]);
        CEP(cv[8], ci[8], cv[10], ci[10]);
        CEP(cv[9], ci[9], cv[11], ci[11]);
        CEP(cv[14], ci[14], cv[12], ci[12]);
        CEP(cv[15], ci[15], cv[13], ci[13]);
        CEP(cv[0], ci[0], cv[1], ci[1]);
        CEP(cv[2], ci[2], cv[3], ci[3]);
        CEP(cv[5], ci[5], cv[4], ci[4]);
        CEP(cv[7], ci[7], cv[6], ci[6]);
        CEP(cv[8], ci[8], cv[9], ci[9]);
        CEP(cv[10], ci[10], cv[11], ci[11]);
        CEP(cv[13], ci[13], cv[12], ci[12]);
        CEP(cv[15], ci[15], cv[14], ci[14]);
        CEP(cv[0], ci[0], cv[4], ci[4]);
        CEP(cv[1], ci[1], cv[5], ci[5]);
        CEP(cv[2], ci[2], cv[6], ci[6]);
        CEP(cv[3], ci[3], cv[7], ci[7]);
        CEP(cv[12], ci[12], cv[8], ci[8]);
        CEP(cv[13], ci[13], cv[9], ci[9]);
        CEP(cv[14], ci[14], cv[10], ci[10]);
        CEP(cv[15], ci[15], cv[11], ci[11]);
        CEP(cv[0], ci[0], cv[2], ci[2]);
        CEP(cv[1], ci[1], cv[3], ci[3]);
        CEP(cv[4], ci[4], cv[6], ci[6]);
        CEP(cv[5], ci[5], cv[7], ci[7]);
        CEP(cv[10], ci[10], cv[8], ci[8]);
        CEP(cv[11], ci[11], cv[9], ci[9]);
        CEP(cv[14], ci[14], cv[12], ci[12]);
        CEP(cv[15], ci[15], cv[13], ci[13]);
        CEP(cv[0], ci[0], cv[1], ci[1]);
        CEP(cv[2], ci[2], cv[3], ci[3]);
        CEP(cv[4], ci[4], cv[5], ci[5]);
        CEP(cv[6], ci[6], cv[7], ci[7]);
        CEP(cv[9], ci[9], cv[8], ci[8]);
        CEP(cv[11], ci[11], cv[10], ci[10]);
        CEP(cv[13], ci[13], cv[12], ci[12]);
        CEP(cv[15], ci[15], cv[14], ci[14]);
        CEP(cv[0], ci[0], cv[8], ci[8]);
        CEP(cv[1], ci[1], cv[9], ci[9]);
        CEP(cv[2], ci[2], cv[10], ci[10]);
        CEP(cv[3], ci[3], cv[11], ci[11]);
        CEP(cv[4], ci[4], cv[12], ci[12]);
        CEP(cv[5], ci[5], cv[13], ci[13]);
        CEP(cv[6], ci[6], cv[14], ci[14]);
        CEP(cv[7], ci[7], cv[15], ci[15]);
        CEP(cv[0], ci[0], cv[4], ci[4]);
        CEP(cv[1], ci[1], cv[5], ci[5]);
        CEP(cv[2], ci[2], cv[6], ci[6]);
        CEP(cv[3], ci[3], cv[7], ci[7]);
        CEP(cv[8], ci[8], cv[12], ci[12]);
        CEP(cv[9], ci[9], cv[13], ci[13]);
        CEP(cv[10], ci[10], cv[14], ci[14]);
        CEP(cv[11], ci[11], cv[15], ci[15]);
        CEP(cv[0], ci[0], cv[2], ci[2]);
        CEP(cv[1], ci[1], cv[3], ci[3]);
        CEP(cv[4], ci[4], cv[6], ci[6]);
        CEP(cv[5], ci[5], cv[7], ci[7]);
        CEP(cv[8], ci[8], cv[10], ci[10]);
        CEP(cv[9], ci[9], cv[11], ci[11]);
        CEP(cv[12], ci[12], cv[14], ci[14]);
        CEP(cv[13], ci[13], cv[15], ci[15]);
        CEP(cv[0], ci[0], cv[1], ci[1]);
        CEP(cv[2], ci[2], cv[3], ci[3]);
        CEP(cv[4], ci[4], cv[5], ci[5]);
        CEP(cv[6], ci[6], cv[7], ci[7]);
        CEP(cv[8], ci[8], cv[9], ci[9]);
        CEP(cv[10], ci[10], cv[11], ci[11]);
        CEP(cv[12], ci[12], cv[13], ci[13]);
        CEP(cv[14], ci[14], cv[15], ci[15]);
        { float ov[16]; int oi[16];
          ov[0] = shx16(cv[15]); oi[0] = shx16(ci[15]);
          ov[1] = shx16(cv[14]); oi[1] = shx16(ci[14]);
          ov[2] = shx16(cv[13]); oi[2] = shx16(ci[13]);
          ov[3] = shx16(cv[12]); oi[3] = shx16(ci[12]);
          ov[4] = shx16(cv[11]); oi[4] = shx16(ci[11]);
          ov[5] = shx16(cv[10]); oi[5] = shx16(ci[10]);
          ov[6] = shx16(cv[9]); oi[6] = shx16(ci[9]);
          ov[7] = shx16(cv[8]); oi[7] = shx16(ci[8]);
          ov[8] = shx16(cv[7]); oi[8] = shx16(ci[7]);
          ov[9] = shx16(cv[6]); oi[9] = shx16(ci[6]);
          ov[10] = shx16(cv[5]); oi[10] = shx16(ci[5]);
          ov[11] = shx16(cv[4]); oi[11] = shx16(ci[4]);
          ov[12] = shx16(cv[3]); oi[12] = shx16(ci[3]);
          ov[13] = shx16(cv[2]); oi[13] = shx16(ci[2]);
          ov[14] = shx16(cv[1]); oi[14] = shx16(ci[1]);
          ov[15] = shx16(cv[0]); oi[15] = shx16(ci[0]);
          { const bool s_ = ov[0] > cv[0]; cv[0] = s_ ? ov[0] : cv[0]; ci[0] = s_ ? oi[0] : ci[0]; }
          { const bool s_ = ov[1] > cv[1]; cv[1] = s_ ? ov[1] : cv[1]; ci[1] = s_ ? oi[1] : ci[1]; }
          { const bool s_ = ov[2] > cv[2]; cv[2] = s_ ? ov[2] : cv[2]; ci[2] = s_ ? oi[2] : ci[2]; }
          { const bool s_ = ov[3] > cv[3]; cv[3] = s_ ? ov[3] : cv[3]; ci[3] = s_ ? oi[3] : ci[3]; }
          { const bool s_ = ov[4] > cv[4]; cv[4] = s_ ? ov[4] : cv[4]; ci[4] = s_ ? oi[4] : ci[4]; }
          { const bool s_ = ov[5] > cv[5]; cv[5] = s_ ? ov[5] : cv[5]; ci[5] = s_ ? oi[5] : ci[5]; }
          { const bool s_ = ov[6] > cv[6]; cv[6] = s_ ? ov[6] : cv[6]; ci[6] = s_ ? oi[6] : ci[6]; }
          { const bool s_ = ov[7] > cv[7]; cv[7] = s_ ? ov[7] : cv[7]; ci[7] = s_ ? oi[7] : ci[7]; }
          { const bool s_ = ov[8] > cv[8]; cv[8] = s_ ? ov[8] : cv[8]; ci[8] = s_ ? oi[8] : ci[8]; }
          { const bool s_ = ov[9] > cv[9]; cv[9] = s_ ? ov[9] : cv[9]; ci[9] = s_ ? oi[9] : ci[9]; }
          { const bool s_ = ov[10] > cv[10]; cv[10] = s_ ? ov[10] : cv[10]; ci[10] = s_ ? oi[10] : ci[10]; }
          { const bool s_ = ov[11] > cv[11]; cv[11] = s_ ? ov[11] : cv[11]; ci[11] = s_ ? oi[11] : ci[11]; }
          { const bool s_ = ov[12] > cv[12]; cv[12] = s_ ? ov[12] : cv[12]; ci[12] = s_ ? oi[12] : ci[12]; }
          { const bool s_ = ov[13] > cv[13]; cv[13] = s_ ? ov[13] : cv[13]; ci[13] = s_ ? oi[13] : ci[13]; }
          { const bool s_ = ov[14] > cv[14]; cv[14] = s_ ? ov[14] : cv[14]; ci[14] = s_ ? oi[14] : ci[14]; }
          { const bool s_ = ov[15] > cv[15]; cv[15] = s_ ? ov[15] : cv[15]; ci[15] = s_ ? oi[15] : ci[15]; }
        }
        CEP(cv[0], ci[0], cv[8], ci[8]);
        CEP(cv[1], ci[1], cv[9], ci[9]);
        CEP(cv[2], ci[2], cv[10], ci[10]);
        CEP(cv[3], ci[3], cv[11], ci[11]);
        CEP(cv[4], ci[4], cv[12], ci[12]);
        CEP(cv[5], ci[5], cv[13], ci[13]);
        CEP(cv[6], ci[6], cv[14], ci[14]);
        CEP(cv[7], ci[7], cv[15], ci[15]);
        CEP(cv[0], ci[0], cv[4], ci[4]);
        CEP(cv[1], ci[1], cv[5], ci[5]);
        CEP(cv[2], ci[2], cv[6], ci[6]);
        CEP(cv[3], ci[3], cv[7], ci[7]);
        CEP(cv[8], ci[8], cv[12], ci[12]);
        CEP(cv[9], ci[9], cv[13], ci[13]);
        CEP(cv[10], ci[10], cv[14], ci[14]);
        CEP(cv[11], ci[11], cv[15], ci[15]);
        CEP(cv[0], ci[0], cv[2], ci[2]);
        CEP(cv[1], ci[1], cv[3], ci[3]);
        CEP(cv[4], ci[4], cv[6], ci[6]);
        CEP(cv[5], ci[5], cv[7], ci[7]);
        CEP(cv[8], ci[8], cv[10], ci[10]);
        CEP(cv[9], ci[9], cv[11], ci[11]);
        CEP(cv[12], ci[12], cv[14], ci[14]);
        CEP(cv[13], ci[13], cv[15], ci[15]);
        CEP(cv[0], ci[0], cv[1], ci[1]);
        CEP(cv[2], ci[2], cv[3], ci[3]);
        CEP(cv[4], ci[4], cv[5], ci[5]);
        CEP(cv[6], ci[6], cv[7], ci[7]);
        CEP(cv[8], ci[8], cv[9], ci[9]);
        CEP(cv[10], ci[10], cv[11], ci[11]);
        CEP(cv[12], ci[12], cv[13], ci[13]);
        CEP(cv[14], ci[14], cv[15], ci[15]);
        { float ov[16]; int oi[16];
          ov[0] = shx32(cv[15]); oi[0] = shx32(ci[15]);
          ov[1] = shx32(cv[14]); oi[1] = shx32(ci[14]);
          ov[2] = shx32(cv[13]); oi[2] = shx32(ci[13]);
          ov[3] = shx32(cv[12]); oi[3] = shx32(ci[12]);
          ov[4] = shx32(cv[11]); oi[4] = shx32(ci[11]);
          ov[5] = shx32(cv[10]); oi[5] = shx32(ci[10]);
          ov[6] = shx32(cv[9]); oi[6] = shx32(ci[9]);
          ov[7] = shx32(cv[8]); oi[7] = shx32(ci[8]);
          ov[8] = shx32(cv[7]); oi[8] = shx32(ci[7]);
          ov[9] = shx32(cv[6]); oi[9] = shx32(ci[6]);
          ov[10] = shx32(cv[5]); oi[10] = shx32(ci[5]);
          ov[11] = shx32(cv[4]); oi[11] = shx32(ci[4]);
          ov[12] = shx32(cv[3]); oi[12] = shx32(ci[3]);
          ov[13] = shx32(cv[2]); oi[13] = shx32(ci[2]);
          ov[14] = shx32(cv[1]); oi[14] = shx32(ci[1]);
          ov[15] = shx32(cv[0]); oi[15] = shx32(ci[0]);
          { const bool s_ = ov[0] > cv[0]; cv[0] = s_ ? ov[0] : cv[0]; ci[0] = s_ ? oi[0] : ci[0]; }
          { const bool s_ = ov[1] > cv[1]; cv[1] = s_ ? ov[1] : cv[1]; ci[1] = s_ ? oi[1] : ci[1]; }
          { const bool s_ = ov[2] > cv[2]; cv[2] = s_ ? ov[2] : cv[2]; ci[2] = s_ ? oi[2] : ci[2]; }
          { const bool s_ = ov[3] > cv[3]; cv[3] = s_ ? ov[3] : cv[3]; ci[3] = s_ ? oi[3] : ci[3]; }
          { const bool s_ = ov[4] > cv[4]; cv[4] = s_ ? ov[4] : cv[4]; ci[4] = s_ ? oi[4] : ci[4]; }
          { const bool s_ = ov[5] > cv[5]; cv[5] = s_ ? ov[5] : cv[5]; ci[5] = s_ ? oi[5] : ci[5]; }
          { const bool s_ = ov[6] > cv[6]; cv[6] = s_ ? ov[6] : cv[6]; ci[6] = s_ ? oi[6] : ci[6]; }
          { const bool s_ = ov[7] > cv[7]; cv[7] = s_ ? ov[7] : cv[7]; ci[7] = s_ ? oi[7] : ci[7]; }
          { const bool s_ = ov[8] > cv[8]; cv[8] = s_ ? ov[8] : cv[8]; ci[8] = s_ ? oi[8] : ci[8]; }
          { const bool s_ = ov[9] > cv[9]; cv[9] = s_ ? ov[9] : cv[9]; ci[9] = s_ ? oi[9] : ci[9]; }
          { const bool s_ = ov[10] > cv[10]; cv[10] = s_ ? ov[10] : cv[10]; ci[10] = s_ ? oi[10] : ci[10]; }
          { const bool s_ = ov[11] > cv[11]; cv[11] = s_ ? ov[11] : cv[11]; ci[11] = s_ ? oi[11] : ci[11]; }
          { const bool s_ = ov[12] > cv[12]; cv[12] = s_ ? ov[12] : cv[12]; ci[12] = s_ ? oi[12] : ci[12]; }
          { const bool s_ = ov[13] > cv[13]; cv[13] = s_ ? ov[13] : cv[13]; ci[13] = s_ ? oi[13] : ci[13]; }
          { const bool s_ = ov[14] > cv[14]; cv[14] = s_ ? ov[14] : cv[14]; ci[14] = s_ ? oi[14] : ci[14]; }
          { const bool s_ = ov[15] > cv[15]; cv[15] = s_ ? ov[15] : cv[15]; ci[15] = s_ ? oi[15] : ci[15]; }
        }
        CEP(cv[0], ci[0], cv[8], ci[8]);
        CEP(cv[1], ci[1], cv[9], ci[9]);
        CEP(cv[2], ci[2], cv[10], ci[10]);
        CEP(cv[3], ci[3], cv[11], ci[11]);
        CEP(cv[4], ci[4], cv[12], ci[12]);
        CEP(cv[5], ci[5], cv[13], ci[13]);
        CEP(cv[6], ci[6], cv[14], ci[14]);
        CEP(cv[7], ci[7], cv[15], ci[15]);
        CEP(cv[0], ci[0], cv[4], ci[4]);
        CEP(cv[1], ci[1], cv[5], ci[5]);
        CEP(cv[2], ci[2], cv[6], ci[6]);
        CEP(cv[3], ci[3], cv[7], ci[7]);
        CEP(cv[8], ci[8], cv[12], ci[12]);
        CEP(cv[9], ci[9], cv[13], ci[13]);
        CEP(cv[10], ci[10], cv[14], ci[14]);
        CEP(cv[11], ci[11], cv[15], ci[15]);
        CEP(cv[0], ci[0], cv[2], ci[2]);
        CEP(cv[1], ci[1], cv[3], ci[3]);
        CEP(cv[4], ci[4], cv[6], ci[6]);
        CEP(cv[5], ci[5], cv[7], ci[7]);
        CEP(cv[8], ci[8], cv[10], ci[10]);
        CEP(cv[9], ci[9], cv[11], ci[11]);
        CEP(cv[12], ci[12], cv[14], ci[14]);
        CEP(cv[13], ci[13], cv[15], ci[15]);
        CEP(cv[0], ci[0], cv[1], ci[1]);
        CEP(cv[2], ci[2], cv[3], ci[3]);
        CEP(cv[4], ci[4], cv[5], ci[5]);
        CEP(cv[6], ci[6], cv[7], ci[7]);
        CEP(cv[8], ci[8], cv[9], ci[9]);
        CEP(cv[10], ci[10], cv[11], ci[11]);
        CEP(cv[12], ci[12], cv[13], ci[13]);
        CEP(cv[14], ci[14], cv[15], ci[15]);
        float ex[16], sum = 0.f;
#pragma unroll
        for (int i = 0; i < 16; ++i) { ex[i] = __expf(cv[i] - cv[0]); sum += ex[i]; }
        const float inv = 1.0f / sum;
        v4u oi4; f32x4 og4;
        oi4[0] = (unsigned)SEL4(g, ci[0], ci[4], ci[8], ci[12]); og4[0] = SEL4(g, ex[0], ex[4], ex[8], ex[12]) * inv;
        oi4[1] = (unsigned)SEL4(g, ci[1], ci[5], ci[9], ci[13]); og4[1] = SEL4(g, ex[1], ex[5], ex[9], ex[13]) * inv;
        oi4[2] = (unsigned)SEL4(g, ci[2], ci[6], ci[10], ci[14]); og4[2] = SEL4(g, ex[2], ex[6], ex[10], ex[14]) * inv;
        oi4[3] = (unsigned)SEL4(g, ci[3], ci[7], ci[11], ci[15]); og4[3] = SEL4(g, ex[3], ex[7], ex[11], ex[15]) * inv;
        { v2u o2; o2.x = oi4[0] | (oi4[1] << 16); o2.y = oi4[2] | (oi4[3] << 16); *(v2u*)(SELI + (size_t)tok * NSEL + h * TOPK + 4 * g) = o2; } *(f32x4*)(SELG + (size_t)tok * NSEL + h * TOPK + 4 * g) = og4;
    }
    }
}

constexpr int NSLICE = 16;
template <int CTRL> __device__ __forceinline__ float dpp_f(float v) { return __uint_as_float(__builtin_amdgcn_update_dpp(0u, __float_as_uint(v), CTRL, 0xf, 0xf, false)); }
constexpr int DPP_HALF_MIRROR = 0x141, DPP_QUAD_MIRROR = 0x1B, DPP_QUAD_SWAP1 = 0xB1, DPP_ROR8 = 0x128;
__device__ __forceinline__ float xhalf32(float lo, float hi) { const auto r = __builtin_amdgcn_permlane32_swap(__float_as_uint(lo), __float_as_uint(hi), false, false); return __uint_as_float(r[0]) + __uint_as_float(r[1]); }
__device__ __forceinline__ float xhalf16(float lo, float hi) { const auto r = __builtin_amdgcn_permlane16_swap(__float_as_uint(lo), __float_as_uint(hi), false, false); return __uint_as_float(r[0]) + __uint_as_float(r[1]); }
struct DotsPre { v4u xh, xl; };
struct IdsPre { v4u idv[2]; };
struct AxpyPre { v2u hw; };
#define SLICE_EID(idv, i) (((idv)[(i) >> 3][((i) >> 1) & 3] >> (16 * ((i) & 1))) & 0xffffu)
__device__ __forceinline__ void ids_pre(IdsPre& P, const Args& args, int tok, int lane) {
    const int sg = lane >> 3;
    const unsigned short* SELI = (const unsigned short*)W_SLAB(SL_SEL);
    P.idv[0] = *(const v4u*)(SELI + (size_t)tok * NSEL + 16 * sg); P.idv[1] = *(const v4u*)(SELI + (size_t)tok * NSEL + 16 * sg + 8);
}
__device__ __forceinline__ void dots_pre(DotsPre& P, const Args& args, int tok, int sl, int lane) {
    const int m = lane & 7;
    const unsigned char* xp = (const unsigned char*)W_SLAB(SL_MIX) + (size_t)tok * DM + 128 * sl + 16 * m;
    P.xh = *(const v4u*)xp; P.xl = *(const v4u*)(xp + DM / 2);
}
__device__ __forceinline__ void axpy_pre(AxpyPre& P, const Args& args, int tok, int sl, int lane) {
    const int m = lane & 7, sg = lane >> 3;
    P.hw = *(const v2u*)(W_SLAB(SL_H2B) + (size_t)tok * DM + 256 * sl + 32 * m + 4 * sg);
}
template <int ROWB>
__device__ __forceinline__ void slice_rows(v4u (&R)[16], const v4u (&idv)[2], const unsigned char* tb) {
#pragma unroll
    for (int i = 0; i < 16; ++i) R[i] = *(const v4u*)(tb + (size_t)SLICE_EID(idv, i) * ROWB);
}
__device__ __forceinline__ void dots_comp(const v4u (&R)[16], const DotsPre& P, LAS float* acc_row, bool first, int lane) {
    const bool m4 = lane & 4, m2 = lane & 2, m1 = lane & 1;
    float p[16];
#pragma unroll
    for (int i = 0; i < 16; ++i) { int ih = 0, il = 0;
#pragma unroll
        for (int w = 0; w < 4; ++w) { ih = __builtin_amdgcn_sdot8((int)R[i][w], (int)P.xh[w], ih, false); il = __builtin_amdgcn_sdot8((int)R[i][w], (int)P.xl[w], il, false); }
        p[i] = (float)(16 * ih + il); }
    float qd4[8];
#pragma unroll
    for (int j = 0; j < 8; ++j) { const float kp = m4 ? p[8 + j] : p[j], sd = m4 ? p[j] : p[8 + j]; qd4[j] = kp + dpp_f<DPP_HALF_MIRROR>(sd); }
    float qd2[4];
#pragma unroll
    for (int j = 0; j < 4; ++j) { const float kp = m2 ? qd4[4 + j] : qd4[j], sd = m2 ? qd4[j] : qd4[4 + j]; qd2[j] = kp + dpp_f<DPP_QUAD_MIRROR>(sd); }
    float qd1[2];
#pragma unroll
    for (int j = 0; j < 2; ++j) { const float kp = m1 ? qd2[2 + j] : qd2[j], sd = m1 ? qd2[j] : qd2[2 + j]; qd1[j] = kp + dpp_f<DPP_QUAD_SWAP1>(sd); }
    LAS f32x2* ap = (LAS f32x2*)(acc_row + 2 * lane);
    f32x2 o = (f32x2){qd1[0], qd1[1]};
    if (!first) o += *ap;
    *ap = o;
}
__device__ __forceinline__ float axpy_comp(const v4u (&R)[16], const AxpyPre& P, const Args& args, const LAS float* coef_row, int tok, int sl, int lane) {
    const int m = lane & 7, sg = lane >> 3;
    const bool s1 = lane & 8;
    f32x4 cf[4];
#pragma unroll
    for (int q = 0; q < 4; ++q) cf[q] = *(const LAS f32x4*)(coef_row + 16 * sg + 4 * q);
    f32x2 a2[16];
#pragma unroll
    for (int w = 0; w < 16; ++w) a2[w] = (f32x2){0.f, 0.f};
#pragma unroll
    for (int i = 0; i < 16; ++i) { const float c = cf[i >> 2][i & 3]; const f32x2 c2 = (f32x2){c, c};
#pragma unroll
        for (int w = 0; w < 4; ++w) { a2[4 * w] += c2 * __builtin_amdgcn_cvt_scalef32_pk_f32_fp4(R[i][w], 1.0f, 0); a2[4 * w + 1] += c2 * __builtin_amdgcn_cvt_scalef32_pk_f32_fp4(R[i][w], 1.0f, 1);
            a2[4 * w + 2] += c2 * __builtin_amdgcn_cvt_scalef32_pk_f32_fp4(R[i][w], 1.0f, 2); a2[4 * w + 3] += c2 * __builtin_amdgcn_cvt_scalef32_pk_f32_fp4(R[i][w], 1.0f, 3); } }
    float q32[16];
#pragma unroll
    for (int j = 0; j < 16; ++j) { const float lo = (j & 1) ? a2[j >> 1].y : a2[j >> 1].x, hi = (j & 1) ? a2[8 + (j >> 1)].y : a2[8 + (j >> 1)].x; q32[j] = xhalf32(lo, hi); }
    float q16[8];
#pragma unroll
    for (int j = 0; j < 8; ++j) q16[j] = xhalf16(q32[j], q32[8 + j]);
    float q8[4];
#pragma unroll
    for (int j = 0; j < 4; ++j) { const float kp = s1 ? q16[4 + j] : q16[j], sd = s1 ? q16[j] : q16[4 + j]; q8[j] = kp + dpp_f<DPP_ROR8>(sd); }
    const float o0 = bflo(P.hw.x) + q8[0], o1 = bfhi(P.hw.x) + q8[1], o2 = bflo(P.hw.y) + q8[2], o3 = bfhi(P.hw.y) + q8[3];
    *(v2u*)(W_SLAB(SL_ZA) + (size_t)tok * DM + 256 * sl + 32 * m + 4 * sg) = (v2u){pk2(o0, o1), pk2(o2, o3)};
    return (o0 * o0 + o1 * o1) + (o2 * o2 + o3 * o3);
}
constexpr float X8S4 = 24.0f;
__device__ __forceinline__ float wave_sum_dpp(float v) {
    v += dpp_f<0x128>(v); v += dpp_f<0x124>(v); v += dpp_f<0x122>(v); v += dpp_f<0x121>(v);
    v = xhalf16(v, v); v = xhalf32(v, v);
    return v;
}
constexpr int PEER_TPW = 8;
#define PEER_TOK(n) (tokbase + ((n) & (PEER_TPW - 1)))
#define PEER_SL(n) ((n) / PEER_TPW)
#define DOTS_STEP(RX, RY, XX, XY, IX, IY, n) do { if ((n) < NUU) { \
        { const int n1 = ((n) + 1 < NUU) ? (n) + 1 : 0; slice_rows<DM / 2>(RY, IY.idv, U8 + 128 * PEER_SL(n1) + 16 * m); dots_pre(XY, args, PEER_TOK(n1), PEER_SL(n1), lane); } __builtin_amdgcn_sched_barrier(0); \
        dots_comp(RX, XX, ACC + ((n) & (PEER_TPW - 1)) * NSEL, PEER_SL(n) == 0, lane); __builtin_amdgcn_sched_barrier(0); \
        { const int n2 = ((n) + 2 < NUU) ? (n) + 2 : 0; ids_pre(IX, args, PEER_TOK(n2), lane); } __builtin_amdgcn_sched_barrier(0); } } while (0)
#define AXPY_STEP(RX, RY, HX, HY, IX, IY, n) do { if ((n) < NUU) { \
        { const int n1 = ((n) + 1 < NUU) ? (n) + 1 : 0; slice_rows<DM / 2>(RY, IY.idv, V8 + 128 * PEER_SL(n1) + 16 * m); axpy_pre(HY, args, PEER_TOK(n1), PEER_SL(n1), lane); } __builtin_amdgcn_sched_barrier(0); \
        { const float q_ = axpy_comp(RX, HX, args, ACC + ((n) & (PEER_TPW - 1)) * NSEL, PEER_TOK(n), PEER_SL(n), lane); \
          LAS float* sp_ = SSQl + ((n) & (PEER_TPW - 1)) * 64 + lane; *sp_ = (PEER_SL(n) == 0) ? q_ : *sp_ + q_; } __builtin_amdgcn_sched_barrier(0); \
        { const int n2 = ((n) + 2 < NUU) ? (n) + 2 : 0; ids_pre(IX, args, PEER_TOK(n2), lane); } __builtin_amdgcn_sched_barrier(0); } } while (0)
__device__ __forceinline__ void peer_phase(Frame& F, const Args& args, unsigned long long* prof = nullptr, int prof_k = 0) {
    const int lane = lane_now(), m = lane & 7;
    LAS float* ACC = (LAS float*)(F.lds + F.wave * 8192);
    LAS float* SSQl = (LAS float*)(F.lds + F.wave * 8192 + 4096);
    const unsigned char* U8 = (const unsigned char*)W_SLAB(SL_UB); const unsigned char* V8 = (const unsigned char*)W_SLAB(SL_VB);
    const int tpw = M / (F.G * NWAVES);
    const int tokbase = (F.vcu * NWAVES + F.wave) * tpw;
    constexpr int NUU = (NSLICE / 2) * PEER_TPW;
    v4u RA[16], RB[16];
    IdsPre UI0, UI1;
    ids_pre(UI0, args, PEER_TOK(0), lane); ids_pre(UI1, args, PEER_TOK(1), lane);
    slice_rows<DM / 2>(RA, UI0.idv, U8 + 128 * PEER_SL(0) + 16 * m);
    LAS float* XSUM = (LAS float*)(F.lds + F.wave * 8192 + 6144);
    for (int i0 = 0; i0 < PEER_TPW; i0 += 4) {
    v4u hwb[4][4]; float scb[4];
#pragma unroll
    for (int ii = 0; ii < 4; ++ii) { const int tok = tokbase + i0 + ii; scb[ii] = W_RSTD2[tok] * X8S4;
        const v4u* hp = (const v4u*)(W_SLAB(SL_H2B) + (size_t)tok * DM + 32 * lane);
#pragma unroll
        for (int q = 0; q < 4; ++q) hwb[ii][q] = hp[q]; }
    __builtin_amdgcn_sched_barrier(0);
#pragma unroll
    for (int ii = 0; ii < 4; ++ii) { const int i = i0 + ii; const int tok = tokbase + i;
        const float sc = scb[ii];
        v4u hw[4];
#pragma unroll
        for (int q = 0; q < 4; ++q) hw[q] = hwb[ii][q];
        v4u ph, pl; int sum = 0;
#pragma unroll
        for (int w = 0; w < 4; ++w) { unsigned wh = 0u, wl = 0u;
#pragma unroll
            for (int t = 0; t < 8; ++t) { const unsigned word = hw[w][t >> 1]; const float xv = ((t & 1) ? bfhi(word) : bflo(word)) * sc;
                const int x8 = (int)fminf(fmaxf(rintf(xv), -120.f), 119.f); const int lo = ((x8 + 8) & 15) - 8, hi = (x8 - lo) >> 4; sum += x8;
                wh |= ((unsigned)hi & 15u) << (4 * t); wl |= ((unsigned)lo & 15u) << (4 * t); }
            ph[w] = wh; pl[w] = wl; }
        unsigned char* xq = (unsigned char*)W_SLAB(SL_MIX) + (size_t)tok * DM + 16 * lane;
        *(v4u*)xq = ph; *(v4u*)(xq + DM / 2) = pl;
        const float tot = wave_sum_dpp((float)sum);
        if (lane == 0) XSUM[i] = tot; }
    }
    asm volatile("s_waitcnt vmcnt(0) lgkmcnt(0)" ::: "memory");
    { DotsPre XA, XB;
      dots_pre(XA, args, PEER_TOK(0), PEER_SL(0), lane);
      for (int nb = 0; nb < NUU; nb += 2) { DOTS_STEP(RA, RB, XA, XB, UI0, UI1, nb); DOTS_STEP(RB, RA, XB, XA, UI1, UI0, nb + 1); } }
    AxpyPre HA, HB; IdsPre VI0, VI1;
    ids_pre(VI0, args, PEER_TOK(0), lane); ids_pre(VI1, args, PEER_TOK(1), lane);
    axpy_pre(HA, args, PEER_TOK(0), PEER_SL(0), lane);
    slice_rows<DM / 2>(RA, VI0.idv, V8 + 128 * PEER_SL(0) + 16 * m);
    { const unsigned short* SELI = (const unsigned short*)W_SLAB(SL_SEL); const float* SELG = (const float*)(W_SLAB(SL_SEL)) + (size_t)M * NSEL;
#pragma unroll 8
      for (int i = 0; i < PEER_TPW; ++i) { const int tok = tokbase + i;
          const unsigned idw = *(const unsigned*)(SELI + (size_t)tok * NSEL + 2 * lane); const int e0 = (int)(idw & 0xffffu), e1 = (int)(idw >> 16);
          const f32x2 gt = *(const f32x2*)(SELG + (size_t)tok * NSEL + 2 * lane);
          LAS f32x2* ap = (LAS f32x2*)(ACC + i * NSEL + 2 * lane); const f32x2 d = *ap;
          const float hs = 0.5f * XSUM[i]; const pg8::f32x2 ge = pg8::gelu_pk((pg8::f32x2){(d.x + hs) * (W_PSC[e0] * (1.0f / X8S4)), (d.y + hs) * (W_PSC[e1] * (1.0f / X8S4))});
          *ap = (f32x2){ge.x * gt.x * W_PSC[NEXP + e0], ge.y * gt.y * W_PSC[NEXP + e1]}; } }
    if (prof && F.wave == 0 && lane == 0) { const unsigned long long t_ = __builtin_amdgcn_s_memrealtime(); __hip_atomic_fetch_max(prof + prof_k, t_, __ATOMIC_RELAXED, __HIP_MEMORY_SCOPE_AGENT); __hip_atomic_fetch_max(prof + 32 + prof_k, ~t_, __ATOMIC_RELAXED, __HIP_MEMORY_SCOPE_AGENT); }
    { for (int nb = 0; nb < NUU; nb += 2) { AXPY_STEP(RA, RB, HA, HB, VI0, VI1, nb); AXPY_STEP(RB, RA, HB, HA, VI1, VI0, nb + 1); } }
    asm volatile("s_waitcnt vmcnt(0) lgkmcnt(0)" ::: "memory");
    for (int i0 = 0; i0 < PEER_TPW; i0 += 4) {
    v4u vb[4][4];
#pragma unroll
    for (int ii = 0; ii < 4; ++ii) { const v4u* ur = (const v4u*)(W_SLAB(SL_ZA) + (size_t)(tokbase + i0 + ii) * DM) + lane;
#pragma unroll
        for (int j = 0; j < 4; ++j) vb[ii][j] = __builtin_nontemporal_load(ur + 64 * j); }
    __builtin_amdgcn_sched_barrier(0);
#pragma unroll
    for (int ii = 0; ii < 4; ++ii) { const int i = i0 + ii; const int tok = tokbase + i;
        const float r3 = __builtin_amdgcn_rsqf(wave_sum_dpp(SSQl[i * 64 + lane]) * (1.0f / DM) + EPS);
        f32x4* xr = (f32x4*)(A_out + (size_t)tok * DM); const f32x4* gr = (const f32x4*)A_final_g;
        v4u v[4];
#pragma unroll
        for (int j = 0; j < 4; ++j) v[j] = vb[ii][j];
#pragma unroll
        for (int j = 0; j < 4; ++j) { const int e4 = 2 * lane + 128 * j;
            __builtin_nontemporal_store((f32x4){bflo(v[j].x), bfhi(v[j].x), bflo(v[j].y), bfhi(v[j].y)} * r3 * gr[e4], xr + e4);
            __builtin_nontemporal_store((f32x4){bflo(v[j].z), bfhi(v[j].z), bflo(v[j].w), bfhi(v[j].w)} * r3 * gr[e4 + 1], xr + e4 + 1); } }
    }
}

__global__ void __launch_bounds__(NWAVES * 64, 2) fwd_kernel(Args args) {
    extern __shared__ __attribute__((aligned(16))) unsigned char lds[];
    Frame F;
    F.lds = (LAS unsigned char*)lds;
    F.MISC = (volatile LAS unsigned*)(F.lds + MISC_OFF);
    F.wave = __builtin_amdgcn_readfirstlane((int)threadIdx.x >> 6);
    F.G = gridDim.x; { const int bx = blockIdx.x; F.vcu = (F.G % 8 == 0) ? (bx % 8) * (F.G / 8) + bx / 8 : bx; }
    for (int u = F.wave * 64 + lane_now(); u < (LDS_BYTES - LDSCTL_OFF) / 4; u += NWAVES * 64) ((LAS unsigned*)(F.lds + LDSCTL_OFF))[u] = 0u;
    __syncthreads();
    XcdBarrier bar = xcd_barrier_post((unsigned*)(args.ws + WS_CTL) + CW_BAR, F.MISC + 8);
#define ST_ ((bf16*)args.out)
#if PROF_SEL
    unsigned long long* PROFW = (unsigned long long*)(args.ws + WS_CTL + 256 * 1024);
    int prof_k = 0;
#define PROF_ARRIVE() do { if (F.wave == 0 && lane_now() == 0) { const unsigned long long t_ = __builtin_amdgcn_s_memrealtime(); \
        __hip_atomic_fetch_max(PROFW + prof_k, t_, __ATOMIC_RELAXED, __HIP_MEMORY_SCOPE_AGENT); __hip_atomic_fetch_max(PROFW + 32 + prof_k, ~t_, __ATOMIC_RELAXED, __HIP_MEMORY_SCOPE_AGENT); } } while (0)
#define GRID_BAR() do { PROF_ARRIVE(); xcd_barrier(bar); if (blockIdx.x == 0 && F.wave == 0 && lane_now() == 0) PROFW[64 + prof_k] = __builtin_amdgcn_s_memrealtime(); ++prof_k; } while (0)
#define PROF_MARK() do { PROF_ARRIVE(); if (blockIdx.x == 0 && F.wave == 0 && lane_now() == 0) PROFW[64 + prof_k] = (prof_k == 0) ? PROFW[95] : PROFW[64 + prof_k - 1]; ++prof_k; } while (0)
#else
#define GRID_BAR() xcd_barrier(bar)
#define PROF_MARK() do { } while (0)
#endif

#define PH_P0() do { p0_prologue(F, args); GRID_BAR(); } while (0)
#define PH_G1() do { { pg8::Gemm gm{W_XN, W_WinT, M, INW, DM / 2, nullptr, nullptr};     \
      pg8::StaticOrder S; S.init(M, INW, F.G, (int)blockIdx.x); \
      pg8::EpiSplit E{W_SLAB(0), DM, DM, (size_t)M * DM, 1.0f / (W8S * X8S)}; \
      pg8::gemm_phase<pg8::EpiSplit, pg8::StaticOrder, true, true, true>(F.lds, gm, S, E, F.wave); } \
    p1_meta(F, args); GRID_BAR(); } while (0)
#define PH_P2A() do { rg_phase<0>(F, args); PROF_MARK(); hg_phase<0>(F, args, ST_); GRID_BAR(); } while (0)
#define PH_G345(QPSLAB) do { \
    p3_convert_uv(F, args); __syncthreads(); \
    { pg8::Gemm gm{W_SLAB(SL_YA), W_WpaT, M, DM, DM, W_SLAB(SL_OG), W_WpbT}; pg8::PairOrder S; S.init(M, DM, F.G, (int)blockIdx.x); \
      pg8::EpiPairGate E{W_SLAB(SL_ZA), W_SLAB(SL_ZB), W_SLAB(SL_MIX), DM}; \
      pg8::gemm_phase<pg8::EpiPairGate, pg8::PairOrder, true, true>(F.lds, gm, S, E, F.wave); } \
    GRID_BAR(); \
    { pg8::Gemm gm{W_SLAB(SL_MIX), W_WoutT, M, DM, DM, nullptr, nullptr}; pg8::StaticOrder S; S.init(M, DM, F.G, (int)blockIdx.x); \
      pg8::EpiResid E{A_x, A_out, W_SLAB(SL_H2B), W_RSP, DM}; \
      pg8::gemm_phase<pg8::EpiResid, pg8::StaticOrder, true, true>(F.lds, gm, S, E, F.wave); } \
    GRID_BAR(); \
    { pg8::Gemm gm{W_SLAB(SL_H2B), W_WqT, M, DM, DM, nullptr, nullptr}; pg8::StaticOrder S; S.init(M, DM, F.G, (int)blockIdx.x); \
      pg8::EpiRowScale E{W_SLAB(QPSLAB), DM, W_RSP, 1.0f / DM, EPS, W_RSTD2}; \
      pg8::gemm_phase<pg8::EpiRowScale, pg8::StaticOrder, true, true>(F.lds, gm, S, E, F.wave); } \
    } while (0)
#define PH_SEL() do { sel_phase(F, args); GRID_BAR(); } while (0)

#if defined(TEST_ONLY)
#if TEST_ONLY == 1
    rg_phase<0>(F, args);
#elif TEST_ONLY == 2
    rg_phase<1>(F, args);
#elif TEST_ONLY == 3
    hg_phase<0>(F, args, ST_);
#elif TEST_ONLY == 4
    hg_phase<1>(F, args, ST_);
#elif TEST_ONLY == 5
    sel_phase(F, args);
#elif TEST_ONLY == 6
    peer_phase(F, args);
#elif TEST_ONLY == 7
    p0_prologue(F, args);
#endif
    return;
#endif
#if PROF_SEL
    if (blockIdx.x == 0 && F.wave == 0 && lane_now() == 0) PROFW[95] = __builtin_amdgcn_s_memrealtime();
#endif
    PH_P0();
#if REPMASK & 1
    PH_P0();
#endif
    PH_G1();
#if REPMASK & 2
    PH_G1();
#endif
#if REPMASK & 64
    rg_phase<0, false, RGVAR>(F, args); GRID_BAR();
#endif
    PH_P2A();
#if REPMASK & 4
    PH_P2A();
#endif
#if REPMASK & 128
    hg_phase<0>(F, args, ST_); GRID_BAR();
#endif
    hg_carry(F, args, ST_);
    GRID_BAR();
#if REPMASK & 256
    rg_phase<1, true>(F, args); GRID_BAR();
#endif
#if REPMASK & 512
    hg_phase<1, true>(F, args, ST_); GRID_BAR();
#endif
    rg_phase<1>(F, args);
    PROF_MARK();
    hg_phase<1>(F, args, ST_);
    GRID_BAR();
#if REPMASK & 8
    PH_G345(SL_MIX); GRID_BAR();
#endif
    PH_G345(SL_QP);
    PH_SEL();
#if REPMASK & 16
    PH_SEL();
#endif
#if PROF_SEL
    peer_phase(F, args, PROFW, prof_k); if (blockIdx.x == 0 && F.wave == 0 && lane_now() == 0) PROFW[64 + prof_k] = PROFW[64 + prof_k - 1]; ++prof_k;
#else
    peer_phase(F, args);
#endif
#if PROF_SEL
    PROF_ARRIVE();
    asm volatile("s_waitcnt vmcnt(0)" ::: "memory");
    if (blockIdx.x == 0) {
        if (F.wave == 0 && lane_now() == 0) {
            const unsigned long long t0 = __builtin_amdgcn_s_memrealtime();
            while (__builtin_amdgcn_s_memrealtime() - t0 < 30000ull) __builtin_amdgcn_s_sleep(8);
            const int k = PROF_SEL % 100;
            const unsigned long long last = __hip_atomic_load(PROFW + k, __ATOMIC_RELAXED, __HIP_MEMORY_SCOPE_AGENT), first = ~__hip_atomic_load(PROFW + 32 + k, __ATOMIC_RELAXED, __HIP_MEMORY_SCOPE_AGENT);
            const unsigned long long rel = (k == 0) ? PROFW[95] : PROFW[64 + k - 1];
            unsigned long long q = (PROF_SEL >= 200) ? (last - first) : (last - rel);
            if (PROF_SEL == 300) q = 0ull; if (PROF_SEL == 301) q = 10000ull;
            if (q > 200000ull) q = 200000ull;
            const unsigned long long t1 = __builtin_amdgcn_s_memrealtime();
            while (__builtin_amdgcn_s_memrealtime() - t1 < q * PROF_AMP) __builtin_amdgcn_s_sleep(8);
        }
    }
#endif
}

extern "C" void kernel_launch(void* const* d_in, const int* in_sizes, int n_in, void* d_out, int out_size, void* d_ws, size_t ws_size, hipStream_t stream) {
    static int grid = 0;
    if (grid == 0) {
        if (n_in != 22 || in_sizes[0] != M * DM || out_size != M * DM || ws_size < WS_END) { fprintf(stderr, "kernel_launch: unexpected shapes (n_in %d in0 %d out %d ws %zu)\n", n_in, n_in > 0 ? in_sizes[0] : -1, out_size, ws_size); grid = -1; return; }
        int dev = 0, cus = 0, per_cu = 0;
        if (hipGetDevice(&dev) != hipSuccess || hipDeviceGetAttribute(&cus, hipDeviceAttributeMultiprocessorCount, dev) != hipSuccess) { grid = -1; return; }
        if (hipFuncSetAttribute((const void*)fwd_kernel, hipFuncAttributeMaxDynamicSharedMemorySize, LDS_BYTES) != hipSuccess) { fprintf(stderr, "kernel_launch: hipFuncSetAttribute failed\n"); grid = -1; return; }
        if (hipOccupancyMaxActiveBlocksPerMultiprocessor(&per_cu, (const void*)fwd_kernel, NWAVES * 64, LDS_BYTES) != hipSuccess || per_cu < 1) { fprintf(stderr, "kernel_launch: occupancy query says %d\n", per_cu); per_cu = 1; }
        (void)hipGetLastError();
        grid = cus;
        if (grid % 8 != 0 || grid > 256) grid = (grid > 256) ? 256 : (grid / 8) * 8;
        if (M / (grid * NWAVES) != PEER_TPW || M % (grid * NWAVES) != 0) { fprintf(stderr, "kernel_launch: built for a 256-CU device (got %d)\n", grid); grid = -1; return; }
    }
    if (grid <= 0) return;
    (void)hipMemsetAsync((char*)d_ws + WS_CTL, 0, CTL_ZERO_BYTES, stream);
    Args a{};
    for (int i = 0; i < 22; ++i) a.in[i] = (const float*)d_in[i];
    a.out = (float*)d_out; a.ws = (unsigned char*)d_ws;
    hipLaunchKernelGGL(fwd_kernel, dim3(grid), dim3(NWAVES * 64), LDS_BYTES, stream, a);
}
```
